# Optimizing an MI355X kernel written in HIP

```python
import math
import jax, jax.numpy as jnp
from jax import lax
import numpy as np

D_MODEL = 1024
BATCH = 32
SEQ = 2048
DEPTH = 1
DEC_BATCH = 128
DEC_SEQ = 1
PAST_LEN = 8192
PAGE_SIZE = 128

D_MIX = D_MODEL
N_ATT_HEADS = 8
ATT_HEAD_DIM = 64
N_KV_HEADS = 2
D_ATT = N_ATT_HEADS * ATT_HEAD_DIM
KV_DIM = N_KV_HEADS * ATT_HEAD_DIM
N_IDX_HEADS = 16
IDX_DIM = 64
TOPK_MAX = 256
N_GDN_HEADS = 4
GDN_HEAD_DIM = 128
D_GDN = N_GDN_HEADS * GDN_HEAD_DIM
CONV_W = 4
GDN_CHUNK = 64
N_BUCKETS = 32
MAX_DISTANCE = 128
Q_BLOCK = 128
RMS_EPS = 1e-6
NEG_BIG = -1e30
PROJ_SIZES = (D_ATT, KV_DIM, KV_DIM, D_ATT, N_IDX_HEADS * IDX_DIM, IDX_DIM, N_IDX_HEADS,
              3 * D_GDN, D_GDN, N_GDN_HEADS, N_GDN_HEADS)
D_PROJ = sum(PROJ_SIZES)

kernel_name = 'hymba_dsa_gdn_decode_step'


def _rmsnorm(x, g):
    xf = x.astype(jnp.float32)
    y = xf * lax.rsqrt(jnp.mean(xf * xf, axis=-1, keepdims=True) + RMS_EPS)
    return (y * g.astype(jnp.float32)).astype(x.dtype)


def _l2norm(x):
    return x * lax.rsqrt(jnp.sum(x * x, axis=-1, keepdims=True) + 1e-6)


def _rel_bucket(dist):
    n = jnp.maximum(dist, 0)
    max_exact = N_BUCKETS // 2
    nf = jnp.maximum(n, 1).astype(jnp.float32)
    large = max_exact + (jnp.log(nf / max_exact) / math.log(MAX_DISTANCE / max_exact)
                         * (N_BUCKETS - max_exact)).astype(jnp.int32)
    large = jnp.minimum(large, N_BUCKETS - 1)
    return jnp.where(n < max_exact, n, large)


def _mixer_inputs(x, norm_g, w_in):
    B, T, _ = x.shape
    h = _rmsnorm(x, norm_g)
    splits = np.cumsum(PROJ_SIZES)[:-1].tolist()
    q, k, v, z_a, qi, ki, wi, qkv, z_g, a_g, b_g = jnp.split(h @ w_in, splits, axis=-1)
    return (q.reshape(B, T, N_ATT_HEADS, ATT_HEAD_DIM),
            k.reshape(B, T, N_KV_HEADS, ATT_HEAD_DIM),
            v.reshape(B, T, N_KV_HEADS, ATT_HEAD_DIM),
            z_a, qi.reshape(B, T, N_IDX_HEADS, IDX_DIM), ki, wi, qkv, z_g, a_g, b_g)


def _indexer_scores(qi, wi, ki):
    s = jnp.einsum('...thd,...sd->...ths', qi.astype(jnp.float32), ki.astype(jnp.float32)) * (IDX_DIM ** -0.5)
    return jnp.einsum('...ths,...th->...ts', jax.nn.relu(s), wi.astype(jnp.float32)) * (N_IDX_HEADS ** -0.5)


def _sparse_attend(q, k_sel, v_sel, valid, bias):
    *lead, T, H, Dh = q.shape
    K = k_sel.shape[-3]
    G = H // N_KV_HEADS
    qg = q.reshape(*lead, T, N_KV_HEADS, G, Dh).astype(jnp.float32)
    logits = jnp.einsum('...tgrd,...tkgd->...tgrk', qg, k_sel.astype(jnp.float32)) * (Dh ** -0.5)
    b = jnp.moveaxis(bias.astype(jnp.float32).reshape(*lead, T, K, N_KV_HEADS, G), -3, -1)
    logits = jnp.where(valid[..., :, None, None, :], logits + b, NEG_BIG)
    p = jax.nn.softmax(logits, axis=-1)
    o = jnp.einsum('...tgrk,...tkgd->...tgrd', p, v_sel.astype(jnp.float32))
    return o.reshape(*lead, T, H * Dh)


def _dsa_prompt(q, k, v, qi, ki, wi, rel_table):
    B, S = q.shape[:2]
    topk = min(TOPK_MAX, S // 4)
    n_blocks = S // Q_BLOCK
    kpos = jnp.arange(S)

    def per_seq(args):
        q1, k1, v1, qi1, ki1, wi1 = args

        def per_block(bi):
            t0 = bi * Q_BLOCK
            qb = lax.dynamic_slice_in_dim(q1, t0, Q_BLOCK, 0)
            qib = lax.dynamic_slice_in_dim(qi1, t0, Q_BLOCK, 0)
            wib = lax.dynamic_slice_in_dim(wi1, t0, Q_BLOCK, 0)
            qpos = t0 + jnp.arange(Q_BLOCK)
            sc = _indexer_scores(qib, wib, ki1)
            sc = jnp.where(kpos[None, :] <= qpos[:, None], sc, NEG_BIG)
            _, sel = lax.top_k(sc, topk)
            valid = sel <= qpos[:, None]
            bias = rel_table[_rel_bucket(qpos[:, None] - sel)]
            return _sparse_attend(qb, k1[sel], v1[sel], valid, bias)

        return lax.map(per_block, jnp.arange(n_blocks)).reshape(S, D_ATT)

    return lax.map(per_seq, (q, k, v, qi, ki, wi))


def _dsa_sample(q, k_new, v_new, qi, ki_new, wi, cache_k, cache_v, cache_kidx, layer, page_table, rel_table):
    Bd, T = q.shape[:2]
    n_pages = page_table.shape[1]
    P = n_pages * PAGE_SIZE
    L = P + T
    topk = min(TOPK_MAX, L // 4)
    ki_past = cache_kidx[layer, page_table].reshape(Bd, P, IDX_DIM)
    ki_all = jnp.concatenate([ki_past.astype(ki_new.dtype), ki_new], axis=1)
    qpos = P + jnp.arange(T)
    kpos = jnp.arange(L)
    sc = _indexer_scores(qi, wi, ki_all)
    sc = jnp.where(kpos[None, None, :] <= qpos[None, :, None], sc, NEG_BIG)
    _, sel = lax.top_k(sc, topk)
    valid = sel <= qpos[None, :, None]
    in_past = (sel < P)[..., None, None]
    sp = jnp.minimum(sel, P - 1)
    bidx = jnp.arange(Bd)[:, None, None]
    phys = page_table[bidx, sp // PAGE_SIZE]
    off = sp % PAGE_SIZE
    sn = jnp.clip(sel - P, 0, T - 1)
    k_sel = jnp.where(in_past, cache_k[layer, phys, off].astype(k_new.dtype), k_new[bidx, sn])
    v_sel = jnp.where(in_past, cache_v[layer, phys, off].astype(v_new.dtype), v_new[bidx, sn])
    bias = rel_table[_rel_bucket(qpos[None, :, None] - sel)]
    return _sparse_attend(q, k_sel, v_sel, valid, bias)


def _causal_conv(x_ext, w):
    T = x_ext.shape[1] - (CONV_W - 1)
    out = x_ext[:, 0:T] * w[0]
    for j in range(1, CONV_W):
        out = out + x_ext[:, j:j + T] * w[j]
    return jax.nn.silu(out)


def _gdn_features(qkv_c, a_g, b_g, a_log, dt_bias):
    B, T, _ = qkv_c.shape
    q, k, v = jnp.split(qkv_c.astype(jnp.float32), 3, axis=-1)
    q = _l2norm(q.reshape(B, T, N_GDN_HEADS, GDN_HEAD_DIM)) * (GDN_HEAD_DIM ** -0.5)
    k = _l2norm(k.reshape(B, T, N_GDN_HEADS, GDN_HEAD_DIM))
    v = v.reshape(B, T, N_GDN_HEADS, GDN_HEAD_DIM)
    g = -jnp.exp(a_log.astype(jnp.float32)) * jax.nn.softplus(a_g.astype(jnp.float32) + dt_bias.astype(jnp.float32))
    beta = jax.nn.sigmoid(b_g.astype(jnp.float32))
    return q, k, v, g, beta


def _gdn_chunked(q, k, v, g, beta):
    B, T, H, Dk = q.shape
    Dv = v.shape[-1]
    C = GDN_CHUNK
    N = T // C

    def chunkify(x):
        return x.reshape(B, N, C, H, -1).transpose(0, 3, 1, 2, 4)

    qc, kc, vc = chunkify(q), chunkify(k), chunkify(v)
    gc = g.reshape(B, N, C, H).transpose(0, 3, 1, 2)
    bc = beta.reshape(B, N, C, H).transpose(0, 3, 1, 2)
    gcum = jnp.cumsum(gc, axis=-1)
    tril = jnp.tril(jnp.ones((C, C), dtype=bool))
    strict = jnp.tril(jnp.ones((C, C), dtype=bool), -1)
    diff = gcum[..., :, None] - gcum[..., None, :]
    decay = jnp.where(tril, jnp.exp(jnp.where(tril, diff, 0.0)), 0.0)
    kb = kc * bc[..., None]
    vb = vc * bc[..., None]
    a_mat = jnp.where(strict, jnp.einsum('bhncd,bhnsd->bhncs', kb, kc) * decay, 0.0)
    u = lax.linalg.triangular_solve(a_mat, vb, left_side=True, lower=True, unit_diagonal=True)
    w = lax.linalg.triangular_solve(a_mat, kb * jnp.exp(gcum)[..., None], left_side=True, lower=True, unit_diagonal=True)
    attn_qk = jnp.einsum('bhncd,bhnsd->bhncs', qc, kc) * decay
    q_dec = qc * jnp.exp(gcum)[..., None]
    k_dec = kc * jnp.exp(gcum[..., -1:] - gcum)[..., None]
    chunk_dec = jnp.exp(gcum[..., -1])

    def step(S, xs):
        q_d, k_d, u_i, w_i, a_i, dec = xs
        v_new = u_i - jnp.einsum('bhcd,bhde->bhce', w_i, S)
        o = jnp.einsum('bhcd,bhde->bhce', q_d, S) + jnp.einsum('bhcs,bhse->bhce', a_i, v_new)
        S = S * dec[..., None, None] + jnp.einsum('bhcd,bhce->bhde', k_d, v_new)
        return S, o

    xs = tuple(jnp.moveaxis(t, 2, 0) for t in (q_dec, k_dec, u, w, attn_qk, chunk_dec))
    S0 = jnp.zeros((B, H, Dk, Dv), jnp.float32)
    S_fin, o = lax.scan(step, S0, xs)
    o = o.transpose(1, 0, 3, 2, 4).reshape(B, T, H, Dv)
    return o, S_fin


def _gdn_recurrent(q, k, v, g, beta, S0):
    def step(S, xs):
        q_t, k_t, v_t, g_t, b_t = xs
        S = S * jnp.exp(g_t)[..., None, None]
        kv = jnp.einsum('bhd,bhde->bhe', k_t, S)
        delta = (v_t - kv) * b_t[..., None]
        S = S + jnp.einsum('bhd,bhe->bhde', k_t, delta)
        return S, jnp.einsum('bhd,bhde->bhe', q_t, S)

    xs = tuple(jnp.moveaxis(t, 1, 0) for t in (q, k, v, g, beta))
    S_fin, o = lax.scan(step, S0.astype(jnp.float32), xs)
    return jnp.moveaxis(o, 0, 1), S_fin


def _merge(x, att_o, z_a, gdn_o, z_g, gdn_norm_g, w_out):
    B, T = x.shape[:2]
    att = att_o * jax.nn.silu(z_a.astype(jnp.float32))
    gdn = _rmsnorm(gdn_o, gdn_norm_g).reshape(B, T, D_GDN) * jax.nn.silu(z_g.astype(jnp.float32))
    mixed = jnp.concatenate([att, gdn], axis=-1).astype(x.dtype)
    return x + mixed @ w_out


def setup_inputs(seed: int = 0) -> dict:
    key = jax.random.key(seed)
    ks = jax.random.split(key, 20)
    f32 = jnp.float32
    n_pages = PAST_LEN // PAGE_SIZE
    n_pool = (DEC_BATCH * n_pages * 5) // 4
    x_prompt = jax.random.normal(ks[0], (BATCH, SEQ, D_MODEL), f32)
    x_sample = jax.random.normal(ks[1], (DEC_BATCH, DEC_SEQ, D_MODEL), f32)
    cache_k = jax.random.normal(ks[2], (DEPTH, n_pool, PAGE_SIZE, N_KV_HEADS, ATT_HEAD_DIM), f32)
    cache_v = jax.random.normal(ks[3], (DEPTH, n_pool, PAGE_SIZE, N_KV_HEADS, ATT_HEAD_DIM), f32)
    cache_kidx = jax.random.normal(ks[4], (DEPTH, n_pool, PAGE_SIZE, IDX_DIM), f32)
    state_ssm = 0.1 * jax.random.normal(ks[5], (DEPTH, DEC_BATCH, N_GDN_HEADS, GDN_HEAD_DIM, GDN_HEAD_DIM), f32)
    state_conv = jax.random.normal(ks[6], (DEPTH, DEC_BATCH, CONV_W - 1, 3 * D_GDN), f32)
    page_table = jax.random.permutation(ks[7], n_pool)[:DEC_BATCH * n_pages].reshape(DEC_BATCH, n_pages).astype(jnp.int32)
    norm_in = 1.0 + 0.01 * jax.random.normal(ks[8], (DEPTH, D_MODEL), f32)
    w_in = jax.random.normal(ks[9], (DEPTH, D_MODEL, D_PROJ), f32) * (D_MODEL ** -0.5)
    conv_w = jax.random.normal(ks[10], (DEPTH, CONV_W, 3 * D_GDN), f32) * (CONV_W ** -0.5)
    a_log = jnp.log(jax.random.uniform(ks[11], (DEPTH, N_GDN_HEADS), f32, 1.0, 16.0))
    dt = jnp.exp(jax.random.uniform(ks[12], (DEPTH, N_GDN_HEADS), f32, math.log(1e-3), math.log(1e-1)))
    dt_bias = dt + jnp.log(-jnp.expm1(-dt))
    gdn_norm = 1.0 + 0.01 * jax.random.normal(ks[13], (DEPTH, GDN_HEAD_DIM), f32)
    w_out = jax.random.normal(ks[14], (DEPTH, D_MIX, D_MODEL), f32) * (D_MIX ** -0.5)
    rel_table = 0.5 * jax.random.normal(ks[15], (N_BUCKETS, N_ATT_HEADS), f32)
    norm_final = 1.0 + 0.01 * jax.random.normal(ks[16], (D_MODEL,), f32)
    return {'x_prompt': x_prompt, 'x_sample': x_sample, 'cache_k': cache_k, 'cache_v': cache_v,
            'cache_kidx': cache_kidx, 'state_ssm': state_ssm, 'state_conv': state_conv,
            'page_table': page_table, 'norm_in': norm_in, 'w_in': w_in, 'conv_w': conv_w,
            'a_log': a_log, 'dt_bias': dt_bias, 'gdn_norm': gdn_norm, 'w_out': w_out,
            'rel_table': rel_table, 'norm_final': norm_final}


def reference(x_prompt, x_sample, cache_k, cache_v, cache_kidx, state_ssm, state_conv, page_table,
              norm_in, w_in, conv_w, a_log, dt_bias, gdn_norm, w_out, rel_table, norm_final):
    hp, hs = x_prompt, x_sample
    kp_l, vp_l, kip_l, sp_l, cp_l = [], [], [], [], []
    ks_l, vs_l, kis_l, ss_l, cs_l = [], [], [], [], []
    for l in range(DEPTH):
        q, k, v, z_a, qi, ki, wi, qkv, z_g, a_g, b_g = _mixer_inputs(hp, norm_in[l], w_in[l])
        att = _dsa_prompt(q, k, v, qi, ki, wi, rel_table)
        qkv_c = _causal_conv(jnp.pad(qkv, ((0, 0), (CONV_W - 1, 0), (0, 0))), conv_w[l])
        gq, gk, gv, g, beta = _gdn_features(qkv_c, a_g, b_g, a_log[l], dt_bias[l])
        gdn, s_fin = _gdn_chunked(gq, gk, gv, g, beta)
        hp = _merge(hp, att, z_a, gdn, z_g, gdn_norm[l], w_out[l])
        kp_l.append(k)
        vp_l.append(v)
        kip_l.append(ki)
        sp_l.append(s_fin.astype(x_prompt.dtype))
        cp_l.append(qkv[:, -(CONV_W - 1):])
        q, k, v, z_a, qi, ki, wi, qkv, z_g, a_g, b_g = _mixer_inputs(hs, norm_in[l], w_in[l])
        att = _dsa_sample(q, k, v, qi, ki, wi, cache_k, cache_v, cache_kidx, l, page_table, rel_table)
        conv_ext = jnp.concatenate([state_conv[l].astype(qkv.dtype), qkv], axis=1)
        qkv_c = _causal_conv(conv_ext, conv_w[l])
        gq, gk, gv, g, beta = _gdn_features(qkv_c, a_g, b_g, a_log[l], dt_bias[l])
        gdn, s_new = _gdn_recurrent(gq, gk, gv, g, beta, state_ssm[l])
        hs = _merge(hs, att, z_a, gdn, z_g, gdn_norm[l], w_out[l])
        ks_l.append(k)
        vs_l.append(v)
        kis_l.append(ki)
        ss_l.append(s_new.astype(state_ssm.dtype))
        cs_l.append(conv_ext[:, -(CONV_W - 1):])
    y_prompt = _rmsnorm(hp, norm_final)
    y_sample = _rmsnorm(hs, norm_final)
    return (y_prompt, y_sample,
            jnp.stack(kp_l), jnp.stack(vp_l), jnp.stack(kip_l), jnp.stack(sp_l), jnp.stack(cp_l),
            jnp.stack(ks_l), jnp.stack(vs_l), jnp.stack(kis_l), jnp.stack(ss_l), jnp.stack(cs_l))
```

```cpp
#include <hip/hip_runtime.h>
#include <cstdio>
#include <cstdint>

#define LAS __attribute__((address_space(3)))
#define GAS __attribute__((address_space(1)))
typedef unsigned short bf16_t;
typedef short bf16x8 __attribute__((ext_vector_type(8)));
typedef float f32x4 __attribute__((ext_vector_type(4)));
typedef unsigned u32x4 __attribute__((ext_vector_type(4)));

constexpr int D_MODEL = 1024, BATCH = 32, SEQ = 2048, DEC_BATCH = 128, PAST = 8192, PAGE = 128, NPAGES = 64;
constexpr int MPROMPT = BATCH * SEQ;
constexpr int MVALID = MPROMPT + DEC_BATCH;
constexpr int MP = MPROMPT + 256;
constexpr int NP = 4608;
constexpr int C_Q = 0, C_K = 512, C_V = 640, C_ZA = 768, C_QI = 1280, C_KI = 2304, C_WI = 2368, C_AG = 2384, C_BG = 2388, C_QKV = 2560, C_ZG = 4096;
constexpr int AUXP = 32;
constexpr size_t O_YP = 0, O_YS = 67108864, O_KP = 67239936, O_VP = 75628544, O_KIP = 84017152, O_SSMP = 88211456, O_CP = 90308608,
                 O_KS = 90456064, O_VS = 90472448, O_KIS = 90488832, O_SSMS = 90497024, O_CS = 98885632, O_END = 99475456;
constexpr size_t MiB = 1u << 20;
constexpr size_t WS_CTL = 0, CTL_BYTES = 1 * MiB;
constexpr size_t WS_ROWSS = 512 * 1024;
constexpr size_t WS_WINT = 2 * MiB;
constexpr size_t WS_WOUTT = 12 * MiB;
constexpr size_t WS_XN = 16 * MiB;
constexpr size_t WS_PROJ = 146 * MiB;
constexpr size_t WS_AUX = 726 * MiB;
constexpr size_t WS_MIXED = 736 * MiB;
constexpr size_t WS_MASK = 866 * MiB;
constexpr size_t WS_END = 900 * MiB;

__constant__ unsigned char c_bucket[128] = {0, 1, 2, 3, 4, 5, 6, 7, 8, 9, 10, 11, 12, 13, 14, 15, 16, 16, 16, 17, 17, 18, 18, 18, 19, 19, 19, 20, 20, 20, 20, 21, 21, 21, 21, 22, 22, 22, 22, 22, 23, 23, 23, 23, 23, 23, 24, 24, 24, 24, 24, 24, 25, 25, 25, 25, 25, 25, 25, 26, 26, 26, 26, 26, 26, 26, 26, 27, 27, 27, 27, 27, 27, 27, 27, 27, 27, 28, 28, 28, 28, 28, 28, 28, 28, 28, 28, 29, 29, 29, 29, 29, 29, 29, 29, 29, 29, 29, 29, 30, 30, 30, 30, 30, 30, 30, 30, 30, 30, 30, 30, 30, 30, 31, 31, 31, 31, 31, 31, 31, 31, 31, 31, 31, 31, 31, 31, 31};

__device__ __forceinline__ float bf2f(unsigned short b) { return __builtin_bit_cast(float, (unsigned)b << 16); }
__device__ __forceinline__ unsigned f2bf(float f) { unsigned u = __builtin_bit_cast(unsigned, f); return (u + 0x7fffu + ((u >> 16) & 1u)) >> 16; }
__device__ __forceinline__ unsigned pk2(float lo, float hi) { return f2bf(lo) | (f2bf(hi) << 16); }
__device__ __forceinline__ float wave_sum(float v) {
#pragma unroll
    for (int o = 1; o < 64; o <<= 1) v += __shfl_xor(v, o);
    return v;
}
__device__ __forceinline__ int wave_sum_i(int v) {
#pragma unroll
    for (int o = 1; o < 64; o <<= 1) v += __shfl_xor(v, o);
    return v;
}
__device__ __forceinline__ float wave_max(float v) {
#pragma unroll
    for (int o = 1; o < 64; o <<= 1) v = fmaxf(v, __shfl_xor(v, o));
    return v;
}
__device__ __forceinline__ int wave_excl_scan_i(int v, int lane) {
    int x = v;
#pragma unroll
    for (int o = 1; o < 64; o <<= 1) { int y = __shfl_up(x, o); if (lane >= o) x += y; }
    return x - v;
}
__device__ __forceinline__ unsigned f2key(float f) { unsigned u = __builtin_bit_cast(unsigned, f); return (u & 0x80000000u) ? ~u : (u | 0x80000000u); }
__device__ __forceinline__ float silu_f(float z) { return z / (1.f + __expf(-z)); }
__device__ __forceinline__ void unpack8(const u32x4 w, float* f) {
    f[0] = __builtin_bit_cast(float, w.x << 16); f[1] = __builtin_bit_cast(float, w.x & 0xffff0000u);
    f[2] = __builtin_bit_cast(float, w.y << 16); f[3] = __builtin_bit_cast(float, w.y & 0xffff0000u);
    f[4] = __builtin_bit_cast(float, w.z << 16); f[5] = __builtin_bit_cast(float, w.z & 0xffff0000u);
    f[6] = __builtin_bit_cast(float, w.w << 16); f[7] = __builtin_bit_cast(float, w.w & 0xffff0000u);
}

namespace pg8 {
#define PG8_LAS __attribute__((address_space(3)))
constexpr int BM = 256, BK = 64, HALF = 128, HTB = HALF * BK * 2, STAGE_BYTES = 8 * HTB, NXCD = 8, WGM = 8;
__host__ __device__ __forceinline__ int lds_byte(int r, int c) { const int st = (r >> 4) * 2 + (c >> 5), rr = r & 15, cc = c & 31, ob = rr * 64 + cc * 2; return st * 1024 + (ob ^ (((ob >> 9) & 1) << 5)); }
__host__ __device__ __forceinline__ void stage_rc(int b, int& R, int& C) { const int st = b / 1024, sb = b % 1024, swz = sb ^ (((sb >> 9) & 1) << 5); R = (st >> 1) * 16 + swz / 64; C = (st & 1) * 32 + (swz % 64) / 2; }
__host__ __device__ __forceinline__ int perm32(int rho) { const int n = rho >> 4, i = rho & 15; return 8 * (i >> 2) + 4 * n + (i & 3); }
struct Unit { int pm, pn; };
struct Gemm { const bf16_t* A; const bf16_t* Bt; int M, N, K; };
struct StaticOrder {
    int nM, nN, nwg, G, c;
    __host__ __device__ void init(int M, int N, int G_, int c_) { nM = M / BM; nN = N / BM; nwg = nM * nN; G = G_; c = c_; }
    __host__ __device__ bool next(int i, Unit& u) const {
        const long L = (long)i * G + c; if (L >= nwg) return false;
        int wgid = (int)L; { const int q = nwg / NXCD, r = nwg % NXCD, xcd = wgid % NXCD, off = wgid / NXCD; wgid = (xcd < r ? xcd * (q + 1) : r * (q + 1) + (xcd - r) * q) + off; }
        const int nig = WGM * nN, gid = wgid / nig, fm = gid * WGM, gsz = (nM - fm) < WGM ? (nM - fm) : WGM;
        u.pm = fm + ((wgid % nig) % gsz); u.pn = (wgid % nig) / gsz; return true;
    }
    __device__ __forceinline__ void a_ready(const Unit&) const {}
    __device__ __forceinline__ void done(const Unit&) const {}
};
__device__ __forceinline__ unsigned cvt_pk_bf16(float lo, float hi) { unsigned r; asm volatile("v_cvt_pk_bf16_f32 %0, %1, %2" : "=v"(r) : "v"(lo), "v"(hi)); return r; }

template <class Epi, class Sched, bool ALIGN_EPI = false, bool SP2 = false>
__device__ __forceinline__ void gemm_phase(PG8_LAS unsigned char* lds, const Gemm g, const Sched& S, const Epi& E) {
    const int tid = threadIdx.x, wid = __builtin_amdgcn_readfirstlane(tid >> 6), lane = tid & 63, wr = wid >> 2, wc = wid & 3, fr = lane & 15, fq = lane >> 4;
    const int K = g.K, nt = K / BK;
    unsigned voffA[2], voffB[2];
#pragma unroll
    for (int i = 0; i < 2; ++i) { int R, C; stage_rc(tid * 16 + i * 8192, R, C); const int Rb = Epi::PERM ? ((R & ~31) + perm32(R & 31)) : R;
        voffA[i] = (unsigned)(R * K + C) * 2u; voffB[i] = (unsigned)(Rb * K + C) * 2u; }
    const size_t kstep = (size_t)(BK * 2);
    const size_t hstep = (size_t)HALF * K * 2;
    const size_t tstep = 2 * hstep;
    const unsigned ldsw = (unsigned)wid * 1024u;
    const int aoff = lds_byte(wr * 64 + fr, fq * 8), boff = lds_byte(wc * 32 + fr, fq * 8);
#define PG8_SA(b, h) (((b) * 2 + (h)) * HTB)
#define PG8_SB(b, h) ((4 + (b) * 2 + (h)) * HTB)
#define PG8_STAGE(bufoff, gbase, voff) do { _Pragma("unroll") for (int _i = 0; _i < 2; ++_i) \
        __builtin_amdgcn_global_load_lds((const unsigned*)((const char*)(gbase) + (voff)[_i]), (PG8_LAS unsigned*)(lds + (bufoff) + ldsw + _i * 8192), 16, 0, 0); } while (0)
#define PG8_LDA(dst, b, h) do { _Pragma("unroll") for (int m = 0; m < 4; ++m) _Pragma("unroll") for (int k = 0; k < 2; ++k) dst[m][k] = *(const PG8_LAS bf16x8*)(lds + PG8_SA(b, h) + aoff + m * 2048 + k * 1024); } while (0)
#define PG8_LDB(dst, b, h) do { _Pragma("unroll") for (int n = 0; n < 2; ++n) _Pragma("unroll") for (int k = 0; k < 2; ++k) dst[n][k] = *(const PG8_LAS bf16x8*)(lds + PG8_SB(b, h) + boff + n * 2048 + k * 1024); } while (0)
#define PG8_MMA(ai, bj, At, Bt) do { __builtin_amdgcn_s_setprio(1); _Pragma("unroll") for (int m = 0; m < 4; ++m) _Pragma("unroll") for (int n = 0; n < 2; ++n) _Pragma("unroll") for (int k = 0; k < 2; ++k) \
        acc[ai][bj][m][n] = __builtin_amdgcn_mfma_f32_16x16x32_bf16(Bt[n][k], At[m][k], acc[ai][bj][m][n], 0, 0, 0); __builtin_amdgcn_s_setprio(0); } while (0)
#define PG8_WAIT_V(n) asm volatile("s_waitcnt vmcnt(" #n ")" ::: "memory")
#define PG8_WAIT_L(n) asm volatile("s_waitcnt lgkmcnt(" #n ")" ::: "memory")
#define PG8_BAR __builtin_amdgcn_s_barrier()
#define PG8_SCHED __builtin_amdgcn_sched_barrier(0)
    Unit cur, nxt; int ui = 0;
    if (!S.next(0, cur)) return;
    f32x4 acc[2][2][4][2];
#pragma unroll
    for (int a = 0; a < 2; ++a)
#pragma unroll
        for (int b = 0; b < 2; ++b)
#pragma unroll
            for (int m = 0; m < 4; ++m)
#pragma unroll
                for (int n = 0; n < 2; ++n) acc[a][b][m][n] = (f32x4){0.f, 0.f, 0.f, 0.f};
    bf16x8 At[4][2], B0[2][2], B1[2][2];
    const char* cA = (const char*)g.A + (size_t)cur.pm * tstep; const char* cB = (const char*)g.Bt + (size_t)cur.pn * tstep;
    S.a_ready(cur);
    if constexpr (SP2) {
        PG8_STAGE(PG8_SB(0, 0), cB, voffB); PG8_STAGE(PG8_SB(0, 1), cB + hstep, voffB); PG8_STAGE(PG8_SA(0, 0), cA, voffA); PG8_STAGE(PG8_SA(0, 1), cA + hstep, voffA);
        if (wr == 1) PG8_BAR;
        PG8_WAIT_V(2); PG8_BAR;
        PG8_STAGE(PG8_SB(1, 0), cB + kstep, voffB); PG8_STAGE(PG8_SA(1, 0), cA + kstep, voffA); PG8_STAGE(PG8_SB(1, 1), cB + hstep + kstep, voffB);
        PG8_WAIT_V(6); PG8_BAR;
    } else {
        PG8_STAGE(PG8_SB(0, 0), cB, voffB); PG8_STAGE(PG8_SA(0, 0), cA, voffA); PG8_STAGE(PG8_SB(0, 1), cB + hstep, voffB); PG8_STAGE(PG8_SA(0, 1), cA + hstep, voffA);
        if (wr == 1) PG8_BAR;
        PG8_WAIT_V(4); PG8_BAR;
        PG8_STAGE(PG8_SB(1, 0), cB + kstep, voffB); PG8_STAGE(PG8_SA(1, 0), cA + kstep, voffA); PG8_STAGE(PG8_SB(1, 1), cB + hstep + kstep, voffB);
        PG8_WAIT_V(6); PG8_BAR;
    }
    for (;;) {
        const bool has_next = S.next(ui + 1, nxt);
        const char* nA = has_next ? (const char*)g.A + (size_t)nxt.pm * tstep : cA; const char* nB = has_next ? (const char*)g.Bt + (size_t)nxt.pn * tstep : cB;
        for (int t = 0; t < nt; t += 2) {
            const bool last = (t == nt - 2);
            const char* a1 = cA + (size_t)(t + 1) * kstep;
            const char* a2 = last ? nA : cA + (size_t)(t + 2) * kstep; const char* b2 = last ? nB : cB + (size_t)(t + 2) * kstep;
            const char* a3 = a2 + kstep; const char* b3 = b2 + kstep;
            if (last && has_next) S.a_ready(nxt);
            if constexpr (SP2) {
            PG8_LDB(B0, 0, 0); PG8_LDB(B1, 0, 1); PG8_SCHED; PG8_LDA(At, 0, 0); PG8_STAGE(PG8_SA(1, 1), a1 + hstep, voffA);
            PG8_WAIT_V(8); PG8_WAIT_L(0); PG8_BAR; PG8_MMA(0, 0, At, B0); PG8_MMA(0, 1, At, B1); PG8_BAR; PG8_SCHED;
            PG8_LDA(At, 0, 1); PG8_STAGE(PG8_SB(0, 0), b2, voffB); PG8_STAGE(PG8_SB(0, 1), b2 + hstep, voffB); PG8_STAGE(PG8_SA(0, 0), a2, voffA);
            PG8_WAIT_V(8); PG8_WAIT_L(0); PG8_BAR; PG8_MMA(1, 0, At, B0); PG8_MMA(1, 1, At, B1); PG8_BAR; PG8_SCHED;
            PG8_LDB(B0, 1, 0); PG8_LDB(B1, 1, 1); PG8_SCHED; PG8_LDA(At, 1, 0); PG8_STAGE(PG8_SA(0, 1), a2 + hstep, voffA);
            PG8_WAIT_V(8); PG8_WAIT_L(0); PG8_BAR; PG8_MMA(0, 0, At, B0); PG8_MMA(0, 1, At, B1); PG8_BAR; PG8_SCHED;
            PG8_LDA(At, 1, 1); PG8_STAGE(PG8_SB(1, 0), b3, voffB); PG8_STAGE(PG8_SB(1, 1), b3 + hstep, voffB); PG8_STAGE(PG8_SA(1, 0), a3, voffA);
            PG8_WAIT_V(8); PG8_WAIT_L(0); PG8_BAR; PG8_MMA(1, 0, At, B0); PG8_MMA(1, 1, At, B1); PG8_BAR; PG8_SCHED;
            } else {
            PG8_LDB(B0, 0, 0); PG8_SCHED; PG8_LDA(At, 0, 0); PG8_STAGE(PG8_SA(1, 1), a1 + hstep, voffA);
            PG8_WAIT_L(8); PG8_BAR; PG8_WAIT_L(0); PG8_MMA(0, 0, At, B0); PG8_BAR; PG8_SCHED;
            PG8_LDB(B1, 0, 1); PG8_STAGE(PG8_SB(0, 0), b2, voffB);
            PG8_BAR; PG8_WAIT_L(0); PG8_MMA(0, 1, At, B1); PG8_BAR;
            PG8_LDA(At, 0, 1); PG8_STAGE(PG8_SA(0, 0), a2, voffA);
            PG8_BAR; PG8_WAIT_L(0); PG8_MMA(1, 0, At, B0); PG8_BAR; PG8_SCHED;
            PG8_STAGE(PG8_SB(0, 1), b2 + hstep, voffB);
            PG8_WAIT_V(6); PG8_BAR; PG8_MMA(1, 1, At, B1); PG8_BAR;
            PG8_LDB(B0, 1, 0); PG8_SCHED; PG8_LDA(At, 1, 0); PG8_STAGE(PG8_SA(0, 1), a2 + hstep, voffA);
            PG8_WAIT_L(8); PG8_BAR; PG8_WAIT_L(0); PG8_MMA(0, 0, At, B0); PG8_BAR; PG8_SCHED;
            PG8_LDB(B1, 1, 1); PG8_STAGE(PG8_SB(1, 0), b3, voffB);
            PG8_BAR; PG8_WAIT_L(0); PG8_MMA(0, 1, At, B1); PG8_BAR;
            PG8_LDA(At, 1, 1); PG8_STAGE(PG8_SA(1, 0), a3, voffA);
            PG8_BAR; PG8_WAIT_L(0); PG8_MMA(1, 0, At, B0); PG8_BAR; PG8_SCHED;
            PG8_STAGE(PG8_SB(1, 1), b3 + hstep, voffB);
            PG8_WAIT_V(6); PG8_BAR; PG8_MMA(1, 1, At, B1); PG8_BAR;
            }
        }
        if constexpr (ALIGN_EPI) { if (wr == 0) PG8_BAR; }
        if constexpr (!Epi::AFTER_DRAIN) { E(acc, cur, wr, wc, fr, fq); S.done(cur); }
        if (!has_next) break;
#pragma unroll
        for (int a = 0; a < 2; ++a)
#pragma unroll
            for (int b = 0; b < 2; ++b)
#pragma unroll
                for (int m = 0; m < 4; ++m)
#pragma unroll
                    for (int n = 0; n < 2; ++n) acc[a][b][m][n] = (f32x4){0.f, 0.f, 0.f, 0.f};
        cur = nxt; cA = nA; cB = nB; ++ui;
        if constexpr (ALIGN_EPI) { if (wr == 1) PG8_BAR; }
    }
    PG8_WAIT_V(0);
    if constexpr (!ALIGN_EPI) { if (wr == 0) PG8_BAR; }
    PG8_BAR;
#undef PG8_SA
#undef PG8_SB
#undef PG8_STAGE
#undef PG8_LDA
#undef PG8_LDB
#undef PG8_MMA
#undef PG8_WAIT_V
#undef PG8_WAIT_L
#undef PG8_BAR
#undef PG8_SCHED
}
}

struct EpiIn {
    static constexpr bool PERM = true, AFTER_DRAIN = false;
    bf16_t* proj; float* aux; float* out;
    __device__ __forceinline__ void operator()(const f32x4 (&acc)[2][2][4][2], const pg8::Unit& u, int wr, int wc, int fr, int fq) const {
        const int row0 = u.pm * 256 + wr * 64 + fr, colb = u.pn * 256 + wc * 32 + 8 * fq, pn = u.pn;
#pragma unroll
        for (int ai = 0; ai < 2; ++ai)
#pragma unroll
            for (int m = 0; m < 4; ++m) {
                const int row = row0 + ai * 128 + m * 16;
#pragma unroll
                for (int bj = 0; bj < 2; ++bj) {
                    const int col = colb + bj * 128;
                    const f32x4 v0 = acc[ai][bj][m][0], v1 = acc[ai][bj][m][1];
                    u32x4 w; w.x = pg8::cvt_pk_bf16(v0[0], v0[1]); w.y = pg8::cvt_pk_bf16(v0[2], v0[3]); w.z = pg8::cvt_pk_bf16(v1[0], v1[1]); w.w = pg8::cvt_pk_bf16(v1[2], v1[3]);
                    *(u32x4*)(proj + (size_t)row * NP + col) = w;
                    float* dst = nullptr;
                    if (pn == 2) {
                        const int c = col - C_K; const int isv = c >= 128; const int cc = c & 127;
                        if (row < MPROMPT) dst = out + (isv ? O_VP : O_KP) + (size_t)row * 128 + cc;
                        else if (row < MVALID) dst = out + (isv ? O_VS : O_KS) + (size_t)(row - MPROMPT) * 128 + cc;
                    } else if (pn == 9) {
                        const int c = col - C_KI;
                        if (c < 64) {
                            if (row < MPROMPT) dst = out + O_KIP + (size_t)row * 64 + c;
                            else if (row < MVALID) dst = out + O_KIS + (size_t)(row - MPROMPT) * 64 + c;
                        } else if (c < 88) dst = aux + (size_t)row * AUXP + (c - 64);
                    } else if (pn >= 10 && pn <= 15) {
                        const int c = col - C_QKV;
                        if (row < MPROMPT) { const int t = row & (SEQ - 1); if (t >= SEQ - 3) dst = out + O_CP + ((size_t)(row >> 11) * 3 + (t - (SEQ - 3))) * 1536 + c; }
                        else if (row < MVALID) dst = out + O_CS + ((size_t)(row - MPROMPT) * 3 + 2) * 1536 + c;
                    }
                    if (dst) { *(f32x4*)dst = v0; *(f32x4*)(dst + 4) = v1; }
                }
            }
    }
};
struct EpiOut {
    static constexpr bool PERM = true, AFTER_DRAIN = false;
    const float* xp; const float* xs; float* out; float* rowss;
    __device__ __forceinline__ void operator()(const f32x4 (&acc)[2][2][4][2], const pg8::Unit& u, int wr, int wc, int fr, int fq) const {
        const int row0 = u.pm * 256 + wr * 64 + fr, colb = u.pn * 256 + wc * 32 + 8 * fq;
#pragma unroll
        for (int ai = 0; ai < 2; ++ai)
#pragma unroll
            for (int m = 0; m < 4; ++m) {
                const int row = row0 + ai * 128 + m * 16;
                float ss = 0.f;
                if (row < MVALID) {
                    const float* xr = row < MPROMPT ? xp + (size_t)row * D_MODEL : xs + (size_t)(row - MPROMPT) * D_MODEL;
#pragma unroll
                    for (int bj = 0; bj < 2; ++bj) {
                        const int col = colb + bj * 128;
                        f32x4 h0 = *(const f32x4*)(xr + col) + acc[ai][bj][m][0], h1 = *(const f32x4*)(xr + col + 4) + acc[ai][bj][m][1];
                        *(f32x4*)(out + (size_t)row * D_MODEL + col) = h0; *(f32x4*)(out + (size_t)row * D_MODEL + col + 4) = h1;
                        ss += (h0[0] * h0[0] + h0[1] * h0[1]) + (h0[2] * h0[2] + h0[3] * h0[3]) + (h1[0] * h1[0] + h1[1] * h1[1]) + (h1[2] * h1[2] + h1[3] * h1[3]);
                    }
                }
                ss += __shfl_xor(ss, 16); ss += __shfl_xor(ss, 32);
                if (fq == 0 && row < MVALID) atomicAdd(rowss + row, ss);
            }
    }
};

struct Params {
    const float* x_prompt; const float* x_sample; const float* cache_k; const float* cache_v; const float* cache_kidx; const float* state_ssm; const float* state_conv;
    const int* page_table; const float* norm_in; const float* w_in; const float* conv_w; const float* a_log; const float* dt_bias; const float* gdn_norm; const float* w_out;
    const float* rel_table; const float* norm_final; float* out; unsigned char* ws;
};

__device__ __forceinline__ int win_src_col(int n) {
    if (n < C_AG) return n;
    if (n < C_AG + 8) return n + 2048;
    if (n < C_QKV) return -1;
    return n - 176;
}
template <bool MAPPED>
__device__ __forceinline__ void transpose_item(const float* W, int K, int N, bf16_t* WT, float* scr, int item, int nblk, int lane) {
    const int kb = item / nblk, nb = item % nblk, k0 = 64 * kb, n0 = 32 * nb;
    const int nd = n0 + (lane & 31); const int src = MAPPED ? win_src_col(nd) : nd;
#pragma unroll 8
    for (int i = 0; i < 32; ++i) { const int kk = 2 * i + (lane >> 5); scr[kk * 33 + (lane & 31)] = src >= 0 ? W[(size_t)(k0 + kk) * N + src] : 0.f; }
    asm volatile("s_waitcnt lgkmcnt(0)" ::: "memory");
    const int c = lane & 7;
#pragma unroll
    for (int j = 0; j < 4; ++j) { const int n = (lane >> 3) + 8 * j; const float* s = scr + (8 * c) * 33 + n;
        u32x4 o; o.x = pk2(s[0 * 33], s[1 * 33]); o.y = pk2(s[2 * 33], s[3 * 33]); o.z = pk2(s[4 * 33], s[5 * 33]); o.w = pk2(s[6 * 33], s[7 * 33]);
        *(u32x4*)(WT + (size_t)(n0 + n) * K + k0 + 8 * c) = o; }
    asm volatile("s_waitcnt lgkmcnt(0)" ::: "memory");
}
__global__ void __launch_bounds__(256) k_prologue(Params p) {
    __shared__ float scr_all[4][64 * 33];
    const int tid = threadIdx.x, lane = tid & 63, wave = tid >> 6;
    const int gw = blockIdx.x * 4 + wave, NGW = gridDim.x * 4;
    bf16_t* WINT = (bf16_t*)(p.ws + WS_WINT); bf16_t* WOUTT = (bf16_t*)(p.ws + WS_WOUTT); bf16_t* XN = (bf16_t*)(p.ws + WS_XN);
    float* scr = scr_all[wave];
    constexpr int I_IN = (1024 / 64) * (NP / 32), I_OUT = (1024 / 64) * (1024 / 32);
    for (int it = gw; it < I_IN + I_OUT; it += NGW) {
        if (it < I_IN) transpose_item<true>(p.w_in, 1024, 4440, WINT, scr, it, NP / 32, lane);
        else transpose_item<false>(p.w_out, 1024, 1024, WOUTT, scr, it - I_IN, 1024 / 32, lane);
    }
    for (int m = gw; m < MP; m += NGW) {
        unsigned long long* o8 = (unsigned long long*)(XN + (size_t)m * D_MODEL) + lane;
        if (m >= MVALID) {
#pragma unroll
            for (int j = 0; j < 4; ++j) o8[64 * j] = 0ull;
            continue;
        }
        const float* xrow = m < MPROMPT ? p.x_prompt + (size_t)m * D_MODEL : p.x_sample + (size_t)(m - MPROMPT) * D_MODEL;
        const f32x4* xr = (const f32x4*)xrow + lane; const f32x4* gr = (const f32x4*)p.norm_in + lane;
        f32x4 v[4]; float s = 0.f;
#pragma unroll
        for (int j = 0; j < 4; ++j) { v[j] = xr[64 * j]; s += (v[j].x * v[j].x + v[j].y * v[j].y) + (v[j].z * v[j].z + v[j].w * v[j].w); }
        const float rs = rsqrtf(wave_sum(s) * (1.f / D_MODEL) + 1e-6f);
#pragma unroll
        for (int j = 0; j < 4; ++j) { const f32x4 g = gr[64 * j]; const f32x4 y = v[j] * rs * g;
            o8[64 * j] = (unsigned long long)pk2(y.x, y.y) | ((unsigned long long)pk2(y.z, y.w) << 32); }
    }
}

__global__ void __launch_bounds__(512, 2) k_gemm_in(Params p) {
    extern __shared__ __attribute__((aligned(16))) unsigned char lds[];
    pg8::Gemm g{(const bf16_t*)(p.ws + WS_XN), (const bf16_t*)(p.ws + WS_WINT), MP, NP, 1024};
    pg8::StaticOrder S; S.init(MP, NP, gridDim.x, blockIdx.x);
    EpiIn E{(bf16_t*)(p.ws + WS_PROJ), (float*)(p.ws + WS_AUX), p.out};
    pg8::gemm_phase<EpiIn, pg8::StaticOrder, true, true>((LAS unsigned char*)lds, g, S, E);
}
__global__ void __launch_bounds__(512, 2) k_gemm_out(Params p) {
    extern __shared__ __attribute__((aligned(16))) unsigned char lds[];
    pg8::Gemm g{(const bf16_t*)(p.ws + WS_MIXED), (const bf16_t*)(p.ws + WS_WOUTT), MP, 1024, 1024};
    pg8::StaticOrder S; S.init(MP, 1024, gridDim.x, blockIdx.x);
    EpiOut E{p.x_prompt, p.x_sample, p.out, (float*)(p.ws + WS_ROWSS)};
    pg8::gemm_phase<EpiOut, pg8::StaticOrder, true, true>((LAS unsigned char*)lds, g, S, E);
}
__global__ void __launch_bounds__(512) k_final_norm(Params p) {
    const int lane = threadIdx.x & 63, gw = blockIdx.x * 8 + (threadIdx.x >> 6), NGW = gridDim.x * 8;
    const float* rowss = (const float*)(p.ws + WS_ROWSS);
    for (int m = gw; m < MVALID; m += NGW) {
        const float rs = rsqrtf(rowss[m] * (1.f / D_MODEL) + 1e-6f);
        f32x4* yr = (f32x4*)(p.out + (size_t)m * D_MODEL) + lane; const f32x4* gr = (const f32x4*)p.norm_final + lane;
#pragma unroll
        for (int j = 0; j < 4; ++j) yr[64 * j] = yr[64 * j] * rs * gr[64 * j];
    }
}

__global__ void __launch_bounds__(256) k_idx_naive(Params p) {
    __shared__ float qs[4][1024];
    __shared__ float scl[4][64 * 33];
    __shared__ float wh[4][16];
    const int wave = threadIdx.x >> 6, lane = threadIdx.x & 63;
    const int r = blockIdx.x * 4 + wave, b = r >> 11, t = r & (SEQ - 1);
    const bf16_t* proj = (const bf16_t*)(p.ws + WS_PROJ); const float* aux = (const float*)(p.ws + WS_AUX); unsigned* mask = (unsigned*)(p.ws + WS_MASK);
    const bf16_t* qrow = proj + (size_t)r * NP + C_QI;
    for (int i = lane; i < 1024; i += 64) qs[wave][i] = bf2f(qrow[i]) * 0.125f;
    if (lane < 16) wh[wave][lane] = aux[(size_t)r * AUXP + lane] * 0.25f;
    __syncthreads();
    for (int j = 0; j < 32; ++j) {
        const int s = 32 * lane + j;
        float sc = -1e30f;
        if (s <= t) {
            const u32x4* krow = (const u32x4*)(proj + (size_t)(b * SEQ + s) * NP + C_KI);
            float kf[64];
#pragma unroll
            for (int c = 0; c < 8; ++c) unpack8(krow[c], kf + 8 * c);
            sc = 0.f;
            for (int h = 0; h < 16; ++h) {
                float dot = 0.f;
#pragma unroll
                for (int d = 0; d < 64; ++d) dot += qs[wave][h * 64 + d] * kf[d];
                sc += fmaxf(dot, 0.f) * wh[wave][h];
            }
        }
        scl[wave][lane * 33 + j] = sc;
    }
    __syncthreads();
    unsigned key[32];
#pragma unroll
    for (int j = 0; j < 32; ++j) key[j] = f2key(scl[wave][lane * 33 + j]);
    unsigned prefix = 0u;
    for (int bit = 31; bit >= 0; --bit) {
        const unsigned cand = prefix | (1u << bit);
        int c = 0;
#pragma unroll
        for (int j = 0; j < 32; ++j) c += (key[j] >= cand) ? 1 : 0;
        c = wave_sum_i(c);
        if (c >= 256) prefix = cand;
    }
    int cgt = 0, ceq = 0;
#pragma unroll
    for (int j = 0; j < 32; ++j) { cgt += (key[j] > prefix) ? 1 : 0; ceq += (key[j] == prefix) ? 1 : 0; }
    const int need = 256 - wave_sum_i(cgt);
    int run = wave_excl_scan_i(ceq, lane);
    unsigned word = 0u;
#pragma unroll
    for (int j = 0; j < 32; ++j) {
        if (key[j] > prefix) word |= (1u << j);
        else if (key[j] == prefix) { if (run < need) word |= (1u << j); ++run; }
    }
    const int nv = t + 1 - 32 * lane;
    const unsigned vm = nv >= 32 ? 0xffffffffu : (nv <= 0 ? 0u : ((1u << nv) - 1u));
    mask[(size_t)r * 64 + lane] = word & vm;
}

__global__ void __launch_bounds__(256) k_attn_naive(Params p) {
    __shared__ float qs[4][512];
    __shared__ int lst[4][256];
    __shared__ float pl[4][8 * 256];
    __shared__ float bd[128 * 8];
    const int wave = threadIdx.x >> 6, lane = threadIdx.x & 63;
    const int r = blockIdx.x * 4 + wave, b = r >> 11, t = r & (SEQ - 1);
    const bf16_t* proj = (const bf16_t*)(p.ws + WS_PROJ); const unsigned* mask = (const unsigned*)(p.ws + WS_MASK); bf16_t* mixed = (bf16_t*)(p.ws + WS_MIXED);
    for (int i = threadIdx.x; i < 1024; i += 256) bd[i] = p.rel_table[(int)c_bucket[i >> 3] * 8 + (i & 7)];
    const bf16_t* qrow = proj + (size_t)r * NP + C_Q;
    for (int i = lane; i < 512; i += 64) qs[wave][i] = bf2f(qrow[i]) * 0.125f;
    const unsigned word = mask[(size_t)r * 64 + lane];
    const int cnt = __popc(word);
    int pos = wave_excl_scan_i(cnt, lane);
    const int nsel = wave_sum_i(cnt);
    { unsigned w = word; while (w) { const int j = __ffs(w) - 1; lst[wave][pos++] = 32 * lane + j; w &= w - 1u; } }
    __syncthreads();
    for (int i = lane; i < nsel; i += 64) {
        const int s = lst[wave][i]; int dn = t - s; dn = dn > 127 ? 127 : dn;
        for (int g = 0; g < 2; ++g) {
            const u32x4* krow = (const u32x4*)(proj + (size_t)(b * SEQ + s) * NP + C_K + g * 64);
            float kf[64];
#pragma unroll
            for (int c = 0; c < 8; ++c) unpack8(krow[c], kf + 8 * c);
            for (int hh = 0; hh < 4; ++hh) {
                const int h = g * 4 + hh; float dot = 0.f;
#pragma unroll
                for (int d = 0; d < 64; ++d) dot += qs[wave][h * 64 + d] * kf[d];
                pl[wave][h * 256 + i] = dot + bd[dn * 8 + h];
            }
        }
    }
    __syncthreads();
    for (int h = 0; h < 8; ++h) {
        float m = -3.0e38f;
        for (int i = lane; i < nsel; i += 64) m = fmaxf(m, pl[wave][h * 256 + i]);
        m = wave_max(m);
        float sum = 0.f;
        for (int i = lane; i < nsel; i += 64) { const float e = __expf(pl[wave][h * 256 + i] - m); pl[wave][h * 256 + i] = e; sum += e; }
        const float inv = 1.f / wave_sum(sum);
        for (int i = lane; i < nsel; i += 64) pl[wave][h * 256 + i] *= inv;
    }
    __syncthreads();
#pragma unroll
    for (int g = 0; g < 2; ++g) {
        float acc[4] = {0.f, 0.f, 0.f, 0.f};
        for (int i = 0; i < nsel; ++i) {
            const int s = lst[wave][i];
            const float v = bf2f(proj[(size_t)(b * SEQ + s) * NP + C_V + g * 64 + lane]);
#pragma unroll
            for (int hh = 0; hh < 4; ++hh) acc[hh] += pl[wave][(g * 4 + hh) * 256 + i] * v;
        }
#pragma unroll
        for (int hh = 0; hh < 4; ++hh) {
            const int h = g * 4 + hh;
            const float z = bf2f(proj[(size_t)r * NP + C_ZA + h * 64 + lane]);
            mixed[(size_t)r * D_MODEL + h * 64 + lane] = (bf16_t)f2bf(acc[hh] * silu_f(z));
        }
    }
}

template <int MODE>
__global__ void __launch_bounds__(512) k_gdn_naive(Params p) {
    __shared__ float qkv_s[384];
    __shared__ float red[1024];
    __shared__ float sc[8];
    const int tid = threadIdx.x, lane = tid & 63, wave = tid >> 6;
    const int b = blockIdx.x >> 2, h = blockIdx.x & 3;
    const int T = MODE ? 1 : SEQ; const int row0 = MODE ? MPROMPT + b : b * SEQ;
    const int e = tid & 127, sl = tid >> 7;
    const bf16_t* proj = (const bf16_t*)(p.ws + WS_PROJ); const float* aux = (const float*)(p.ws + WS_AUX); bf16_t* mixed = (bf16_t*)(p.ws + WS_MIXED);
    float S[32];
#pragma unroll
    for (int i = 0; i < 32; ++i) S[i] = MODE ? p.state_ssm[((size_t)(b * 4 + h) * 128 + sl * 32 + i) * 128 + e] : 0.f;
    const int part = tid >> 7, ci = tid & 127, c = part * 512 + h * 128 + ci;
    float w0 = 0.f, w1 = 0.f, w2 = 0.f, w3 = 0.f, x0 = 0.f, x1 = 0.f, x2 = 0.f;
    if (tid < 384) {
        w0 = p.conv_w[0 * 1536 + c]; w1 = p.conv_w[1 * 1536 + c]; w2 = p.conv_w[2 * 1536 + c]; w3 = p.conv_w[3 * 1536 + c];
        if (MODE) { x0 = p.state_conv[((size_t)b * 3 + 0) * 1536 + c]; x1 = p.state_conv[((size_t)b * 3 + 1) * 1536 + c]; x2 = p.state_conv[((size_t)b * 3 + 2) * 1536 + c]; }
    }
    const float A = __expf(p.a_log[h]), dtb = p.dt_bias[h], gn = p.gdn_norm[e];
    for (int t = 0; t < T; ++t) {
        const size_t r = (size_t)(row0 + t);
        if (tid < 384) {
            float x3;
            if (MODE) x3 = p.out[O_CS + ((size_t)b * 3 + 2) * 1536 + c];
            else x3 = bf2f(proj[r * NP + C_QKV + c]);
            const float y = x0 * w0 + x1 * w1 + x2 * w2 + x3 * w3;
            x0 = x1; x1 = x2; x2 = x3;
            qkv_s[tid] = silu_f(y);
        }
        __syncthreads();
        if (wave == 0) { const float a = qkv_s[lane], a2 = qkv_s[lane + 64]; const float s = wave_sum(a * a + a2 * a2); if (lane == 0) sc[0] = s; }
        else if (wave == 1) { const float a = qkv_s[128 + lane], a2 = qkv_s[192 + lane]; const float s = wave_sum(a * a + a2 * a2); if (lane == 0) sc[1] = s; }
        else if (wave == 2) { const float s = wave_sum(qkv_s[lane] * qkv_s[128 + lane] + qkv_s[lane + 64] * qkv_s[192 + lane]); if (lane == 0) sc[2] = s; }
        __syncthreads();
        const float qn = rsqrtf(sc[0] + 1e-6f) * 0.08838834764831845f, kn = rsqrtf(sc[1] + 1e-6f), qk = sc[2] * qn * kn;
        const float ag = aux[r * AUXP + 16 + h], bg = aux[r * AUXP + 20 + h];
        const float xg = ag + dtb;
        const float sp = xg > 20.f ? xg : log1pf(__expf(xg));
        const float dec = __expf(-A * sp), beta = 1.f / (1.f + __expf(-bg));
        float pk = 0.f, pq = 0.f;
#pragma unroll
        for (int i = 0; i < 32; ++i) { const int d = sl * 32 + i; S[i] *= dec; pk += qkv_s[128 + d] * S[i]; pq += qkv_s[d] * S[i]; }
        red[sl * 128 + e] = pk * kn; red[512 + sl * 128 + e] = pq * qn;
        __syncthreads();
        const float kv = (red[e] + red[128 + e]) + (red[256 + e] + red[384 + e]);
        const float qS = (red[512 + e] + red[640 + e]) + (red[768 + e] + red[896 + e]);
        const float delta = (qkv_s[256 + e] - kv) * beta;
        const float o = qS + qk * delta;
#pragma unroll
        for (int i = 0; i < 32; ++i) { const int d = sl * 32 + i; S[i] += qkv_s[128 + d] * kn * delta; }
        if (sl == 0) { const float s = wave_sum(o * o); if (lane == 0) sc[4 + wave] = s; }
        __syncthreads();
        if (sl == 0) {
            const float rs = rsqrtf((sc[4] + sc[5]) * (1.f / 128.f) + 1e-6f);
            const float z = bf2f(proj[r * NP + C_ZG + h * 128 + e]);
            mixed[r * D_MODEL + 512 + h * 128 + e] = (bf16_t)f2bf(o * rs * gn * silu_f(z));
        }
    }
    float* So = p.out + (MODE ? O_SSMS : O_SSMP);
#pragma unroll
    for (int i = 0; i < 32; ++i) So[((size_t)(b * 4 + h) * 128 + sl * 32 + i) * 128 + e] = S[i];
}

__global__ void __launch_bounds__(512) k_sample_naive(Params p) {
    __shared__ float scs[8704];
    __shared__ float qs[1024];
    __shared__ float wh[16];
    __shared__ int lst[256];
    __shared__ int eql[64];
    __shared__ int cnts[16];
    __shared__ float pl[8 * 256];
    __shared__ float qa[512];
    const int tid = threadIdx.x, lane = tid & 63, wave = tid >> 6, b = blockIdx.x;
    const size_t r = (size_t)MPROMPT + b;
    const bf16_t* proj = (const bf16_t*)(p.ws + WS_PROJ); const float* aux = (const float*)(p.ws + WS_AUX); bf16_t* mixed = (bf16_t*)(p.ws + WS_MIXED);
    for (int i = tid; i < 1024; i += 512) qs[i] = bf2f(proj[r * NP + C_QI + i]) * 0.125f;
    if (tid < 512) qa[tid] = bf2f(proj[r * NP + C_Q + tid]) * 0.125f;
    if (tid < 16) wh[tid] = aux[r * AUXP + tid] * 0.25f;
    if (tid < 16) cnts[tid] = 0;
    for (int i = tid; i < 2 * 1536; i += 512) p.out[O_CS + (size_t)b * 3 * 1536 + i] = p.state_conv[(size_t)b * 3 * 1536 + 1536 + i];
    __syncthreads();
    for (int i = 0; i < 17; ++i) {
        const int s = tid + 512 * i;
        float sc = -3.0e38f;
        if (s <= PAST) {
            const float* krow = s < PAST ? p.cache_kidx + ((size_t)p.page_table[b * NPAGES + (s >> 7)] * PAGE + (s & 127)) * 64 : p.out + O_KIS + (size_t)b * 64;
            float kf[64];
#pragma unroll
            for (int c = 0; c < 16; ++c) { const f32x4 v = ((const f32x4*)krow)[c]; kf[4 * c] = v.x; kf[4 * c + 1] = v.y; kf[4 * c + 2] = v.z; kf[4 * c + 3] = v.w; }
            sc = 0.f;
            for (int h = 0; h < 16; ++h) {
                float dot = 0.f;
#pragma unroll
                for (int d = 0; d < 64; ++d) dot += qs[h * 64 + d] * kf[d];
                sc += fmaxf(dot, 0.f) * wh[h];
            }
        }
        scs[s] = sc;
    }
    __syncthreads();
    unsigned key[17];
#pragma unroll
    for (int i = 0; i < 17; ++i) { const int s = tid + 512 * i; key[i] = s <= PAST ? f2key(scs[s]) : 0u; }
    unsigned prefix = 0u;
    for (int bit = 31; bit >= 0; --bit) {
        const unsigned cand = prefix | (1u << bit);
        int c = 0;
#pragma unroll
        for (int i = 0; i < 17; ++i) c += (key[i] >= cand) ? 1 : 0;
        c = wave_sum_i(c);
        if (lane == 0) cnts[8 + wave] = c;
        __syncthreads();
        int tot = 0;
#pragma unroll
        for (int w = 0; w < 8; ++w) tot += cnts[8 + w];
        __syncthreads();
        if (tot >= 256) prefix = cand;
    }
#pragma unroll
    for (int i = 0; i < 17; ++i) {
        const int s = tid + 512 * i;
        if (key[i] > prefix) { const int pos = atomicAdd(&cnts[0], 1); if (pos < 256) lst[pos] = s; }
        else if (key[i] == prefix && s <= PAST) { const int pos = atomicAdd(&cnts[1], 1); if (pos < 64) eql[pos] = s; }
    }
    __syncthreads();
    const int ngt = cnts[0], neq = cnts[1] < 64 ? cnts[1] : 64, need = 256 - ngt;
    __syncthreads();
    if (tid < neq) {
        const int s = eql[tid]; int rank = 0;
        for (int j = 0; j < neq; ++j) rank += (eql[j] < s) ? 1 : 0;
        if (rank < need) { const int pos = atomicAdd(&cnts[0], 1); if (pos < 256) lst[pos] = s; }
    }
    __syncthreads();
    {
        const int i = tid & 255, g = tid >> 8;
        const int s = lst[i]; int dn = PAST - s; dn = dn > 127 ? 127 : dn;
        const float* krow = s < PAST ? p.cache_k + (((size_t)p.page_table[b * NPAGES + (s >> 7)] * PAGE + (s & 127)) * 2 + g) * 64 : p.out + O_KS + (size_t)b * 128 + g * 64;
        float kf[64];
#pragma unroll
        for (int c = 0; c < 16; ++c) { const f32x4 v = ((const f32x4*)krow)[c]; kf[4 * c] = v.x; kf[4 * c + 1] = v.y; kf[4 * c + 2] = v.z; kf[4 * c + 3] = v.w; }
        for (int hh = 0; hh < 4; ++hh) {
            const int h = g * 4 + hh; float dot = 0.f;
#pragma unroll
            for (int d = 0; d < 64; ++d) dot += qa[h * 64 + d] * kf[d];
            pl[h * 256 + i] = dot + p.rel_table[(int)c_bucket[dn] * 8 + h];
        }
    }
    __syncthreads();
    {
        const int h = wave;
        float v[4]; float m = -3.0e38f;
#pragma unroll
        for (int j = 0; j < 4; ++j) { v[j] = pl[h * 256 + lane + 64 * j]; m = fmaxf(m, v[j]); }
        m = wave_max(m);
        float sum = 0.f;
#pragma unroll
        for (int j = 0; j < 4; ++j) { v[j] = __expf(v[j] - m); sum += v[j]; }
        const float inv = 1.f / wave_sum(sum);
#pragma unroll
        for (int j = 0; j < 4; ++j) pl[h * 256 + lane + 64 * j] = v[j] * inv;
    }
    __syncthreads();
    {
        const int d = tid & 63, h = tid >> 6, g = h >> 2;
        float acc = 0.f;
        for (int i = 0; i < 256; ++i) {
            const int s = lst[i];
            const float* vrow = s < PAST ? p.cache_v + (((size_t)p.page_table[b * NPAGES + (s >> 7)] * PAGE + (s & 127)) * 2 + g) * 64 : p.out + O_VS + (size_t)b * 128 + g * 64;
            acc += pl[h * 256 + i] * vrow[d];
        }
        const float z = bf2f(proj[r * NP + C_ZA + h * 64 + d]);
        mixed[r * D_MODEL + h * 64 + d] = (bf16_t)f2bf(acc * silu_f(z));
    }
}

extern "C" void kernel_launch(void* const* d_in, const int* in_sizes, int n_in, void* d_out, int out_size, void* d_ws, size_t ws_size, hipStream_t stream) {
    static int ok = 0;
    if (ok == 0) {
        if (n_in != 17 || (size_t)out_size != O_END || ws_size < WS_END) { fprintf(stderr, "kernel_launch: unexpected shapes n_in %d out %d ws %zu\n", n_in, out_size, ws_size); ok = -1; return; }
        if (hipFuncSetAttribute((const void*)k_gemm_in, hipFuncAttributeMaxDynamicSharedMemorySize, pg8::STAGE_BYTES) != hipSuccess ||
            hipFuncSetAttribute((const void*)k_gemm_out, hipFuncAttributeMaxDynamicSharedMemorySize, pg8::STAGE_BYTES) != hipSuccess) { fprintf(stderr, "kernel_launch: hipFuncSetAttribute failed\n"); ok = -1; return; }
        ok = 1;
    }
    if (ok < 0) return;
    Params p{};
    p.x_prompt = (const float*)d_in[0]; p.x_sample = (const float*)d_in[1]; p.cache_k = (const float*)d_in[2]; p.cache_v = (const float*)d_in[3]; p.cache_kidx = (const float*)d_in[4];
    p.state_ssm = (const float*)d_in[5]; p.state_conv = (const float*)d_in[6]; p.page_table = (const int*)d_in[7]; p.norm_in = (const float*)d_in[8]; p.w_in = (const float*)d_in[9];
    p.conv_w = (const float*)d_in[10]; p.a_log = (const float*)d_in[11]; p.dt_bias = (const float*)d_in[12]; p.gdn_norm = (const float*)d_in[13]; p.w_out = (const float*)d_in[14];
    p.rel_table = (const float*)d_in[15]; p.norm_final = (const float*)d_in[16]; p.out = (float*)d_out; p.ws = (unsigned char*)d_ws;
    (void)hipMemsetAsync((char*)d_ws + WS_CTL, 0, CTL_BYTES, stream);
    hipLaunchKernelGGL(k_prologue, dim3(1024), dim3(256), 0, stream, p);
    hipLaunchKernelGGL(k_gemm_in, dim3(256), dim3(512), pg8::STAGE_BYTES, stream, p);
    hipLaunchKernelGGL(k_idx_naive, dim3(MPROMPT / 4), dim3(256), 0, stream, p);
    hipLaunchKernelGGL(k_attn_naive, dim3(MPROMPT / 4), dim3(256), 0, stream, p);
    hipLaunchKernelGGL(k_gdn_naive<0>, dim3(BATCH * 4), dim3(512), 0, stream, p);
    hipLaunchKernelGGL(k_sample_naive, dim3(DEC_BATCH), dim3(512), 0, stream, p);
    hipLaunchKernelGGL(k_gdn_naive<1>, dim3(DEC_BATCH * 4), dim3(512), 0, stream, p);
    hipLaunchKernelGGL(k_gemm_out, dim3(256), dim3(512), pg8::STAGE_BYTES, stream, p);
    hipLaunchKernelGGL(k_final_norm, dim3(256), dim3(512), 0, stream, p);
}
```

```cpp
#include <hip/hip_runtime.h>
#include <cstdio>
#include <cstdint>

#define LAS __attribute__((address_space(3)))
#define GAS __attribute__((address_space(1)))
typedef unsigned short bf16_t;
typedef short bf16x8 __attribute__((ext_vector_type(8)));
typedef float f32x4 __attribute__((ext_vector_type(4)));
typedef unsigned u32x4 __attribute__((ext_vector_type(4)));

constexpr int D_MODEL = 1024, BATCH = 32, SEQ = 2048, DEC_BATCH = 128, PAST = 8192, PAGE = 128, NPAGES = 64;
constexpr int MPROMPT = BATCH * SEQ;
constexpr int MVALID = MPROMPT + DEC_BATCH;
constexpr int MP = MPROMPT + 256;
constexpr int NP = 4608;
constexpr int C_Q = 0, C_K = 512, C_V = 640, C_ZA = 768, C_QI = 1280, C_KI = 2304, C_WI = 2368, C_AG = 2384, C_BG = 2388, C_QKV = 2560, C_ZG = 4096;
constexpr int AUXP = 32;
constexpr size_t O_YP = 0, O_YS = 67108864, O_KP = 67239936, O_VP = 75628544, O_KIP = 84017152, O_SSMP = 88211456, O_CP = 90308608,
                 O_KS = 90456064, O_VS = 90472448, O_KIS = 90488832, O_SSMS = 90497024, O_CS = 98885632, O_END = 99475456;
constexpr size_t MiB = 1u << 20;
constexpr size_t WS_CTL = 0, CTL_BYTES = 1 * MiB;
constexpr size_t WS_ROWSS = 512 * 1024;
constexpr size_t WS_WINT = 2 * MiB;
constexpr size_t WS_WOUTT = 12 * MiB;
constexpr size_t WS_XN = 16 * MiB;
constexpr size_t WS_PROJ = 146 * MiB;
constexpr size_t WS_AUX = 726 * MiB;
constexpr size_t WS_MIXED = 736 * MiB;
constexpr size_t WS_MASK = 866 * MiB;
constexpr size_t WS_END = 900 * MiB;

__constant__ unsigned char c_bucket[128] = {0, 1, 2, 3, 4, 5, 6, 7, 8, 9, 10, 11, 12, 13, 14, 15, 16, 16, 16, 17, 17, 18, 18, 18, 19, 19, 19, 20, 20, 20, 20, 21, 21, 21, 21, 22, 22, 22, 22, 22, 23, 23, 23, 23, 23, 23, 24, 24, 24, 24, 24, 24, 25, 25, 25, 25, 25, 25, 25, 26, 26, 26, 26, 26, 26, 26, 26, 27, 27, 27, 27, 27, 27, 27, 27, 27, 27, 28, 28, 28, 28, 28, 28, 28, 28, 28, 28, 29, 29, 29, 29, 29, 29, 29, 29, 29, 29, 29, 29, 30, 30, 30, 30, 30, 30, 30, 30, 30, 30, 30, 30, 30, 30, 31, 31, 31, 31, 31, 31, 31, 31, 31, 31, 31, 31, 31, 31, 31};

__device__ __forceinline__ float bf2f(unsigned short b) { return __builtin_bit_cast(float, (unsigned)b << 16); }
__device__ __forceinline__ unsigned f2bf(float f) { unsigned u = __builtin_bit_cast(unsigned, f); return (u + 0x7fffu + ((u >> 16) & 1u)) >> 16; }
__device__ __forceinline__ unsigned pk2(float lo, float hi) { return f2bf(lo) | (f2bf(hi) << 16); }
__device__ __forceinline__ float wave_sum(float v) {
#pragma unroll
    for (int o = 1; o < 64; o <<= 1) v += __shfl_xor(v, o);
    return v;
}
__device__ __forceinline__ int wave_sum_i(int v) {
#pragma unroll
    for (int o = 1; o < 64; o <<= 1) v += __shfl_xor(v, o);
    return v;
}
__device__ __forceinline__ float wave_max(float v) {
#pragma unroll
    for (int o = 1; o < 64; o <<= 1) v = fmaxf(v, __shfl_xor(v, o));
    return v;
}
__device__ __forceinline__ int wave_excl_scan_i(int v, int lane) {
    int x = v;
#pragma unroll
    for (int o = 1; o < 64; o <<= 1) { int y = __shfl_up(x, o); if (lane >= o) x += y; }
    return x - v;
}
__device__ __forceinline__ unsigned f2key(float f) { unsigned u = __builtin_bit_cast(unsigned, f); return (u & 0x80000000u) ? ~u : (u | 0x80000000u); }
__device__ __forceinline__ float silu_f(float z) { return z / (1.f + __expf(-z)); }
__device__ __forceinline__ void unpack8(const u32x4 w, float* f) {
    f[0] = __builtin_bit_cast(float, w.x << 16); f[1] = __builtin_bit_cast(float, w.x & 0xffff0000u);
    f[2] = __builtin_bit_cast(float, w.y << 16); f[3] = __builtin_bit_cast(float, w.y & 0xffff0000u);
    f[4] = __builtin_bit_cast(float, w.z << 16); f[5] = __builtin_bit_cast(float, w.z & 0xffff0000u);
    f[6] = __builtin_bit_cast(float, w.w << 16); f[7] = __builtin_bit_cast(float, w.w & 0xffff0000u);
}

namespace pg8 {
#define PG8_LAS __attribute__((address_space(3)))
constexpr int BM = 256, BK = 64, HALF = 128, HTB = HALF * BK * 2, STAGE_BYTES = 8 * HTB, NXCD = 8, WGM = 8;
__host__ __device__ __forceinline__ int lds_byte(int r, int c) { const int st = (r >> 4) * 2 + (c >> 5), rr = r & 15, cc = c & 31, ob = rr * 64 + cc * 2; return st * 1024 + (ob ^ (((ob >> 9) & 1) << 5)); }
__host__ __device__ __forceinline__ void stage_rc(int b, int& R, int& C) { const int st = b / 1024, sb = b % 1024, swz = sb ^ (((sb >> 9) & 1) << 5); R = (st >> 1) * 16 + swz / 64; C = (st & 1) * 32 + (swz % 64) / 2; }
__host__ __device__ __forceinline__ int perm32(int rho) { const int n = rho >> 4, i = rho & 15; return 8 * (i >> 2) + 4 * n + (i & 3); }
struct Unit { int pm, pn; };
struct Gemm { const bf16_t* A; const bf16_t* Bt; int M, N, K; };
struct StaticOrder {
    int nM, nN, nwg, G, c;
    __host__ __device__ void init(int M, int N, int G_, int c_) { nM = M / BM; nN = N / BM; nwg = nM * nN; G = G_; c = c_; }
    __host__ __device__ bool next(int i, Unit& u) const {
        const long L = (long)i * G + c; if (L >= nwg) return false;
        int wgid = (int)L; { const int q = nwg / NXCD, r = nwg % NXCD, xcd = wgid % NXCD, off = wgid / NXCD; wgid = (xcd < r ? xcd * (q + 1) : r * (q + 1) + (xcd - r) * q) + off; }
        const int nig = WGM * nN, gid = wgid / nig, fm = gid * WGM, gsz = (nM - fm) < WGM ? (nM - fm) : WGM;
        u.pm = fm + ((wgid % nig) % gsz); u.pn = (wgid % nig) / gsz; return true;
    }
    __device__ __forceinline__ void a_ready(const Unit&) const {}
    __device__ __forceinline__ void done(const Unit&) const {}
};
__device__ __forceinline__ unsigned cvt_pk_bf16(float lo, float hi) { unsigned r; asm volatile("v_cvt_pk_bf16_f32 %0, %1, %2" : "=v"(r) : "v"(lo), "v"(hi)); return r; }

template <class Epi, class Sched, bool ALIGN_EPI = false, bool SP2 = false>
__device__ __forceinline__ void gemm_phase(PG8_LAS unsigned char* lds, const Gemm g, const Sched& S, const Epi& E) {
    const int tid = threadIdx.x, wid = __builtin_amdgcn_readfirstlane(tid >> 6), lane = tid & 63, wr = wid >> 2, wc = wid & 3, fr = lane & 15, fq = lane >> 4;
    const int K = g.K, nt = K / BK;
    unsigned voffA[2], voffB[2];
#pragma unroll
    for (int i = 0; i < 2; ++i) { int R, C; stage_rc(tid * 16 + i * 8192, R, C); const int Rb = Epi::PERM ? ((R & ~31) + perm32(R & 31)) : R;
        voffA[i] = (unsigned)(R * K + C) * 2u; voffB[i] = (unsigned)(Rb * K + C) * 2u; }
    const size_t kstep = (size_t)(BK * 2);
    const size_t hstep = (size_t)HALF * K * 2;
    const size_t tstep = 2 * hstep;
    const unsigned ldsw = (unsigned)wid * 1024u;
    const int aoff = lds_byte(wr * 64 + fr, fq * 8), boff = lds_byte(wc * 32 + fr, fq * 8);
#define PG8_SA(b, h) (((b) * 2 + (h)) * HTB)
#define PG8_SB(b, h) ((4 + (b) * 2 + (h)) * HTB)
#define PG8_STAGE(bufoff, gbase, voff) do { _Pragma("unroll") for (int _i = 0; _i < 2; ++_i) \
        __builtin_amdgcn_global_load_lds((const unsigned*)((const char*)(gbase) + (voff)[_i]), (PG8_LAS unsigned*)(lds + (bufoff) + ldsw + _i * 8192), 16, 0, 0); } while (0)
#define PG8_LDA(dst, b, h) do { _Pragma("unroll") for (int m = 0; m < 4; ++m) _Pragma("unroll") for (int k = 0; k < 2; ++k) dst[m][k] = *(const PG8_LAS bf16x8*)(lds + PG8_SA(b, h) + aoff + m * 2048 + k * 1024); } while (0)
#define PG8_LDB(dst, b, h) do { _Pragma("unroll") for (int n = 0; n < 2; ++n) _Pragma("unroll") for (int k = 0; k < 2; ++k) dst[n][k] = *(const PG8_LAS bf16x8*)(lds + PG8_SB(b, h) + boff + n * 2048 + k * 1024); } while (0)
#define PG8_MMA(ai, bj, At, Bt) do { __builtin_amdgcn_s_setprio(1); _Pragma("unroll") for (int m = 0; m < 4; ++m) _Pragma("unroll") for (int n = 0; n < 2; ++n) _Pragma("unroll") for (int k = 0; k < 2; ++k) \
        acc[ai][bj][m][n] = __builtin_amdgcn_mfma_f32_16x16x32_bf16(Bt[n][k], At[m][k], acc[ai][bj][m][n], 0, 0, 0); __builtin_amdgcn_s_setprio(0); } while (0)
#define PG8_WAIT_V(n) asm volatile("s_waitcnt vmcnt(" #n ")" ::: "memory")
#define PG8_WAIT_L(n) asm volatile("s_waitcnt lgkmcnt(" #n ")" ::: "memory")
#define PG8_BAR __builtin_amdgcn_s_barrier()
#define PG8_SCHED __builtin_amdgcn_sched_barrier(0)
    Unit cur, nxt; int ui = 0;
    if (!S.next(0, cur)) return;
    f32x4 acc[2][2][4][2];
#pragma unroll
    for (int a = 0; a < 2; ++a)
#pragma unroll
        for (int b = 0; b < 2; ++b)
#pragma unroll
            for (int m = 0; m < 4; ++m)
#pragma unroll
                for (int n = 0; n < 2; ++n) acc[a][b][m][n] = (f32x4){0.f, 0.f, 0.f, 0.f};
    bf16x8 At[4][2], B0[2][2], B1[2][2];
    const char* cA = (const char*)g.A + (size_t)cur.pm * tstep; const char* cB = (const char*)g.Bt + (size_t)cur.pn * tstep;
    S.a_ready(cur);
    if constexpr (SP2) {
        PG8_STAGE(PG8_SB(0, 0), cB, voffB); PG8_STAGE(PG8_SB(0, 1), cB + hstep, voffB); PG8_STAGE(PG8_SA(0, 0), cA, voffA); PG8_STAGE(PG8_SA(0, 1), cA + hstep, voffA);
        if (wr == 1) PG8_BAR;
        PG8_WAIT_V(2); PG8_BAR;
        PG8_STAGE(PG8_SB(1, 0), cB + kstep, voffB); PG8_STAGE(PG8_SA(1, 0), cA + kstep, voffA); PG8_STAGE(PG8_SB(1, 1), cB + hstep + kstep, voffB);
        PG8_WAIT_V(6); PG8_BAR;
    } else {
        PG8_STAGE(PG8_SB(0, 0), cB, voffB); PG8_STAGE(PG8_SA(0, 0), cA, voffA); PG8_STAGE(PG8_SB(0, 1), cB + hstep, voffB); PG8_STAGE(PG8_SA(0, 1), cA + hstep, voffA);
        if (wr == 1) PG8_BAR;
        PG8_WAIT_V(4); PG8_BAR;
        PG8_STAGE(PG8_SB(1, 0), cB + kstep, voffB); PG8_STAGE(PG8_SA(1, 0), cA + kstep, voffA); PG8_STAGE(PG8_SB(1, 1), cB + hstep + kstep, voffB);
        PG8_WAIT_V(6); PG8_BAR;
    }
    for (;;) {
        const bool has_next = S.next(ui + 1, nxt);
        const char* nA = has_next ? (const char*)g.A + (size_t)nxt.pm * tstep : cA; const char* nB = has_next ? (const char*)g.Bt + (size_t)nxt.pn * tstep : cB;
        for (int t = 0; t < nt; t += 2) {
            const bool last = (t == nt - 2);
            const char* a1 = cA + (size_t)(t + 1) * kstep;
            const char* a2 = last ? nA : cA + (size_t)(t + 2) * kstep; const char* b2 = last ? nB : cB + (size_t)(t + 2) * kstep;
            const char* a3 = a2 + kstep; const char* b3 = b2 + kstep;
            if (last && has_next) S.a_ready(nxt);
            if constexpr (SP2) {
            PG8_LDB(B0, 0, 0); PG8_LDB(B1, 0, 1); PG8_SCHED; PG8_LDA(At, 0, 0); PG8_STAGE(PG8_SA(1, 1), a1 + hstep, voffA);
            PG8_WAIT_V(8); PG8_WAIT_L(0); PG8_BAR; PG8_MMA(0, 0, At, B0); PG8_MMA(0, 1, At, B1); PG8_BAR; PG8_SCHED;
            PG8_LDA(At, 0, 1); PG8_STAGE(PG8_SB(0, 0), b2, voffB); PG8_STAGE(PG8_SB(0, 1), b2 + hstep, voffB); PG8_STAGE(PG8_SA(0, 0), a2, voffA);
            PG8_WAIT_V(8); PG8_WAIT_L(0); PG8_BAR; PG8_MMA(1, 0, At, B0); PG8_MMA(1, 1, At, B1); PG8_BAR; PG8_SCHED;
            PG8_LDB(B0, 1, 0); PG8_LDB(B1, 1, 1); PG8_SCHED; PG8_LDA(At, 1, 0); PG8_STAGE(PG8_SA(0, 1), a2 + hstep, voffA);
            PG8_WAIT_V(8); PG8_WAIT_L(0); PG8_BAR; PG8_MMA(0, 0, At, B0); PG8_MMA(0, 1, At, B1); PG8_BAR; PG8_SCHED;
            PG8_LDA(At, 1, 1); PG8_STAGE(PG8_SB(1, 0), b3, voffB); PG8_STAGE(PG8_SB(1, 1), b3 + hstep, voffB); PG8_STAGE(PG8_SA(1, 0), a3, voffA);
            PG8_WAIT_V(8); PG8_WAIT_L(0); PG8_BAR; PG8_MMA(1, 0, At, B0); PG8_MMA(1, 1, At, B1); PG8_BAR; PG8_SCHED;
            } else {
            PG8_LDB(B0, 0, 0); PG8_SCHED; PG8_LDA(At, 0, 0); PG8_STAGE(PG8_SA(1, 1), a1 + hstep, voffA);
            PG8_WAIT_L(8); PG8_BAR; PG8_WAIT_L(0); PG8_MMA(0, 0, At, B0); PG8_BAR; PG8_SCHED;
            PG8_LDB(B1, 0, 1); PG8_STAGE(PG8_SB(0, 0), b2, voffB);
            PG8_BAR; PG8_WAIT_L(0); PG8_MMA(0, 1, At, B1); PG8_BAR;
            PG8_LDA(At, 0, 1); PG8_STAGE(PG8_SA(0, 0), a2, voffA);
            PG8_BAR; PG8_WAIT_L(0); PG8_MMA(1, 0, At, B0); PG8_BAR; PG8_SCHED;
            PG8_STAGE(PG8_SB(0, 1), b2 + hstep, voffB);
            PG8_WAIT_V(6); PG8_BAR; PG8_MMA(1, 1, At, B1); PG8_BAR;
            PG8_LDB(B0, 1, 0); PG8_SCHED; PG8_LDA(At, 1, 0); PG8_STAGE(PG8_SA(0, 1), a2 + hstep, voffA);
            PG8_WAIT_L(8); PG8_BAR; PG8_WAIT_L(0); PG8_MMA(0, 0, At, B0); PG8_BAR; PG8_SCHED;
            PG8_LDB(B1, 1, 1); PG8_STAGE(PG8_SB(1, 0), b3, voffB);
            PG8_BAR; PG8_WAIT_L(0); PG8_MMA(0, 1, At, B1); PG8_BAR;
            PG8_LDA(At, 1, 1); PG8_STAGE(PG8_SA(1, 0), a3, voffA);
            PG8_BAR; PG8_WAIT_L(0); PG8_MMA(1, 0, At, B0); PG8_BAR; PG8_SCHED;
            PG8_STAGE(PG8_SB(1, 1), b3 + hstep, voffB);
            PG8_WAIT_V(6); PG8_BAR; PG8_MMA(1, 1, At, B1); PG8_BAR;
            }
        }
        if constexpr (ALIGN_EPI) { if (wr == 0) PG8_BAR; }
        if constexpr (!Epi::AFTER_DRAIN) { E(acc, cur, wr, wc, fr, fq); S.done(cur); }
        if (!has_next) break;
#pragma unroll
        for (int a = 0; a < 2; ++a)
#pragma unroll
            for (int b = 0; b < 2; ++b)
#pragma unroll
                for (int m = 0; m < 4; ++m)
#pragma unroll
                    for (int n = 0; n < 2; ++n) acc[a][b][m][n] = (f32x4){0.f, 0.f, 0.f, 0.f};
        cur = nxt; cA = nA; cB = nB; ++ui;
        if constexpr (ALIGN_EPI) { if (wr == 1) PG8_BAR; }
    }
    PG8_WAIT_V(0);
    if constexpr (!ALIGN_EPI) { if (wr == 0) PG8_BAR; }
    PG8_BAR;
#undef PG8_SA
#undef PG8_SB
#undef PG8_STAGE
#undef PG8_LDA
#undef PG8_LDB
#undef PG8_MMA
#undef PG8_WAIT_V
#undef PG8_WAIT_L
#undef PG8_BAR
#undef PG8_SCHED
}
}

struct EpiIn {
    static constexpr bool PERM = true, AFTER_DRAIN = false;
    bf16_t* proj; float* aux; float* out;
    __device__ __forceinline__ void operator()(const f32x4 (&acc)[2][2][4][2], const pg8::Unit& u, int wr, int wc, int fr, int fq) const {
        const int row0 = u.pm * 256 + wr * 64 + fr, colb = u.pn * 256 + wc * 32 + 8 * fq, pn = u.pn;
#pragma unroll
        for (int ai = 0; ai < 2; ++ai)
#pragma unroll
            for (int m = 0; m < 4; ++m) {
                const int row = row0 + ai * 128 + m * 16;
#pragma unroll
                for (int bj = 0; bj < 2; ++bj) {
                    const int col = colb + bj * 128;
                    const f32x4 v0 = acc[ai][bj][m][0], v1 = acc[ai][bj][m][1];
                    u32x4 w; w.x = pg8::cvt_pk_bf16(v0[0], v0[1]); w.y = pg8::cvt_pk_bf16(v0[2], v0[3]); w.z = pg8::cvt_pk_bf16(v1[0], v1[1]); w.w = pg8::cvt_pk_bf16(v1[2], v1[3]);
                    *(u32x4*)(proj + (size_t)row * NP + col) = w;
                    float* dst = nullptr;
                    if (pn == 2) {
                        const int c = col - C_K; const int isv = c >= 128; const int cc = c & 127;
                        if (row < MPROMPT) dst = out + (isv ? O_VP : O_KP) + (size_t)row * 128 + cc;
                        else if (row < MVALID) dst = out + (isv ? O_VS : O_KS) + (size_t)(row - MPROMPT) * 128 + cc;
                    } else if (pn == 9) {
                        const int c = col - C_KI;
                        if (c < 64) {
                            if (row < MPROMPT) dst = out + O_KIP + (size_t)row * 64 + c;
                            else if (row < MVALID) dst = out + O_KIS + (size_t)(row - MPROMPT) * 64 + c;
                        } else if (c < 88) dst = aux + (size_t)row * AUXP + (c - 64);
                    } else if (pn >= 10 && pn <= 15) {
                        const int c = col - C_QKV;
                        if (row < MPROMPT) { const int t = row & (SEQ - 1); if (t >= SEQ - 3) dst = out + O_CP + ((size_t)(row >> 11) * 3 + (t - (SEQ - 3))) * 1536 + c; }
                        else if (row < MVALID) dst = out + O_CS + ((size_t)(row - MPROMPT) * 3 + 2) * 1536 + c;
                    }
                    if (dst) { *(f32x4*)dst = v0; *(f32x4*)(dst + 4) = v1; }
                }
            }
    }
};
struct EpiOut {
    static constexpr bool PERM = true, AFTER_DRAIN = false;
    const float* xp; const float* xs; float* out; float* rowss;
    __device__ __forceinline__ void operator()(const f32x4 (&acc)[2][2][4][2], const pg8::Unit& u, int wr, int wc, int fr, int fq) const {
        const int row0 = u.pm * 256 + wr * 64 + fr, colb = u.pn * 256 + wc * 32 + 8 * fq;
#pragma unroll
        for (int ai = 0; ai < 2; ++ai)
#pragma unroll
            for (int m = 0; m < 4; ++m) {
                const int row = row0 + ai * 128 + m * 16;
                float ss = 0.f;
                if (row < MVALID) {
                    const float* xr = row < MPROMPT ? xp + (size_t)row * D_MODEL : xs + (size_t)(row - MPROMPT) * D_MODEL;
#pragma unroll
                    for (int bj = 0; bj < 2; ++bj) {
                        const int col = colb + bj * 128;
                        f32x4 h0 = *(const f32x4*)(xr + col) + acc[ai][bj][m][0], h1 = *(const f32x4*)(xr + col + 4) + acc[ai][bj][m][1];
                        *(f32x4*)(out + (size_t)row * D_MODEL + col) = h0; *(f32x4*)(out + (size_t)row * D_MODEL + col + 4) = h1;
                        ss += (h0[0] * h0[0] + h0[1] * h0[1]) + (h0[2] * h0[2] + h0[3] * h0[3]) + (h1[0] * h1[0] + h1[1] * h1[1]) + (h1[2] * h1[2] + h1[3] * h1[3]);
                    }
                }
                ss += __shfl_xor(ss, 16); ss += __shfl_xor(ss, 32);
                if (fq == 0 && row < MVALID) atomicAdd(rowss + row, ss);
            }
    }
};

struct Params {
    const float* x_prompt; const float* x_sample; const float* cache_k; const float* cache_v; const float* cache_kidx; const float* state_ssm; const float* state_conv;
    const int* page_table; const float* norm_in; const float* w_in; const float* conv_w; const float* a_log; const float* dt_bias; const float* gdn_norm; const float* w_out;
    const float* rel_table; const float* norm_final; float* out; unsigned char* ws;
};

constexpr int NWAVES = 8, NTHR = 512;
constexpr int SCR_BYTES = 131072;
constexpr int MISC_OFF = SCR_BYTES + 320;
constexpr int LDS_BYTES = 147456;
constexpr int CW_BAR = 4096;
typedef GAS unsigned gu32;
#define RLX_AGENT __ATOMIC_RELAXED, __HIP_MEMORY_SCOPE_AGENT
#define LDS_WAIT() asm volatile("s_waitcnt lgkmcnt(0)" ::: "memory")

#define XB_TMO      128
#define XB_XCNT(j)  (256  + 64 * (j))
#define XB_XSUB(j)  (1280 + 64 * (j))
#define XB_XGEN(j)  (2304 + 64 * (j))
#define XB_TOP      3328
#define XB_TOPGEN   3392
#define XCD_BAR_WORDS 3456
#define XB_SPIN_CAP (1u << 22)
__device__ __forceinline__ unsigned xb_ld(unsigned* p)              { return __hip_atomic_load(p, __ATOMIC_RELAXED, __HIP_MEMORY_SCOPE_AGENT); }
__device__ __forceinline__ unsigned xb_add(unsigned* p, unsigned v) { return __hip_atomic_fetch_add(p, v, __ATOMIC_RELAXED, __HIP_MEMORY_SCOPE_AGENT); }
__device__ __forceinline__ unsigned xb_xcc_id() { return (unsigned)__builtin_amdgcn_s_getreg((3 << 11) | 20) & 0xFu; }
#define XB_SPIN(cond, bar) do { unsigned _sp = 0; while (cond) { __builtin_amdgcn_s_sleep(1); \
    if ((++_sp & 255u) == 0u) { if (xb_ld(&(bar)[XB_TMO])) break; if (_sp > XB_SPIN_CAP) { atomicAdd(&(bar)[XB_TMO], 1u); break; } } } } while (0)
struct XcdBarrier { unsigned* bar; unsigned x; volatile LAS unsigned* st; };
__device__ __forceinline__ XcdBarrier xcd_barrier_post(unsigned* bar, volatile LAS unsigned* st) {
    XcdBarrier b; b.bar = bar; b.x = xb_xcc_id(); b.st = st;
    if (threadIdx.x == 0) (void)xb_add(&bar[XB_XCNT(b.x)], 1u);
    return b;
}
__device__ __forceinline__ void xcd_barrier_complete(unsigned* bar, unsigned x, unsigned& nloc, unsigned& nx) {
    const unsigned G = gridDim.x * gridDim.y * gridDim.z;
    unsigned sum, cnt, mine, sp = 0u;
    for (;;) {
        sum = 0u; cnt = 0u; mine = 0u;
#pragma unroll
        for (unsigned j = 0; j < 16; ++j) { const unsigned c = xb_ld(&bar[XB_XCNT(j)]); sum += c; cnt += (c > 0u) ? 1u : 0u; mine = (j == x) ? c : mine; }
        if (sum == G) break;
        __builtin_amdgcn_s_sleep(1);
        if ((++sp & 255u) == 0u) { if (xb_ld(&bar[XB_TMO])) break; if (sp > XB_SPIN_CAP) { atomicAdd(&bar[XB_TMO], 1u); break; } }
    }
    nloc = mine > 0u ? mine : 1u; nx = cnt > 0u ? cnt : 1u;
}
__device__ __forceinline__ void xcd_barrier(const XcdBarrier& b) {
    asm volatile("s_waitcnt vmcnt(0)" ::: "memory");
    __syncthreads();
    if (threadIdx.x == 0) {
        unsigned* bar = b.bar;
        __builtin_amdgcn_s_waitcnt(0);
        unsigned nloc = b.st[0], nx = b.st[1];
        if (nloc == 0u) { xcd_barrier_complete(bar, b.x, nloc, nx); b.st[0] = nloc; b.st[1] = nx; }
        const unsigned old = xb_add(&bar[XB_XSUB(b.x)], 1u);
        const unsigned gen = old / nloc;
        if (old + 1u == (gen + 1u) * nloc) {
            __builtin_amdgcn_fence(__ATOMIC_RELEASE, "agent");
            asm volatile("s_waitcnt vmcnt(0)" ::: "memory");
            const unsigned og = xb_add(&bar[XB_TOP], 1u);
            const unsigned tg = og / nx;
            if (og + 1u == (tg + 1u) * nx) xb_add(&bar[XB_TOPGEN], 1u);
            else XB_SPIN(xb_ld(&bar[XB_TOPGEN]) == tg, bar);
            __builtin_amdgcn_fence(__ATOMIC_ACQUIRE, "agent");
            xb_add(&bar[XB_XGEN(b.x)], 1u);
            asm volatile("s_waitcnt vmcnt(0)" ::: "memory");
        } else {
            XB_SPIN(xb_ld(&bar[XB_XGEN(b.x)]) == gen, bar);
            __builtin_amdgcn_fence(__ATOMIC_ACQUIRE, "agent");
            asm volatile("s_waitcnt vmcnt(0)" ::: "memory");
        }
    }
    __syncthreads();
}

__device__ __forceinline__ int win_src_col(int n) {
    if (n < C_AG) return n;
    if (n < C_AG + 8) return n + 2048;
    if (n < C_QKV) return -1;
    return n - 176;
}
template <bool MAPPED>
__device__ __forceinline__ void transpose_item(const float* W, int K, int N, bf16_t* WT, LAS float* scr, int item, int nblk, int lane) {
    const int kb = item / nblk, nb = item % nblk, k0 = 64 * kb, n0 = 32 * nb;
    const int nd = n0 + (lane & 31); const int src = MAPPED ? win_src_col(nd) : nd;
#pragma unroll 8
    for (int i = 0; i < 32; ++i) { const int kk = 2 * i + (lane >> 5); scr[kk * 33 + (lane & 31)] = src >= 0 ? W[(size_t)(k0 + kk) * N + src] : 0.f; }
    LDS_WAIT();
    const int c = lane & 7;
#pragma unroll
    for (int j = 0; j < 4; ++j) { const int n = (lane >> 3) + 8 * j; const LAS float* s = scr + (8 * c) * 33 + n;
        u32x4 o; o.x = pk2(s[0 * 33], s[1 * 33]); o.y = pk2(s[2 * 33], s[3 * 33]); o.z = pk2(s[4 * 33], s[5 * 33]); o.w = pk2(s[6 * 33], s[7 * 33]);
        *(u32x4*)(WT + (size_t)(n0 + n) * K + k0 + 8 * c) = o; }
    LDS_WAIT();
}
__device__ __forceinline__ void ph_prologue(const Params& p, LAS unsigned char* lds) {
    const int tid = threadIdx.x, lane = tid & 63, wave = tid >> 6;
    const int gw = blockIdx.x * NWAVES + wave, NGW = gridDim.x * NWAVES;
    bf16_t* WINT = (bf16_t*)(p.ws + WS_WINT); bf16_t* WOUTT = (bf16_t*)(p.ws + WS_WOUTT); bf16_t* XN = (bf16_t*)(p.ws + WS_XN);
    LAS float* scr = (LAS float*)(lds + wave * 8448);
    constexpr int I_IN = (1024 / 64) * (NP / 32), I_OUT = (1024 / 64) * (1024 / 32);
    for (int it = gw; it < I_IN + I_OUT; it += NGW) {
        if (it < I_IN) transpose_item<true>(p.w_in, 1024, 4440, WINT, scr, it, NP / 32, lane);
        else transpose_item<false>(p.w_out, 1024, 1024, WOUTT, scr, it - I_IN, 1024 / 32, lane);
    }
    for (int m = gw; m < MP; m += NGW) {
        unsigned long long* o8 = (unsigned long long*)(XN + (size_t)m * D_MODEL) + lane;
        if (m >= MVALID) {
#pragma unroll
            for (int j = 0; j < 4; ++j) o8[64 * j] = 0ull;
            continue;
        }
        const float* xrow = m < MPROMPT ? p.x_prompt + (size_t)m * D_MODEL : p.x_sample + (size_t)(m - MPROMPT) * D_MODEL;
        const f32x4* xr = (const f32x4*)xrow + lane; const f32x4* gr = (const f32x4*)p.norm_in + lane;
        f32x4 v[4]; float s = 0.f;
#pragma unroll
        for (int j = 0; j < 4; ++j) { v[j] = xr[64 * j]; s += (v[j].x * v[j].x + v[j].y * v[j].y) + (v[j].z * v[j].z + v[j].w * v[j].w); }
        const float rs = rsqrtf(wave_sum(s) * (1.f / D_MODEL) + 1e-6f);
#pragma unroll
        for (int j = 0; j < 4; ++j) { const f32x4 g = gr[64 * j]; const f32x4 y = v[j] * rs * g;
            o8[64 * j] = (unsigned long long)pk2(y.x, y.y) | ((unsigned long long)pk2(y.z, y.w) << 32); }
    }
}
__device__ __forceinline__ void ph_final_norm(const Params& p) {
    const int lane = threadIdx.x & 63, gw = blockIdx.x * NWAVES + (threadIdx.x >> 6), NGW = gridDim.x * NWAVES;
    const float* rowss = (const float*)(p.ws + WS_ROWSS);
    for (int m = gw; m < MVALID; m += NGW) {
        const float rs = rsqrtf(rowss[m] * (1.f / D_MODEL) + 1e-6f);
        f32x4* yr = (f32x4*)(p.out + (size_t)m * D_MODEL) + lane; const f32x4* gr = (const f32x4*)p.norm_final + lane;
#pragma unroll
        for (int j = 0; j < 4; ++j) yr[64 * j] = yr[64 * j] * rs * gr[64 * j];
    }
}

__device__ __forceinline__ void nv_idx(const Params& p, LAS unsigned char* lds) {
    const int wave = threadIdx.x >> 6, lane = threadIdx.x & 63;
    LAS float* qs = (LAS float*)(lds + wave * 12800);
    LAS float* scl = qs + 1024;
    LAS float* wh = scl + 64 * 33;
    const bf16_t* proj = (const bf16_t*)(p.ws + WS_PROJ); const float* aux = (const float*)(p.ws + WS_AUX); unsigned* mask = (unsigned*)(p.ws + WS_MASK);
    for (int base = blockIdx.x * NWAVES; base < MPROMPT; base += gridDim.x * NWAVES) {
        const int r = base + wave, b = r >> 11, t = r & (SEQ - 1);
        const bf16_t* qrow = proj + (size_t)r * NP + C_QI;
        for (int i = lane; i < 1024; i += 64) qs[i] = bf2f(qrow[i]) * 0.125f;
        if (lane < 16) wh[lane] = aux[(size_t)r * AUXP + lane] * 0.25f;
        __syncthreads();
        for (int j = 0; j < 32; ++j) {
            const int s = 32 * lane + j;
            float sc = -1e30f;
            if (s <= t) {
                const u32x4* krow = (const u32x4*)(proj + (size_t)(b * SEQ + s) * NP + C_KI);
                float kf[64];
#pragma unroll
                for (int c = 0; c < 8; ++c) unpack8(krow[c], kf + 8 * c);
                sc = 0.f;
                for (int h = 0; h < 16; ++h) {
                    float dot = 0.f;
#pragma unroll
                    for (int d = 0; d < 64; ++d) dot += qs[h * 64 + d] * kf[d];
                    sc += fmaxf(dot, 0.f) * wh[h];
                }
            }
            scl[lane * 33 + j] = sc;
        }
        __syncthreads();
        unsigned key[32];
#pragma unroll
        for (int j = 0; j < 32; ++j) key[j] = f2key(scl[lane * 33 + j]);
        unsigned prefix = 0u;
        for (int bit = 31; bit >= 0; --bit) {
            const unsigned cand = prefix | (1u << bit);
            int c = 0;
#pragma unroll
            for (int j = 0; j < 32; ++j) c += (key[j] >= cand) ? 1 : 0;
            c = wave_sum_i(c);
            if (c >= 256) prefix = cand;
        }
        int cgt = 0, ceq = 0;
#pragma unroll
        for (int j = 0; j < 32; ++j) { cgt += (key[j] > prefix) ? 1 : 0; ceq += (key[j] == prefix) ? 1 : 0; }
        const int need = 256 - wave_sum_i(cgt);
        int run = wave_excl_scan_i(ceq, lane);
        unsigned word = 0u;
#pragma unroll
        for (int j = 0; j < 32; ++j) {
            if (key[j] > prefix) word |= (1u << j);
            else if (key[j] == prefix) { if (run < need) word |= (1u << j); ++run; }
        }
        const int nv = t + 1 - 32 * lane;
        const unsigned vm = nv >= 32 ? 0xffffffffu : (nv <= 0 ? 0u : ((1u << nv) - 1u));
        mask[(size_t)r * 64 + lane] = word & vm;
        __syncthreads();
    }
}

__device__ __forceinline__ void nv_attn(const Params& p, LAS unsigned char* lds) {
    const int wave = threadIdx.x >> 6, lane = threadIdx.x & 63;
    LAS float* bd = (LAS float*)lds;
    LAS float* qs = (LAS float*)(lds + 4096 + wave * 11264);
    LAS int* lst = (LAS int*)(qs + 512);
    LAS float* pl = (LAS float*)(lst + 256);
    const bf16_t* proj = (const bf16_t*)(p.ws + WS_PROJ); const unsigned* mask = (const unsigned*)(p.ws + WS_MASK); bf16_t* mixed = (bf16_t*)(p.ws + WS_MIXED);
    for (int i = threadIdx.x; i < 1024; i += NTHR) bd[i] = p.rel_table[(int)c_bucket[i >> 3] * 8 + (i & 7)];
    for (int base = blockIdx.x * NWAVES; base < MPROMPT; base += gridDim.x * NWAVES) {
        const int r = base + wave, b = r >> 11, t = r & (SEQ - 1);
        const bf16_t* qrow = proj + (size_t)r * NP + C_Q;
        for (int i = lane; i < 512; i += 64) qs[i] = bf2f(qrow[i]) * 0.125f;
        const unsigned word = mask[(size_t)r * 64 + lane];
        const int cnt = __popc(word);
        int pos = wave_excl_scan_i(cnt, lane);
        const int nsel = wave_sum_i(cnt);
        { unsigned w = word; while (w) { const int j = __ffs(w) - 1; lst[pos++] = 32 * lane + j; w &= w - 1u; } }
        __syncthreads();
        for (int i = lane; i < nsel; i += 64) {
            const int s = lst[i]; int dn = t - s; dn = dn > 127 ? 127 : dn;
            for (int g = 0; g < 2; ++g) {
                const u32x4* krow = (const u32x4*)(proj + (size_t)(b * SEQ + s) * NP + C_K + g * 64);
                float kf[64];
#pragma unroll
                for (int c = 0; c < 8; ++c) unpack8(krow[c], kf + 8 * c);
                for (int hh = 0; hh < 4; ++hh) {
                    const int h = g * 4 + hh; float dot = 0.f;
#pragma unroll
                    for (int d = 0; d < 64; ++d) dot += qs[h * 64 + d] * kf[d];
                    pl[h * 256 + i] = dot + bd[dn * 8 + h];
                }
            }
        }
        __syncthreads();
        for (int h = 0; h < 8; ++h) {
            float m = -3.0e38f;
            for (int i = lane; i < nsel; i += 64) m = fmaxf(m, pl[h * 256 + i]);
            m = wave_max(m);
            float sum = 0.f;
            for (int i = lane; i < nsel; i += 64) { const float e = __expf(pl[h * 256 + i] - m); pl[h * 256 + i] = e; sum += e; }
            const float inv = 1.f / wave_sum(sum);
            for (int i = lane; i < nsel; i += 64) pl[h * 256 + i] *= inv;
        }
        __syncthreads();
        for (int g = 0; g < 2; ++g) {
            float acc0 = 0.f, acc1 = 0.f, acc2 = 0.f, acc3 = 0.f;
            for (int i = 0; i < nsel; ++i) {
                const int s = lst[i];
                const float v = bf2f(proj[(size_t)(b * SEQ + s) * NP + C_V + g * 64 + lane]);
                acc0 += pl[(g * 4 + 0) * 256 + i] * v; acc1 += pl[(g * 4 + 1) * 256 + i] * v; acc2 += pl[(g * 4 + 2) * 256 + i] * v; acc3 += pl[(g * 4 + 3) * 256 + i] * v;
            }
            const bf16_t* zr = proj + (size_t)r * NP + C_ZA + g * 256 + lane; bf16_t* mr = mixed + (size_t)r * D_MODEL + g * 256 + lane;
            mr[0] = (bf16_t)f2bf(acc0 * silu_f(bf2f(zr[0]))); mr[64] = (bf16_t)f2bf(acc1 * silu_f(bf2f(zr[64])));
            mr[128] = (bf16_t)f2bf(acc2 * silu_f(bf2f(zr[128]))); mr[192] = (bf16_t)f2bf(acc3 * silu_f(bf2f(zr[192])));
        }
        __syncthreads();
    }
}

template <int MODE>
__device__ __forceinline__ void nv_gdn_unit(const Params& p, LAS unsigned char* lds, int unit) {
    LAS float* qkv_s = (LAS float*)lds;
    LAS float* red = qkv_s + 384;
    LAS float* sc = red + 1024;
    const int tid = threadIdx.x, lane = tid & 63, wave = tid >> 6;
    const int b = unit >> 2, h = unit & 3;
    const int T = MODE ? 1 : SEQ; const int row0 = MODE ? MPROMPT + b : b * SEQ;
    const int e = tid & 127, sl = tid >> 7;
    const bf16_t* proj = (const bf16_t*)(p.ws + WS_PROJ); const float* aux = (const float*)(p.ws + WS_AUX); bf16_t* mixed = (bf16_t*)(p.ws + WS_MIXED);
    float S[32];
#pragma unroll
    for (int i = 0; i < 32; ++i) S[i] = MODE ? p.state_ssm[((size_t)(b * 4 + h) * 128 + sl * 32 + i) * 128 + e] : 0.f;
    const int part = tid >> 7, ci = tid & 127, c = part * 512 + h * 128 + ci;
    float w0 = 0.f, w1 = 0.f, w2 = 0.f, w3 = 0.f, x0 = 0.f, x1 = 0.f, x2 = 0.f;
    if (tid < 384) {
        w0 = p.conv_w[0 * 1536 + c]; w1 = p.conv_w[1 * 1536 + c]; w2 = p.conv_w[2 * 1536 + c]; w3 = p.conv_w[3 * 1536 + c];
        if (MODE) { x0 = p.state_conv[((size_t)b * 3 + 0) * 1536 + c]; x1 = p.state_conv[((size_t)b * 3 + 1) * 1536 + c]; x2 = p.state_conv[((size_t)b * 3 + 2) * 1536 + c]; }
    }
    const float A = __expf(p.a_log[h]), dtb = p.dt_bias[h], gn = p.gdn_norm[e];
    for (int t = 0; t < T; ++t) {
        const size_t r = (size_t)(row0 + t);
        if (tid < 384) {
            float x3;
            if (MODE) x3 = p.out[O_CS + ((size_t)b * 3 + 2) * 1536 + c];
            else x3 = bf2f(proj[r * NP + C_QKV + c]);
            const float y = x0 * w0 + x1 * w1 + x2 * w2 + x3 * w3;
            x0 = x1; x1 = x2; x2 = x3;
            qkv_s[tid] = silu_f(y);
        }
        __syncthreads();
        if (wave == 0) { const float a = qkv_s[lane], a2 = qkv_s[lane + 64]; const float s = wave_sum(a * a + a2 * a2); if (lane == 0) sc[0] = s; }
        else if (wave == 1) { const float a = qkv_s[128 + lane], a2 = qkv_s[192 + lane]; const float s = wave_sum(a * a + a2 * a2); if (lane == 0) sc[1] = s; }
        else if (wave == 2) { const float s = wave_sum(qkv_s[lane] * qkv_s[128 + lane] + qkv_s[lane + 64] * qkv_s[192 + lane]); if (lane == 0) sc[2] = s; }
        __syncthreads();
        const float qn = rsqrtf(sc[0] + 1e-6f) * 0.08838834764831845f, kn = rsqrtf(sc[1] + 1e-6f), qk = sc[2] * qn * kn;
        const float ag = aux[r * AUXP + 16 + h], bg = aux[r * AUXP + 20 + h];
        const float xg = ag + dtb;
        const float sp = xg > 20.f ? xg : log1pf(__expf(xg));
        const float dec = __expf(-A * sp), beta = 1.f / (1.f + __expf(-bg));
        float pk = 0.f, pq = 0.f;
#pragma unroll
        for (int i = 0; i < 32; ++i) { const int d = sl * 32 + i; S[i] *= dec; pk += qkv_s[128 + d] * S[i]; pq += qkv_s[d] * S[i]; }
        red[sl * 128 + e] = pk * kn; red[512 + sl * 128 + e] = pq * qn;
        __syncthreads();
        const float kv = (red[e] + red[128 + e]) + (red[256 + e] + red[384 + e]);
        const float qS = (red[512 + e] + red[640 + e]) + (red[768 + e] + red[896 + e]);
        const float delta = (qkv_s[256 + e] - kv) * beta;
        const float o = qS + qk * delta;
#pragma unroll
        for (int i = 0; i < 32; ++i) { const int d = sl * 32 + i; S[i] += qkv_s[128 + d] * kn * delta; }
        if (sl == 0) { const float s = wave_sum(o * o); if (lane == 0) sc[4 + wave] = s; }
        __syncthreads();
        if (sl == 0) {
            const float rs = rsqrtf((sc[4] + sc[5]) * (1.f / 128.f) + 1e-6f);
            const float z = bf2f(proj[r * NP + C_ZG + h * 128 + e]);
            mixed[r * D_MODEL + 512 + h * 128 + e] = (bf16_t)f2bf(o * rs * gn * silu_f(z));
        }
    }
    float* So = p.out + (MODE ? O_SSMS : O_SSMP);
#pragma unroll
    for (int i = 0; i < 32; ++i) So[((size_t)(b * 4 + h) * 128 + sl * 32 + i) * 128 + e] = S[i];
    __syncthreads();
}

__device__ __forceinline__ void nv_sample_unit(const Params& p, LAS unsigned char* lds, int b) {
    LAS float* scs = (LAS float*)lds;
    LAS float* qs = scs + 8704;
    LAS float* wh = qs + 1024;
    LAS int* lst = (LAS int*)(wh + 16);
    LAS int* eql = lst + 256;
    LAS int* cnts = eql + 64;
    LAS float* pl = (LAS float*)(cnts + 16);
    LAS float* qa = pl + 2048;
    const int tid = threadIdx.x, lane = tid & 63, wave = tid >> 6;
    const size_t r = (size_t)MPROMPT + b;
    const bf16_t* proj = (const bf16_t*)(p.ws + WS_PROJ); const float* aux = (const float*)(p.ws + WS_AUX); bf16_t* mixed = (bf16_t*)(p.ws + WS_MIXED);
    for (int i = tid; i < 1024; i += NTHR) qs[i] = bf2f(proj[r * NP + C_QI + i]) * 0.125f;
    qa[tid] = bf2f(proj[r * NP + C_Q + tid]) * 0.125f;
    if (tid < 16) wh[tid] = aux[r * AUXP + tid] * 0.25f;
    if (tid < 16) cnts[tid] = 0;
    for (int i = tid; i < 2 * 1536; i += NTHR) p.out[O_CS + (size_t)b * 3 * 1536 + i] = p.state_conv[(size_t)b * 3 * 1536 + 1536 + i];
    __syncthreads();
    for (int i = 0; i < 17; ++i) {
        const int s = tid + 512 * i;
        float sc = -3.0e38f;
        if (s <= PAST) {
            const float* krow = s < PAST ? p.cache_kidx + ((size_t)p.page_table[b * NPAGES + (s >> 7)] * PAGE + (s & 127)) * 64 : p.out + O_KIS + (size_t)b * 64;
            float kf[64];
#pragma unroll
            for (int c = 0; c < 16; ++c) { const f32x4 v = ((const f32x4*)krow)[c]; kf[4 * c] = v.x; kf[4 * c + 1] = v.y; kf[4 * c + 2] = v.z; kf[4 * c + 3] = v.w; }
            sc = 0.f;
            for (int h = 0; h < 16; ++h) {
                float dot = 0.f;
#pragma unroll
                for (int d = 0; d < 64; ++d) dot += qs[h * 64 + d] * kf[d];
                sc += fmaxf(dot, 0.f) * wh[h];
            }
        }
        scs[s] = sc;
    }
    __syncthreads();
    unsigned key[17];
#pragma unroll
    for (int i = 0; i < 17; ++i) { const int s = tid + 512 * i; key[i] = s <= PAST ? f2key(scs[s]) : 0u; }
    unsigned prefix = 0u;
    for (int bit = 31; bit >= 0; --bit) {
        const unsigned cand = prefix | (1u << bit);
        int c = 0;
#pragma unroll
        for (int i = 0; i < 17; ++i) c += (key[i] >= cand) ? 1 : 0;
        c = wave_sum_i(c);
        if (lane == 0) cnts[8 + wave] = c;
        __syncthreads();
        int tot = 0;
#pragma unroll
        for (int w = 0; w < 8; ++w) tot += cnts[8 + w];
        __syncthreads();
        if (tot >= 256) prefix = cand;
    }
#pragma unroll
    for (int i = 0; i < 17; ++i) {
        const int s = tid + 512 * i;
        if (key[i] > prefix) { const int pos = atomicAdd((int*)&cnts[0], 1); if (pos < 256) lst[pos] = s; }
        else if (key[i] == prefix && s <= PAST) { const int pos = atomicAdd((int*)&cnts[1], 1); if (pos < 64) eql[pos] = s; }
    }
    __syncthreads();
    const int ngt = cnts[0], neq = cnts[1] < 64 ? cnts[1] : 64, need = 256 - ngt;
    __syncthreads();
    if (tid < neq) {
        const int s = eql[tid]; int rank = 0;
        for (int j = 0; j < neq; ++j) rank += (eql[j] < s) ? 1 : 0;
        if (rank < need) { const int pos = atomicAdd((int*)&cnts[0], 1); if (pos < 256) lst[pos] = s; }
    }
    __syncthreads();
    {
        const int i = tid & 255, g = tid >> 8;
        const int s = lst[i]; int dn = PAST - s; dn = dn > 127 ? 127 : dn;
        const float* krow = s < PAST ? p.cache_k + (((size_t)p.page_table[b * NPAGES + (s >> 7)] * PAGE + (s & 127)) * 2 + g) * 64 : p.out + O_KS + (size_t)b * 128 + g * 64;
        float kf[64];
#pragma unroll
        for (int c = 0; c < 16; ++c) { const f32x4 v = ((const f32x4*)krow)[c]; kf[4 * c] = v.x; kf[4 * c + 1] = v.y; kf[4 * c + 2] = v.z; kf[4 * c + 3] = v.w; }
        for (int hh = 0; hh < 4; ++hh) {
            const int h = g * 4 + hh; float dot = 0.f;
#pragma unroll
            for (int d = 0; d < 64; ++d) dot += qa[h * 64 + d] * kf[d];
            pl[h * 256 + i] = dot + p.rel_table[(int)c_bucket[dn] * 8 + h];
        }
    }
    __syncthreads();
    {
        const int h = wave;
        float v[4]; float m = -3.0e38f;
#pragma unroll
        for (int j = 0; j < 4; ++j) { v[j] = pl[h * 256 + lane + 64 * j]; m = fmaxf(m, v[j]); }
        m = wave_max(m);
        float sum = 0.f;
#pragma unroll
        for (int j = 0; j < 4; ++j) { v[j] = __expf(v[j] - m); sum += v[j]; }
        const float inv = 1.f / wave_sum(sum);
#pragma unroll
        for (int j = 0; j < 4; ++j) pl[h * 256 + lane + 64 * j] = v[j] * inv;
    }
    __syncthreads();
    {
        const int d = tid & 63, h = tid >> 6, g = h >> 2;
        float acc = 0.f;
        for (int i = 0; i < 256; ++i) {
            const int s = lst[i];
            const float* vrow = s < PAST ? p.cache_v + (((size_t)p.page_table[b * NPAGES + (s >> 7)] * PAGE + (s & 127)) * 2 + g) * 64 : p.out + O_VS + (size_t)b * 128 + g * 64;
            acc += pl[h * 256 + i] * vrow[d];
        }
        const float z = bf2f(proj[r * NP + C_ZA + h * 64 + d]);
        mixed[r * D_MODEL + h * 64 + d] = (bf16_t)f2bf(acc * silu_f(z));
    }
    __syncthreads();
}

constexpr int N_PHASES = 6;
struct Args { Params p; int ph_lo, ph_hi; };
__global__ void __launch_bounds__(NTHR, 2) mk_fwd(Args a) {
    extern __shared__ __attribute__((aligned(16))) unsigned char lds_raw[];
    LAS unsigned char* lds = (LAS unsigned char*)lds_raw;
    const Params& p = a.p;
    volatile LAS unsigned* MISC = (volatile LAS unsigned*)(lds + MISC_OFF);
    for (int u = threadIdx.x; u < (LDS_BYTES - SCR_BYTES) / 4; u += NTHR) ((LAS unsigned*)(lds + SCR_BYTES))[u] = 0u;
    __syncthreads();
    const int lo = a.ph_lo, hi = a.ph_hi;
    const bool multi = (hi - lo) > 1;
    XcdBarrier bar; bar.bar = (unsigned*)(p.ws + WS_CTL) + CW_BAR; bar.x = 0; bar.st = nullptr;
    if (multi) bar = xcd_barrier_post((unsigned*)(p.ws + WS_CTL) + CW_BAR, MISC + 8);
#define IN(k) (lo <= (k) && (k) < hi)
#define SEAM(k) do { if (IN(k) && IN((k) + 1)) xcd_barrier(bar); } while (0)
    if (IN(0)) { ph_prologue(p, lds); __syncthreads(); }
    SEAM(0);
    if (IN(1)) {
        pg8::Gemm g{(const bf16_t*)(p.ws + WS_XN), (const bf16_t*)(p.ws + WS_WINT), MP, NP, 1024};
        pg8::StaticOrder S; S.init(MP, NP, gridDim.x, blockIdx.x);
        EpiIn E{(bf16_t*)(p.ws + WS_PROJ), (float*)(p.ws + WS_AUX), p.out};
        pg8::gemm_phase<EpiIn, pg8::StaticOrder, true, true>(lds, g, S, E);
    }
    SEAM(1);
    if (IN(2)) {
        for (int u = blockIdx.x; u < BATCH * 4; u += gridDim.x) nv_gdn_unit<0>(p, lds, u);
        for (int u = (int)gridDim.x - 1 - (int)blockIdx.x; u < DEC_BATCH; u += gridDim.x) nv_sample_unit(p, lds, u);
        for (int u = blockIdx.x; u < DEC_BATCH * 4; u += gridDim.x) nv_gdn_unit<1>(p, lds, u);
        nv_idx(p, lds);
    }
    SEAM(2);
    if (IN(3)) nv_attn(p, lds);
    SEAM(3);
    if (IN(4)) {
        pg8::Gemm g{(const bf16_t*)(p.ws + WS_MIXED), (const bf16_t*)(p.ws + WS_WOUTT), MP, 1024, 1024};
        pg8::StaticOrder S; S.init(MP, 1024, gridDim.x, blockIdx.x);
        EpiOut E{p.x_prompt, p.x_sample, p.out, (float*)(p.ws + WS_ROWSS)};
        pg8::gemm_phase<EpiOut, pg8::StaticOrder, true, true>(lds, g, S, E);
    }
    SEAM(4);
    if (IN(5)) ph_final_norm(p);
#undef IN
#undef SEAM
}

#ifndef MK_N_LAUNCHES
#define MK_N_LAUNCHES 1
#endif
extern "C" void kernel_launch(void* const* d_in, const int* in_sizes, int n_in, void* d_out, int out_size, void* d_ws, size_t ws_size, hipStream_t stream) {
    static int grid = 0;
    if (grid == 0) {
        if (n_in != 17 || (size_t)out_size != O_END || ws_size < WS_END) { fprintf(stderr, "kernel_launch: unexpected shapes n_in %d out %d ws %zu\n", n_in, out_size, ws_size); grid = -1; return; }
        int dev = 0, cus = 0, per_cu = 0;
        if (hipGetDevice(&dev) != hipSuccess || hipDeviceGetAttribute(&cus, hipDeviceAttributeMultiprocessorCount, dev) != hipSuccess) { grid = -1; return; }
        if (hipFuncSetAttribute((const void*)mk_fwd, hipFuncAttributeMaxDynamicSharedMemorySize, LDS_BYTES) != hipSuccess) { fprintf(stderr, "kernel_launch: hipFuncSetAttribute failed\n"); grid = -1; return; }
        if (hipOccupancyMaxActiveBlocksPerMultiprocessor(&per_cu, (const void*)mk_fwd, NTHR, LDS_BYTES) != hipSuccess || per_cu < 1) { fprintf(stderr, "kernel_launch: occupancy query says %d blocks per CU\n", per_cu); (void)hipGetLastError(); }
        grid = cus;
    }
    if (grid < 0) return;
    Args a{};
    Params& p = a.p;
    p.x_prompt = (const float*)d_in[0]; p.x_sample = (const float*)d_in[1]; p.cache_k = (const float*)d_in[2]; p.cache_v = (const float*)d_in[3]; p.cache_kidx = (const float*)d_in[4];
    p.state_ssm = (const float*)d_in[5]; p.state_conv = (const float*)d_in[6]; p.page_table = (const int*)d_in[7]; p.norm_in = (const float*)d_in[8]; p.w_in = (const float*)d_in[9];
    p.conv_w = (const float*)d_in[10]; p.a_log = (const float*)d_in[11]; p.dt_bias = (const float*)d_in[12]; p.gdn_norm = (const float*)d_in[13]; p.w_out = (const float*)d_in[14];
    p.rel_table = (const float*)d_in[15]; p.norm_final = (const float*)d_in[16]; p.out = (float*)d_out; p.ws = (unsigned char*)d_ws;
    (void)hipMemsetAsync((char*)d_ws + WS_CTL, 0, CTL_BYTES, stream);
#if MK_N_LAUNCHES == 1
    a.ph_lo = 0; a.ph_hi = N_PHASES;
    hipLaunchKernelGGL(mk_fwd, dim3(grid), dim3(NTHR), LDS_BYTES, stream, a);
#else
    for (int k = 0; k < N_PHASES; ++k) { a.ph_lo = k; a.ph_hi = k + 1; hipLaunchKernelGGL(mk_fwd, dim3(grid), dim3(NTHR), LDS_BYTES, stream, a); }
#endif
}
```

```cpp
#include <hip/hip_runtime.h>
#include <cstdio>
#include <cstdint>

#define LAS __attribute__((address_space(3)))
#define GAS __attribute__((address_space(1)))
typedef unsigned short bf16_t;
typedef short bf16x8 __attribute__((ext_vector_type(8)));
typedef float f32x4 __attribute__((ext_vector_type(4)));
typedef unsigned u32x4 __attribute__((ext_vector_type(4)));

constexpr int D_MODEL = 1024, BATCH = 32, SEQ = 2048, DEC_BATCH = 128, PAST = 8192, PAGE = 128, NPAGES = 64;
constexpr int MPROMPT = BATCH * SEQ;
constexpr int MVALID = MPROMPT + DEC_BATCH;
constexpr int MP = MPROMPT + 256;
constexpr int NP = 4608;
constexpr int C_Q = 0, C_K = 512, C_V = 640, C_ZA = 768, C_QI = 1280, C_KI = 2304, C_WI = 2368, C_AG = 2384, C_BG = 2388, C_QKV = 2560, C_ZG = 4096;
constexpr int AUXP = 32;
constexpr size_t O_YP = 0, O_YS = 67108864, O_KP = 67239936, O_VP = 75628544, O_KIP = 84017152, O_SSMP = 88211456, O_CP = 90308608,
                 O_KS = 90456064, O_VS = 90472448, O_KIS = 90488832, O_SSMS = 90497024, O_CS = 98885632, O_END = 99475456;
constexpr size_t MiB = 1u << 20;
constexpr size_t WS_CTL = 0, CTL_BYTES = 1 * MiB;
constexpr size_t WS_ROWSS = 512 * 1024;
constexpr size_t WS_WINT = 2 * MiB;
constexpr size_t WS_WOUTT = 12 * MiB;
constexpr size_t WS_XN = 16 * MiB;
constexpr size_t WS_PROJ = 146 * MiB;
constexpr size_t WS_AUX = 726 * MiB;
constexpr size_t WS_MIXED = 736 * MiB;
constexpr size_t WS_MASK = 866 * MiB;
constexpr size_t WS_END = 900 * MiB;

__constant__ unsigned char c_bucket[128] = {0, 1, 2, 3, 4, 5, 6, 7, 8, 9, 10, 11, 12, 13, 14, 15, 16, 16, 16, 17, 17, 18, 18, 18, 19, 19, 19, 20, 20, 20, 20, 21, 21, 21, 21, 22, 22, 22, 22, 22, 23, 23, 23, 23, 23, 23, 24, 24, 24, 24, 24, 24, 25, 25, 25, 25, 25, 25, 25, 26, 26, 26, 26, 26, 26, 26, 26, 27, 27, 27, 27, 27, 27, 27, 27, 27, 27, 28, 28, 28, 28, 28, 28, 28, 28, 28, 28, 29, 29, 29, 29, 29, 29, 29, 29, 29, 29, 29, 29, 30, 30, 30, 30, 30, 30, 30, 30, 30, 30, 30, 30, 30, 30, 31, 31, 31, 31, 31, 31, 31, 31, 31, 31, 31, 31, 31, 31, 31};

__device__ __forceinline__ float bf2f(unsigned short b) { return __builtin_bit_cast(float, (unsigned)b << 16); }
__device__ __forceinline__ unsigned f2bf(float f) { unsigned u = __builtin_bit_cast(unsigned, f); return (u + 0x7fffu + ((u >> 16) & 1u)) >> 16; }
__device__ __forceinline__ unsigned pk2(float lo, float hi) { return f2bf(lo) | (f2bf(hi) << 16); }
__device__ __forceinline__ float wave_sum(float v) {
#pragma unroll
    for (int o = 1; o < 64; o <<= 1) v += __shfl_xor(v, o);
    return v;
}
__device__ __forceinline__ int wave_sum_i(int v) {
#pragma unroll
    for (int o = 1; o < 64; o <<= 1) v += __shfl_xor(v, o);
    return v;
}
__device__ __forceinline__ float wave_max(float v) {
#pragma unroll
    for (int o = 1; o < 64; o <<= 1) v = fmaxf(v, __shfl_xor(v, o));
    return v;
}
__device__ __forceinline__ int wave_excl_scan_i(int v, int lane) {
    int x = v;
#pragma unroll
    for (int o = 1; o < 64; o <<= 1) { int y = __shfl_up(x, o); if (lane >= o) x += y; }
    return x - v;
}
__device__ __forceinline__ unsigned f2key(float f) { unsigned u = __builtin_bit_cast(unsigned, f); return (u & 0x80000000u) ? ~u : (u | 0x80000000u); }
__device__ __forceinline__ float silu_f(float z) { return z / (1.f + __expf(-z)); }
__device__ __forceinline__ void unpack8(const u32x4 w, float* f) {
    f[0] = __builtin_bit_cast(float, w.x << 16); f[1] = __builtin_bit_cast(float, w.x & 0xffff0000u);
    f[2] = __builtin_bit_cast(float, w.y << 16); f[3] = __builtin_bit_cast(float, w.y & 0xffff0000u);
    f[4] = __builtin_bit_cast(float, w.z << 16); f[5] = __builtin_bit_cast(float, w.z & 0xffff0000u);
    f[6] = __builtin_bit_cast(float, w.w << 16); f[7] = __builtin_bit_cast(float, w.w & 0xffff0000u);
}

namespace pg8 {
#define PG8_LAS __attribute__((address_space(3)))
constexpr int BM = 256, BK = 64, HALF = 128, HTB = HALF * BK * 2, STAGE_BYTES = 8 * HTB, NXCD = 8, WGM = 8;
__host__ __device__ __forceinline__ int lds_byte(int r, int c) { const int st = (r >> 4) * 2 + (c >> 5), rr = r & 15, cc = c & 31, ob = rr * 64 + cc * 2; return st * 1024 + (ob ^ (((ob >> 9) & 1) << 5)); }
__host__ __device__ __forceinline__ void stage_rc(int b, int& R, int& C) { const int st = b / 1024, sb = b % 1024, swz = sb ^ (((sb >> 9) & 1) << 5); R = (st >> 1) * 16 + swz / 64; C = (st & 1) * 32 + (swz % 64) / 2; }
__host__ __device__ __forceinline__ int perm32(int rho) { const int n = rho >> 4, i = rho & 15; return 8 * (i >> 2) + 4 * n + (i & 3); }
struct Unit { int pm, pn; };
struct Gemm { const bf16_t* A; const bf16_t* Bt; int M, N, K; };
struct StaticOrder {
    int nM, nN, nwg, G, c;
    __host__ __device__ void init(int M, int N, int G_, int c_) { nM = M / BM; nN = N / BM; nwg = nM * nN; G = G_; c = c_; }
    __host__ __device__ bool next(int i, Unit& u) const {
        const long L = (long)i * G + c; if (L >= nwg) return false;
        int wgid = (int)L; { const int q = nwg / NXCD, r = nwg % NXCD, xcd = wgid % NXCD, off = wgid / NXCD; wgid = (xcd < r ? xcd * (q + 1) : r * (q + 1) + (xcd - r) * q) + off; }
        const int nig = WGM * nN, gid = wgid / nig, fm = gid * WGM, gsz = (nM - fm) < WGM ? (nM - fm) : WGM;
        u.pm = fm + ((wgid % nig) % gsz); u.pn = (wgid % nig) / gsz; return true;
    }
    __device__ __forceinline__ void a_ready(const Unit&) const {}
    __device__ __forceinline__ void done(const Unit&) const {}
};
__device__ __forceinline__ unsigned cvt_pk_bf16(float lo, float hi) { unsigned r; asm volatile("v_cvt_pk_bf16_f32 %0, %1, %2" : "=v"(r) : "v"(lo), "v"(hi)); return r; }

template <class Epi, class Sched, bool ALIGN_EPI = false, bool SP2 = false>
__device__ __forceinline__ void gemm_phase(PG8_LAS unsigned char* lds, const Gemm g, const Sched& S, const Epi& E) {
    const int tid = threadIdx.x, wid = __builtin_amdgcn_readfirstlane(tid >> 6), lane = tid & 63, wr = wid >> 2, wc = wid & 3, fr = lane & 15, fq = lane >> 4;
    const int K = g.K, nt = K / BK;
    unsigned voffA[2], voffB[2];
#pragma unroll
    for (int i = 0; i < 2; ++i) { int R, C; stage_rc(tid * 16 + i * 8192, R, C); const int Rb = Epi::PERM ? ((R & ~31) + perm32(R & 31)) : R;
        voffA[i] = (unsigned)(R * K + C) * 2u; voffB[i] = (unsigned)(Rb * K + C) * 2u; }
    const size_t kstep = (size_t)(BK * 2);
    const size_t hstep = (size_t)HALF * K * 2;
    const size_t tstep = 2 * hstep;
    const unsigned ldsw = (unsigned)wid * 1024u;
    const int aoff = lds_byte(wr * 64 + fr, fq * 8), boff = lds_byte(wc * 32 + fr, fq * 8);
#define PG8_SA(b, h) (((b) * 2 + (h)) * HTB)
#define PG8_SB(b, h) ((4 + (b) * 2 + (h)) * HTB)
#define PG8_STAGE(bufoff, gbase, voff) do { _Pragma("unroll") for (int _i = 0; _i < 2; ++_i) \
        __builtin_amdgcn_global_load_lds((const unsigned*)((const char*)(gbase) + (voff)[_i]), (PG8_LAS unsigned*)(lds + (bufoff) + ldsw + _i * 8192), 16, 0, 0); } while (0)
#define PG8_LDA(dst, b, h) do { _Pragma("unroll") for (int m = 0; m < 4; ++m) _Pragma("unroll") for (int k = 0; k < 2; ++k) dst[m][k] = *(const PG8_LAS bf16x8*)(lds + PG8_SA(b, h) + aoff + m * 2048 + k * 1024); } while (0)
#define PG8_LDB(dst, b, h) do { _Pragma("unroll") for (int n = 0; n < 2; ++n) _Pragma("unroll") for (int k = 0; k < 2; ++k) dst[n][k] = *(const PG8_LAS bf16x8*)(lds + PG8_SB(b, h) + boff + n * 2048 + k * 1024); } while (0)
#define PG8_MMA(ai, bj, At, Bt) do { __builtin_amdgcn_s_setprio(1); _Pragma("unroll") for (int m = 0; m < 4; ++m) _Pragma("unroll") for (int n = 0; n < 2; ++n) _Pragma("unroll") for (int k = 0; k < 2; ++k) \
        acc[ai][bj][m][n] = __builtin_amdgcn_mfma_f32_16x16x32_bf16(Bt[n][k], At[m][k], acc[ai][bj][m][n], 0, 0, 0); __builtin_amdgcn_s_setprio(0); } while (0)
#define PG8_WAIT_V(n) asm volatile("s_waitcnt vmcnt(" #n ")" ::: "memory")
#define PG8_WAIT_L(n) asm volatile("s_waitcnt lgkmcnt(" #n ")" ::: "memory")
#define PG8_BAR __builtin_amdgcn_s_barrier()
#define PG8_SCHED __builtin_amdgcn_sched_barrier(0)
    Unit cur, nxt; int ui = 0;
    if (!S.next(0, cur)) return;
    f32x4 acc[2][2][4][2];
#pragma unroll
    for (int a = 0; a < 2; ++a)
#pragma unroll
        for (int b = 0; b < 2; ++b)
#pragma unroll
            for (int m = 0; m < 4; ++m)
#pragma unroll
                for (int n = 0; n < 2; ++n) acc[a][b][m][n] = (f32x4){0.f, 0.f, 0.f, 0.f};
    bf16x8 At[4][2], B0[2][2], B1[2][2];
    const char* cA = (const char*)g.A + (size_t)cur.pm * tstep; const char* cB = (const char*)g.Bt + (size_t)cur.pn * tstep;
    S.a_ready(cur);
    if constexpr (SP2) {
        PG8_STAGE(PG8_SB(0, 0), cB, voffB); PG8_STAGE(PG8_SB(0, 1), cB + hstep, voffB); PG8_STAGE(PG8_SA(0, 0), cA, voffA); PG8_STAGE(PG8_SA(0, 1), cA + hstep, voffA);
        if (wr == 1) PG8_BAR;
        PG8_WAIT_V(2); PG8_BAR;
        PG8_STAGE(PG8_SB(1, 0), cB + kstep, voffB); PG8_STAGE(PG8_SA(1, 0), cA + kstep, voffA); PG8_STAGE(PG8_SB(1, 1), cB + hstep + kstep, voffB);
        PG8_WAIT_V(6); PG8_BAR;
    } else {
        PG8_STAGE(PG8_SB(0, 0), cB, voffB); PG8_STAGE(PG8_SA(0, 0), cA, voffA); PG8_STAGE(PG8_SB(0, 1), cB + hstep, voffB); PG8_STAGE(PG8_SA(0, 1), cA + hstep, voffA);
        if (wr == 1) PG8_BAR;
        PG8_WAIT_V(4); PG8_BAR;
        PG8_STAGE(PG8_SB(1, 0), cB + kstep, voffB); PG8_STAGE(PG8_SA(1, 0), cA + kstep, voffA); PG8_STAGE(PG8_SB(1, 1), cB + hstep + kstep, voffB);
        PG8_WAIT_V(6); PG8_BAR;
    }
    for (;;) {
        const bool has_next = S.next(ui + 1, nxt);
        const char* nA = has_next ? (const char*)g.A + (size_t)nxt.pm * tstep : cA; const char* nB = has_next ? (const char*)g.Bt + (size_t)nxt.pn * tstep : cB;
        for (int t = 0; t < nt; t += 2) {
            const bool last = (t == nt - 2);
            const char* a1 = cA + (size_t)(t + 1) * kstep;
            const char* a2 = last ? nA : cA + (size_t)(t + 2) * kstep; const char* b2 = last ? nB : cB + (size_t)(t + 2) * kstep;
            const char* a3 = a2 + kstep; const char* b3 = b2 + kstep;
            if (last && has_next) S.a_ready(nxt);
            if constexpr (SP2) {
            PG8_LDB(B0, 0, 0); PG8_LDB(B1, 0, 1); PG8_SCHED; PG8_LDA(At, 0, 0); PG8_STAGE(PG8_SA(1, 1), a1 + hstep, voffA);
            PG8_WAIT_V(8); PG8_WAIT_L(0); PG8_BAR; PG8_MMA(0, 0, At, B0); PG8_MMA(0, 1, At, B1); PG8_BAR; PG8_SCHED;
            PG8_LDA(At, 0, 1); PG8_STAGE(PG8_SB(0, 0), b2, voffB); PG8_STAGE(PG8_SB(0, 1), b2 + hstep, voffB); PG8_STAGE(PG8_SA(0, 0), a2, voffA);
            PG8_WAIT_V(8); PG8_WAIT_L(0); PG8_BAR; PG8_MMA(1, 0, At, B0); PG8_MMA(1, 1, At, B1); PG8_BAR; PG8_SCHED;
            PG8_LDB(B0, 1, 0); PG8_LDB(B1, 1, 1); PG8_SCHED; PG8_LDA(At, 1, 0); PG8_STAGE(PG8_SA(0, 1), a2 + hstep, voffA);
            PG8_WAIT_V(8); PG8_WAIT_L(0); PG8_BAR; PG8_MMA(0, 0, At, B0); PG8_MMA(0, 1, At, B1); PG8_BAR; PG8_SCHED;
            PG8_LDA(At, 1, 1); PG8_STAGE(PG8_SB(1, 0), b3, voffB); PG8_STAGE(PG8_SB(1, 1), b3 + hstep, voffB); PG8_STAGE(PG8_SA(1, 0), a3, voffA);
            PG8_WAIT_V(8); PG8_WAIT_L(0); PG8_BAR; PG8_MMA(1, 0, At, B0); PG8_MMA(1, 1, At, B1); PG8_BAR; PG8_SCHED;
            } else {
            PG8_LDB(B0, 0, 0); PG8_SCHED; PG8_LDA(At, 0, 0); PG8_STAGE(PG8_SA(1, 1), a1 + hstep, voffA);
            PG8_WAIT_L(8); PG8_BAR; PG8_WAIT_L(0); PG8_MMA(0, 0, At, B0); PG8_BAR; PG8_SCHED;
            PG8_LDB(B1, 0, 1); PG8_STAGE(PG8_SB(0, 0), b2, voffB);
            PG8_BAR; PG8_WAIT_L(0); PG8_MMA(0, 1, At, B1); PG8_BAR;
            PG8_LDA(At, 0, 1); PG8_STAGE(PG8_SA(0, 0), a2, voffA);
            PG8_BAR; PG8_WAIT_L(0); PG8_MMA(1, 0, At, B0); PG8_BAR; PG8_SCHED;
            PG8_STAGE(PG8_SB(0, 1), b2 + hstep, voffB);
            PG8_WAIT_V(6); PG8_BAR; PG8_MMA(1, 1, At, B1); PG8_BAR;
            PG8_LDB(B0, 1, 0); PG8_SCHED; PG8_LDA(At, 1, 0); PG8_STAGE(PG8_SA(0, 1), a2 + hstep, voffA);
            PG8_WAIT_L(8); PG8_BAR; PG8_WAIT_L(0); PG8_MMA(0, 0, At, B0); PG8_BAR; PG8_SCHED;
            PG8_LDB(B1, 1, 1); PG8_STAGE(PG8_SB(1, 0), b3, voffB);
            PG8_BAR; PG8_WAIT_L(0); PG8_MMA(0, 1, At, B1); PG8_BAR;
            PG8_LDA(At, 1, 1); PG8_STAGE(PG8_SA(1, 0), a3, voffA);
            PG8_BAR; PG8_WAIT_L(0); PG8_MMA(1, 0, At, B0); PG8_BAR; PG8_SCHED;
            PG8_STAGE(PG8_SB(1, 1), b3 + hstep, voffB);
            PG8_WAIT_V(6); PG8_BAR; PG8_MMA(1, 1, At, B1); PG8_BAR;
            }
        }
        if constexpr (ALIGN_EPI) { if (wr == 0) PG8_BAR; }
        if constexpr (!Epi::AFTER_DRAIN) { E(acc, cur, wr, wc, fr, fq); S.done(cur); }
        if (!has_next) break;
#pragma unroll
        for (int a = 0; a < 2; ++a)
#pragma unroll
            for (int b = 0; b < 2; ++b)
#pragma unroll
                for (int m = 0; m < 4; ++m)
#pragma unroll
                    for (int n = 0; n < 2; ++n) acc[a][b][m][n] = (f32x4){0.f, 0.f, 0.f, 0.f};
        cur = nxt; cA = nA; cB = nB; ++ui;
        if constexpr (ALIGN_EPI) { if (wr == 1) PG8_BAR; }
    }
    PG8_WAIT_V(0);
    if constexpr (!ALIGN_EPI) { if (wr == 0) PG8_BAR; }
    PG8_BAR;
#undef PG8_SA
#undef PG8_SB
#undef PG8_STAGE
#undef PG8_LDA
#undef PG8_LDB
#undef PG8_MMA
#undef PG8_WAIT_V
#undef PG8_WAIT_L
#undef PG8_BAR
#undef PG8_SCHED
}
}

struct EpiIn {
    static constexpr bool PERM = true, AFTER_DRAIN = false;
    bf16_t* proj; float* aux; float* out;
    __device__ __forceinline__ void operator()(const f32x4 (&acc)[2][2][4][2], const pg8::Unit& u, int wr, int wc, int fr, int fq) const {
        const int row0 = u.pm * 256 + wr * 64 + fr, colb = u.pn * 256 + wc * 32 + 8 * fq, pn = u.pn;
#pragma unroll
        for (int ai = 0; ai < 2; ++ai)
#pragma unroll
            for (int m = 0; m < 4; ++m) {
                const int row = row0 + ai * 128 + m * 16;
#pragma unroll
                for (int bj = 0; bj < 2; ++bj) {
                    const int col = colb + bj * 128;
                    const f32x4 v0 = acc[ai][bj][m][0], v1 = acc[ai][bj][m][1];
                    u32x4 w; w.x = pg8::cvt_pk_bf16(v0[0], v0[1]); w.y = pg8::cvt_pk_bf16(v0[2], v0[3]); w.z = pg8::cvt_pk_bf16(v1[0], v1[1]); w.w = pg8::cvt_pk_bf16(v1[2], v1[3]);
                    *(u32x4*)(proj + (size_t)row * NP + col) = w;
                    float* dst = nullptr;
                    if (pn == 2) {
                        const int c = col - C_K; const int isv = c >= 128; const int cc = c & 127;
                        if (row < MPROMPT) dst = out + (isv ? O_VP : O_KP) + (size_t)row * 128 + cc;
                        else if (row < MVALID) dst = out + (isv ? O_VS : O_KS) + (size_t)(row - MPROMPT) * 128 + cc;
                    } else if (pn == 9) {
                        const int c = col - C_KI;
                        if (c < 64) {
                            if (row < MPROMPT) dst = out + O_KIP + (size_t)row * 64 + c;
                            else if (row < MVALID) dst = out + O_KIS + (size_t)(row - MPROMPT) * 64 + c;
                        } else if (c < 88) dst = aux + (size_t)row * AUXP + (c - 64);
                    } else if (pn >= 10 && pn <= 15) {
                        const int c = col - C_QKV;
                        if (row < MPROMPT) { const int t = row & (SEQ - 1); if (t >= SEQ - 3) dst = out + O_CP + ((size_t)(row >> 11) * 3 + (t - (SEQ - 3))) * 1536 + c; }
                        else if (row < MVALID) dst = out + O_CS + ((size_t)(row - MPROMPT) * 3 + 2) * 1536 + c;
                    }
                    if (dst) { *(f32x4*)dst = v0; *(f32x4*)(dst + 4) = v1; }
                }
            }
    }
};
struct EpiOut {
    static constexpr bool PERM = true, AFTER_DRAIN = false;
    const float* xp; const float* xs; float* out; float* rowss;
    __device__ __forceinline__ void operator()(const f32x4 (&acc)[2][2][4][2], const pg8::Unit& u, int wr, int wc, int fr, int fq) const {
        const int row0 = u.pm * 256 + wr * 64 + fr, colb = u.pn * 256 + wc * 32 + 8 * fq;
#pragma unroll
        for (int ai = 0; ai < 2; ++ai)
#pragma unroll
            for (int m = 0; m < 4; ++m) {
                const int row = row0 + ai * 128 + m * 16;
                float ss = 0.f;
                if (row < MVALID) {
                    const float* xr = row < MPROMPT ? xp + (size_t)row * D_MODEL : xs + (size_t)(row - MPROMPT) * D_MODEL;
#pragma unroll
                    for (int bj = 0; bj < 2; ++bj) {
                        const int col = colb + bj * 128;
                        f32x4 h0 = *(const f32x4*)(xr + col) + acc[ai][bj][m][0], h1 = *(const f32x4*)(xr + col + 4) + acc[ai][bj][m][1];
                        *(f32x4*)(out + (size_t)row * D_MODEL + col) = h0; *(f32x4*)(out + (size_t)row * D_MODEL + col + 4) = h1;
                        ss += (h0[0] * h0[0] + h0[1] * h0[1]) + (h0[2] * h0[2] + h0[3] * h0[3]) + (h1[0] * h1[0] + h1[1] * h1[1]) + (h1[2] * h1[2] + h1[3] * h1[3]);
                    }
                }
                ss += __shfl_xor(ss, 16); ss += __shfl_xor(ss, 32);
                if (fq == 0 && row < MVALID) atomicAdd(rowss + row, ss);
            }
    }
};

struct Params {
    const float* x_prompt; const float* x_sample; const float* cache_k; const float* cache_v; const float* cache_kidx; const float* state_ssm; const float* state_conv;
    const int* page_table; const float* norm_in; const float* w_in; const float* conv_w; const float* a_log; const float* dt_bias; const float* gdn_norm; const float* w_out;
    const float* rel_table; const float* norm_final; float* out; unsigned char* ws;
};

constexpr int NWAVES = 8, NTHR = 512;
constexpr int SCR_BYTES = 144384;
constexpr int MISC_OFF = SCR_BYTES + 320;
constexpr int LDS_BYTES = 147456;
constexpr int CW_BAR = 4096;
typedef GAS unsigned gu32;
#define RLX_AGENT __ATOMIC_RELAXED, __HIP_MEMORY_SCOPE_AGENT
#define LDS_WAIT() asm volatile("s_waitcnt lgkmcnt(0)" ::: "memory")

#define XB_TMO      128
#define XB_XCNT(j)  (256  + 64 * (j))
#define XB_XSUB(j)  (1280 + 64 * (j))
#define XB_XGEN(j)  (2304 + 64 * (j))
#define XB_TOP      3328
#define XB_TOPGEN   3392
#define XCD_BAR_WORDS 3456
#define XB_SPIN_CAP (1u << 22)
__device__ __forceinline__ unsigned xb_ld(unsigned* p)              { return __hip_atomic_load(p, __ATOMIC_RELAXED, __HIP_MEMORY_SCOPE_AGENT); }
__device__ __forceinline__ unsigned xb_add(unsigned* p, unsigned v) { return __hip_atomic_fetch_add(p, v, __ATOMIC_RELAXED, __HIP_MEMORY_SCOPE_AGENT); }
__device__ __forceinline__ unsigned xb_xcc_id() { return (unsigned)__builtin_amdgcn_s_getreg((3 << 11) | 20) & 0xFu; }
#define XB_SPIN(cond, bar) do { unsigned _sp = 0; while (cond) { __builtin_amdgcn_s_sleep(1); \
    if ((++_sp & 255u) == 0u) { if (xb_ld(&(bar)[XB_TMO])) break; if (_sp > XB_SPIN_CAP) { atomicAdd(&(bar)[XB_TMO], 1u); break; } } } } while (0)
struct XcdBarrier { unsigned* bar; unsigned x; volatile LAS unsigned* st; };
__device__ __forceinline__ XcdBarrier xcd_barrier_post(unsigned* bar, volatile LAS unsigned* st) {
    XcdBarrier b; b.bar = bar; b.x = xb_xcc_id(); b.st = st;
    if (threadIdx.x == 0) (void)xb_add(&bar[XB_XCNT(b.x)], 1u);
    return b;
}
__device__ __forceinline__ void xcd_barrier_complete(unsigned* bar, unsigned x, unsigned& nloc, unsigned& nx) {
    const unsigned G = gridDim.x * gridDim.y * gridDim.z;
    unsigned sum, cnt, mine, sp = 0u;
    for (;;) {
        sum = 0u; cnt = 0u; mine = 0u;
#pragma unroll
        for (unsigned j = 0; j < 16; ++j) { const unsigned c = xb_ld(&bar[XB_XCNT(j)]); sum += c; cnt += (c > 0u) ? 1u : 0u; mine = (j == x) ? c : mine; }
        if (sum == G) break;
        __builtin_amdgcn_s_sleep(1);
        if ((++sp & 255u) == 0u) { if (xb_ld(&bar[XB_TMO])) break; if (sp > XB_SPIN_CAP) { atomicAdd(&bar[XB_TMO], 1u); break; } }
    }
    nloc = mine > 0u ? mine : 1u; nx = cnt > 0u ? cnt : 1u;
}
__device__ __forceinline__ void xcd_barrier(const XcdBarrier& b) {
    asm volatile("s_waitcnt vmcnt(0)" ::: "memory");
    __syncthreads();
    if (threadIdx.x == 0) {
        unsigned* bar = b.bar;
        __builtin_amdgcn_s_waitcnt(0);
        unsigned nloc = b.st[0], nx = b.st[1];
        if (nloc == 0u) { xcd_barrier_complete(bar, b.x, nloc, nx); b.st[0] = nloc; b.st[1] = nx; }
        const unsigned old = xb_add(&bar[XB_XSUB(b.x)], 1u);
        const unsigned gen = old / nloc;
        if (old + 1u == (gen + 1u) * nloc) {
            __builtin_amdgcn_fence(__ATOMIC_RELEASE, "agent");
            asm volatile("s_waitcnt vmcnt(0)" ::: "memory");
            const unsigned og = xb_add(&bar[XB_TOP], 1u);
            const unsigned tg = og / nx;
            if (og + 1u == (tg + 1u) * nx) xb_add(&bar[XB_TOPGEN], 1u);
            else XB_SPIN(xb_ld(&bar[XB_TOPGEN]) == tg, bar);
            __builtin_amdgcn_fence(__ATOMIC_ACQUIRE, "agent");
            xb_add(&bar[XB_XGEN(b.x)], 1u);
            asm volatile("s_waitcnt vmcnt(0)" ::: "memory");
        } else {
            XB_SPIN(xb_ld(&bar[XB_XGEN(b.x)]) == gen, bar);
            __builtin_amdgcn_fence(__ATOMIC_ACQUIRE, "agent");
            asm volatile("s_waitcnt vmcnt(0)" ::: "memory");
        }
    }
    __syncthreads();
}

__device__ __forceinline__ int win_src_col(int n) {
    if (n < C_AG) return n;
    if (n < C_AG + 8) return n + 2048;
    if (n < C_QKV) return -1;
    return n - 176;
}
template <bool MAPPED>
__device__ __forceinline__ void transpose_item(const float* W, int K, int N, bf16_t* WT, LAS float* scr, int item, int nblk, int lane) {
    const int kb = item / nblk, nb = item % nblk, k0 = 64 * kb, n0 = 32 * nb;
    const int nd = n0 + (lane & 31); const int src = MAPPED ? win_src_col(nd) : nd;
#pragma unroll 8
    for (int i = 0; i < 32; ++i) { const int kk = 2 * i + (lane >> 5); scr[kk * 33 + (lane & 31)] = src >= 0 ? W[(size_t)(k0 + kk) * N + src] : 0.f; }
    LDS_WAIT();
    const int c = lane & 7;
#pragma unroll
    for (int j = 0; j < 4; ++j) { const int n = (lane >> 3) + 8 * j; const LAS float* s = scr + (8 * c) * 33 + n;
        u32x4 o; o.x = pk2(s[0 * 33], s[1 * 33]); o.y = pk2(s[2 * 33], s[3 * 33]); o.z = pk2(s[4 * 33], s[5 * 33]); o.w = pk2(s[6 * 33], s[7 * 33]);
        *(u32x4*)(WT + (size_t)(n0 + n) * K + k0 + 8 * c) = o; }
    LDS_WAIT();
}
__device__ __forceinline__ void ph_prologue(const Params& p, LAS unsigned char* lds) {
    const int tid = threadIdx.x, lane = tid & 63, wave = tid >> 6;
    const int gw = blockIdx.x * NWAVES + wave, NGW = gridDim.x * NWAVES;
    bf16_t* WINT = (bf16_t*)(p.ws + WS_WINT); bf16_t* WOUTT = (bf16_t*)(p.ws + WS_WOUTT); bf16_t* XN = (bf16_t*)(p.ws + WS_XN);
    LAS float* scr = (LAS float*)(lds + wave * 8448);
    constexpr int I_IN = (1024 / 64) * (NP / 32), I_OUT = (1024 / 64) * (1024 / 32);
    for (int it = gw; it < I_IN + I_OUT; it += NGW) {
        if (it < I_IN) transpose_item<true>(p.w_in, 1024, 4440, WINT, scr, it, NP / 32, lane);
        else transpose_item<false>(p.w_out, 1024, 1024, WOUTT, scr, it - I_IN, 1024 / 32, lane);
    }
    for (int m = gw; m < MP; m += NGW) {
        unsigned long long* o8 = (unsigned long long*)(XN + (size_t)m * D_MODEL) + lane;
        if (m >= MVALID) {
#pragma unroll
            for (int j = 0; j < 4; ++j) o8[64 * j] = 0ull;
            continue;
        }
        const float* xrow = m < MPROMPT ? p.x_prompt + (size_t)m * D_MODEL : p.x_sample + (size_t)(m - MPROMPT) * D_MODEL;
        const f32x4* xr = (const f32x4*)xrow + lane; const f32x4* gr = (const f32x4*)p.norm_in + lane;
        f32x4 v[4]; float s = 0.f;
#pragma unroll
        for (int j = 0; j < 4; ++j) { v[j] = xr[64 * j]; s += (v[j].x * v[j].x + v[j].y * v[j].y) + (v[j].z * v[j].z + v[j].w * v[j].w); }
        const float rs = rsqrtf(wave_sum(s) * (1.f / D_MODEL) + 1e-6f);
#pragma unroll
        for (int j = 0; j < 4; ++j) { const f32x4 g = gr[64 * j]; const f32x4 y = v[j] * rs * g;
            o8[64 * j] = (unsigned long long)pk2(y.x, y.y) | ((unsigned long long)pk2(y.z, y.w) << 32); }
    }
}
__device__ __forceinline__ void ph_final_norm(const Params& p) {
    const int lane = threadIdx.x & 63, gw = blockIdx.x * NWAVES + (threadIdx.x >> 6), NGW = gridDim.x * NWAVES;
    const float* rowss = (const float*)(p.ws + WS_ROWSS);
    for (int m = gw; m < MVALID; m += NGW) {
        const float rs = rsqrtf(rowss[m] * (1.f / D_MODEL) + 1e-6f);
        f32x4* yr = (f32x4*)(p.out + (size_t)m * D_MODEL) + lane; const f32x4* gr = (const f32x4*)p.norm_final + lane;
#pragma unroll
        for (int j = 0; j < 4; ++j) yr[64 * j] = yr[64 * j] * rs * gr[64 * j];
    }
}

__device__ __forceinline__ void nv_idx(const Params& p, LAS unsigned char* lds) {
    const int wave = threadIdx.x >> 6, lane = threadIdx.x & 63;
    LAS float* qs = (LAS float*)(lds + wave * 12800);
    LAS float* scl = qs + 1024;
    LAS float* wh = scl + 64 * 33;
    const bf16_t* proj = (const bf16_t*)(p.ws + WS_PROJ); const float* aux = (const float*)(p.ws + WS_AUX); unsigned* mask = (unsigned*)(p.ws + WS_MASK);
    for (int base = blockIdx.x * NWAVES; base < MPROMPT; base += gridDim.x * NWAVES) {
        const int r = base + wave, b = r >> 11, t = r & (SEQ - 1);
        const bf16_t* qrow = proj + (size_t)r * NP + C_QI;
        for (int i = lane; i < 1024; i += 64) qs[i] = bf2f(qrow[i]) * 0.125f;
        if (lane < 16) wh[lane] = aux[(size_t)r * AUXP + lane] * 0.25f;
        __syncthreads();
        for (int j = 0; j < 32; ++j) {
            const int s = 32 * lane + j;
            float sc = -1e30f;
            if (s <= t) {
                const u32x4* krow = (const u32x4*)(proj + (size_t)(b * SEQ + s) * NP + C_KI);
                float kf[64];
#pragma unroll
                for (int c = 0; c < 8; ++c) unpack8(krow[c], kf + 8 * c);
                sc = 0.f;
                for (int h = 0; h < 16; ++h) {
                    float dot = 0.f;
#pragma unroll
                    for (int d = 0; d < 64; ++d) dot += qs[h * 64 + d] * kf[d];
                    sc += fmaxf(dot, 0.f) * wh[h];
                }
            }
            scl[lane * 33 + j] = sc;
        }
        __syncthreads();
        unsigned key[32];
#pragma unroll
        for (int j = 0; j < 32; ++j) key[j] = f2key(scl[lane * 33 + j]);
        unsigned prefix = 0u;
        for (int bit = 31; bit >= 0; --bit) {
            const unsigned cand = prefix | (1u << bit);
            int c = 0;
#pragma unroll
            for (int j = 0; j < 32; ++j) c += (key[j] >= cand) ? 1 : 0;
            c = wave_sum_i(c);
            if (c >= 256) prefix = cand;
        }
        int cgt = 0, ceq = 0;
#pragma unroll
        for (int j = 0; j < 32; ++j) { cgt += (key[j] > prefix) ? 1 : 0; ceq += (key[j] == prefix) ? 1 : 0; }
        const int need = 256 - wave_sum_i(cgt);
        int run = wave_excl_scan_i(ceq, lane);
        unsigned word = 0u;
#pragma unroll
        for (int j = 0; j < 32; ++j) {
            if (key[j] > prefix) word |= (1u << j);
            else if (key[j] == prefix) { if (run < need) word |= (1u << j); ++run; }
        }
        const int nv = t + 1 - 32 * lane;
        const unsigned vm = nv >= 32 ? 0xffffffffu : (nv <= 0 ? 0u : ((1u << nv) - 1u));
        mask[(size_t)r * 64 + lane] = word & vm;
        __syncthreads();
    }
}

__device__ __forceinline__ void nv_attn(const Params& p, LAS unsigned char* lds) {
    const int wave = threadIdx.x >> 6, lane = threadIdx.x & 63;
    LAS float* bd = (LAS float*)lds;
    LAS float* qs = (LAS float*)(lds + 4096 + wave * 11264);
    LAS int* lst = (LAS int*)(qs + 512);
    LAS float* pl = (LAS float*)(lst + 256);
    const bf16_t* proj = (const bf16_t*)(p.ws + WS_PROJ); const unsigned* mask = (const unsigned*)(p.ws + WS_MASK); bf16_t* mixed = (bf16_t*)(p.ws + WS_MIXED);
    for (int i = threadIdx.x; i < 1024; i += NTHR) bd[i] = p.rel_table[(int)c_bucket[i >> 3] * 8 + (i & 7)];
    for (int base = blockIdx.x * NWAVES; base < MPROMPT; base += gridDim.x * NWAVES) {
        const int r = base + wave, b = r >> 11, t = r & (SEQ - 1);
        const bf16_t* qrow = proj + (size_t)r * NP + C_Q;
        for (int i = lane; i < 512; i += 64) qs[i] = bf2f(qrow[i]) * 0.125f;
        const unsigned word = mask[(size_t)r * 64 + lane];
        const int cnt = __popc(word);
        int pos = wave_excl_scan_i(cnt, lane);
        const int nsel = wave_sum_i(cnt);
        { unsigned w = word; while (w) { const int j = __ffs(w) - 1; lst[pos++] = 32 * lane + j; w &= w - 1u; } }
        __syncthreads();
        for (int i = lane; i < nsel; i += 64) {
            const int s = lst[i]; int dn = t - s; dn = dn > 127 ? 127 : dn;
            for (int g = 0; g < 2; ++g) {
                const u32x4* krow = (const u32x4*)(proj + (size_t)(b * SEQ + s) * NP + C_K + g * 64);
                float kf[64];
#pragma unroll
                for (int c = 0; c < 8; ++c) unpack8(krow[c], kf + 8 * c);
                for (int hh = 0; hh < 4; ++hh) {
                    const int h = g * 4 + hh; float dot = 0.f;
#pragma unroll
                    for (int d = 0; d < 64; ++d) dot += qs[h * 64 + d] * kf[d];
                    pl[h * 256 + i] = dot + bd[dn * 8 + h];
                }
            }
        }
        __syncthreads();
        for (int h = 0; h < 8; ++h) {
            float m = -3.0e38f;
            for (int i = lane; i < nsel; i += 64) m = fmaxf(m, pl[h * 256 + i]);
            m = wave_max(m);
            float sum = 0.f;
            for (int i = lane; i < nsel; i += 64) { const float e = __expf(pl[h * 256 + i] - m); pl[h * 256 + i] = e; sum += e; }
            const float inv = 1.f / wave_sum(sum);
            for (int i = lane; i < nsel; i += 64) pl[h * 256 + i] *= inv;
        }
        __syncthreads();
        for (int g = 0; g < 2; ++g) {
            float acc0 = 0.f, acc1 = 0.f, acc2 = 0.f, acc3 = 0.f;
            for (int i = 0; i < nsel; ++i) {
                const int s = lst[i];
                const float v = bf2f(proj[(size_t)(b * SEQ + s) * NP + C_V + g * 64 + lane]);
                acc0 += pl[(g * 4 + 0) * 256 + i] * v; acc1 += pl[(g * 4 + 1) * 256 + i] * v; acc2 += pl[(g * 4 + 2) * 256 + i] * v; acc3 += pl[(g * 4 + 3) * 256 + i] * v;
            }
            const bf16_t* zr = proj + (size_t)r * NP + C_ZA + g * 256 + lane; bf16_t* mr = mixed + (size_t)r * D_MODEL + g * 256 + lane;
            mr[0] = (bf16_t)f2bf(acc0 * silu_f(bf2f(zr[0]))); mr[64] = (bf16_t)f2bf(acc1 * silu_f(bf2f(zr[64])));
            mr[128] = (bf16_t)f2bf(acc2 * silu_f(bf2f(zr[128]))); mr[192] = (bf16_t)f2bf(acc3 * silu_f(bf2f(zr[192])));
        }
        __syncthreads();
    }
}

template <int MODE>
__device__ __forceinline__ void nv_gdn_unit(const Params& p, LAS unsigned char* lds, int unit) {
    LAS float* qkv_s = (LAS float*)lds;
    LAS float* red = qkv_s + 384;
    LAS float* sc = red + 1024;
    const int tid = threadIdx.x, lane = tid & 63, wave = tid >> 6;
    const int b = unit >> 2, h = unit & 3;
    const int T = MODE ? 1 : SEQ; const int row0 = MODE ? MPROMPT + b : b * SEQ;
    const int e = tid & 127, sl = tid >> 7;
    const bf16_t* proj = (const bf16_t*)(p.ws + WS_PROJ); const float* aux = (const float*)(p.ws + WS_AUX); bf16_t* mixed = (bf16_t*)(p.ws + WS_MIXED);
    float S[32];
#pragma unroll
    for (int i = 0; i < 32; ++i) S[i] = MODE ? p.state_ssm[((size_t)(b * 4 + h) * 128 + sl * 32 + i) * 128 + e] : 0.f;
    const int part = tid >> 7, ci = tid & 127, c = part * 512 + h * 128 + ci;
    float w0 = 0.f, w1 = 0.f, w2 = 0.f, w3 = 0.f, x0 = 0.f, x1 = 0.f, x2 = 0.f;
    if (tid < 384) {
        w0 = p.conv_w[0 * 1536 + c]; w1 = p.conv_w[1 * 1536 + c]; w2 = p.conv_w[2 * 1536 + c]; w3 = p.conv_w[3 * 1536 + c];
        if (MODE) { x0 = p.state_conv[((size_t)b * 3 + 0) * 1536 + c]; x1 = p.state_conv[((size_t)b * 3 + 1) * 1536 + c]; x2 = p.state_conv[((size_t)b * 3 + 2) * 1536 + c]; }
    }
    const float A = __expf(p.a_log[h]), dtb = p.dt_bias[h], gn = p.gdn_norm[e];
    for (int t = 0; t < T; ++t) {
        const size_t r = (size_t)(row0 + t);
        if (tid < 384) {
            float x3;
            if (MODE) x3 = p.out[O_CS + ((size_t)b * 3 + 2) * 1536 + c];
            else x3 = bf2f(proj[r * NP + C_QKV + c]);
            const float y = x0 * w0 + x1 * w1 + x2 * w2 + x3 * w3;
            x0 = x1; x1 = x2; x2 = x3;
            qkv_s[tid] = silu_f(y);
        }
        __syncthreads();
        if (wave == 0) { const float a = qkv_s[lane], a2 = qkv_s[lane + 64]; const float s = wave_sum(a * a + a2 * a2); if (lane == 0) sc[0] = s; }
        else if (wave == 1) { const float a = qkv_s[128 + lane], a2 = qkv_s[192 + lane]; const float s = wave_sum(a * a + a2 * a2); if (lane == 0) sc[1] = s; }
        else if (wave == 2) { const float s = wave_sum(qkv_s[lane] * qkv_s[128 + lane] + qkv_s[lane + 64] * qkv_s[192 + lane]); if (lane == 0) sc[2] = s; }
        __syncthreads();
        const float qn = rsqrtf(sc[0] + 1e-6f) * 0.08838834764831845f, kn = rsqrtf(sc[1] + 1e-6f), qk = sc[2] * qn * kn;
        const float ag = aux[r * AUXP + 16 + h], bg = aux[r * AUXP + 20 + h];
        const float xg = ag + dtb;
        const float sp = xg > 20.f ? xg : log1pf(__expf(xg));
        const float dec = __expf(-A * sp), beta = 1.f / (1.f + __expf(-bg));
        float pk = 0.f, pq = 0.f;
#pragma unroll
        for (int i = 0; i < 32; ++i) { const int d = sl * 32 + i; S[i] *= dec; pk += qkv_s[128 + d] * S[i]; pq += qkv_s[d] * S[i]; }
        red[sl * 128 + e] = pk * kn; red[512 + sl * 128 + e] = pq * qn;
        __syncthreads();
        const float kv = (red[e] + red[128 + e]) + (red[256 + e] + red[384 + e]);
        const float qS = (red[512 + e] + red[640 + e]) + (red[768 + e] + red[896 + e]);
        const float delta = (qkv_s[256 + e] - kv) * beta;
        const float o = qS + qk * delta;
#pragma unroll
        for (int i = 0; i < 32; ++i) { const int d = sl * 32 + i; S[i] += qkv_s[128 + d] * kn * delta; }
        if (sl == 0) { const float s = wave_sum(o * o); if (lane == 0) sc[4 + wave] = s; }
        __syncthreads();
        if (sl == 0) {
            const float rs = rsqrtf((sc[4] + sc[5]) * (1.f / 128.f) + 1e-6f);
            const float z = bf2f(proj[r * NP + C_ZG + h * 128 + e]);
            mixed[r * D_MODEL + 512 + h * 128 + e] = (bf16_t)f2bf(o * rs * gn * silu_f(z));
        }
    }
    float* So = p.out + (MODE ? O_SSMS : O_SSMP);
#pragma unroll
    for (int i = 0; i < 32; ++i) So[((size_t)(b * 4 + h) * 128 + sl * 32 + i) * 128 + e] = S[i];
    __syncthreads();
}

__device__ __forceinline__ void nv_sample_unit(const Params& p, LAS unsigned char* lds, int b) {
    LAS float* scs = (LAS float*)lds;
    LAS float* qs = scs + 8704;
    LAS float* wh = qs + 1024;
    LAS int* lst = (LAS int*)(wh + 16);
    LAS int* eql = lst + 256;
    LAS int* cnts = eql + 64;
    LAS float* pl = (LAS float*)(cnts + 16);
    LAS float* qa = pl + 2048;
    const int tid = threadIdx.x, lane = tid & 63, wave = tid >> 6;
    const size_t r = (size_t)MPROMPT + b;
    const bf16_t* proj = (const bf16_t*)(p.ws + WS_PROJ); const float* aux = (const float*)(p.ws + WS_AUX); bf16_t* mixed = (bf16_t*)(p.ws + WS_MIXED);
    for (int i = tid; i < 1024; i += NTHR) qs[i] = bf2f(proj[r * NP + C_QI + i]) * 0.125f;
    qa[tid] = bf2f(proj[r * NP + C_Q + tid]) * 0.125f;
    if (tid < 16) wh[tid] = aux[r * AUXP + tid] * 0.25f;
    if (tid < 16) cnts[tid] = 0;
    for (int i = tid; i < 2 * 1536; i += NTHR) p.out[O_CS + (size_t)b * 3 * 1536 + i] = p.state_conv[(size_t)b * 3 * 1536 + 1536 + i];
    __syncthreads();
    for (int i = 0; i < 17; ++i) {
        const int s = tid + 512 * i;
        float sc = -3.0e38f;
        if (s <= PAST) {
            const float* krow = s < PAST ? p.cache_kidx + ((size_t)p.page_table[b * NPAGES + (s >> 7)] * PAGE + (s & 127)) * 64 : p.out + O_KIS + (size_t)b * 64;
            float kf[64];
#pragma unroll
            for (int c = 0; c < 16; ++c) { const f32x4 v = ((const f32x4*)krow)[c]; kf[4 * c] = v.x; kf[4 * c + 1] = v.y; kf[4 * c + 2] = v.z; kf[4 * c + 3] = v.w; }
            sc = 0.f;
            for (int h = 0; h < 16; ++h) {
                float dot = 0.f;
#pragma unroll
                for (int d = 0; d < 64; ++d) dot += qs[h * 64 + d] * kf[d];
                sc += fmaxf(dot, 0.f) * wh[h];
            }
        }
        scs[s] = sc;
    }
    __syncthreads();
    unsigned key[17];
#pragma unroll
    for (int i = 0; i < 17; ++i) { const int s = tid + 512 * i; key[i] = s <= PAST ? f2key(scs[s]) : 0u; }
    unsigned prefix = 0u;
    for (int bit = 31; bit >= 0; --bit) {
        const unsigned cand = prefix | (1u << bit);
        int c = 0;
#pragma unroll
        for (int i = 0; i < 17; ++i) c += (key[i] >= cand) ? 1 : 0;
        c = wave_sum_i(c);
        if (lane == 0) cnts[8 + wave] = c;
        __syncthreads();
        int tot = 0;
#pragma unroll
        for (int w = 0; w < 8; ++w) tot += cnts[8 + w];
        __syncthreads();
        if (tot >= 256) prefix = cand;
    }
#pragma unroll
    for (int i = 0; i < 17; ++i) {
        const int s = tid + 512 * i;
        if (key[i] > prefix) { const int pos = atomicAdd((int*)&cnts[0], 1); if (pos < 256) lst[pos] = s; }
        else if (key[i] == prefix && s <= PAST) { const int pos = atomicAdd((int*)&cnts[1], 1); if (pos < 64) eql[pos] = s; }
    }
    __syncthreads();
    const int ngt = cnts[0], neq = cnts[1] < 64 ? cnts[1] : 64, need = 256 - ngt;
    __syncthreads();
    if (tid < neq) {
        const int s = eql[tid]; int rank = 0;
        for (int j = 0; j < neq; ++j) rank += (eql[j] < s) ? 1 : 0;
        if (rank < need) { const int pos = atomicAdd((int*)&cnts[0], 1); if (pos < 256) lst[pos] = s; }
    }
    __syncthreads();
    {
        const int i = tid & 255, g = tid >> 8;
        const int s = lst[i]; int dn = PAST - s; dn = dn > 127 ? 127 : dn;
        const float* krow = s < PAST ? p.cache_k + (((size_t)p.page_table[b * NPAGES + (s >> 7)] * PAGE + (s & 127)) * 2 + g) * 64 : p.out + O_KS + (size_t)b * 128 + g * 64;
        float kf[64];
#pragma unroll
        for (int c = 0; c < 16; ++c) { const f32x4 v = ((const f32x4*)krow)[c]; kf[4 * c] = v.x; kf[4 * c + 1] = v.y; kf[4 * c + 2] = v.z; kf[4 * c + 3] = v.w; }
        for (int hh = 0; hh < 4; ++hh) {
            const int h = g * 4 + hh; float dot = 0.f;
#pragma unroll
            for (int d = 0; d < 64; ++d) dot += qa[h * 64 + d] * kf[d];
            pl[h * 256 + i] = dot + p.rel_table[(int)c_bucket[dn] * 8 + h];
        }
    }
    __syncthreads();
    {
        const int h = wave;
        float v[4]; float m = -3.0e38f;
#pragma unroll
        for (int j = 0; j < 4; ++j) { v[j] = pl[h * 256 + lane + 64 * j]; m = fmaxf(m, v[j]); }
        m = wave_max(m);
        float sum = 0.f;
#pragma unroll
        for (int j = 0; j < 4; ++j) { v[j] = __expf(v[j] - m); sum += v[j]; }
        const float inv = 1.f / wave_sum(sum);
#pragma unroll
        for (int j = 0; j < 4; ++j) pl[h * 256 + lane + 64 * j] = v[j] * inv;
    }
    __syncthreads();
    {
        const int d = tid & 63, h = tid >> 6, g = h >> 2;
        float acc = 0.f;
        for (int i = 0; i < 256; ++i) {
            const int s = lst[i];
            const float* vrow = s < PAST ? p.cache_v + (((size_t)p.page_table[b * NPAGES + (s >> 7)] * PAGE + (s & 127)) * 2 + g) * 64 : p.out + O_VS + (size_t)b * 128 + g * 64;
            acc += pl[h * 256 + i] * vrow[d];
        }
        const float z = bf2f(proj[r * NP + C_ZA + h * 64 + d]);
        mixed[r * D_MODEL + h * 64 + d] = (bf16_t)f2bf(acc * silu_f(z));
    }
    __syncthreads();
}

typedef _Float16 half_t;
constexpr int SCP = 2048;
constexpr int DSA_MK_OFF = 32 * SCP * 2;
__device__ __forceinline__ bf16x8 pack8_scaled(const u32x4 raw, float sc) {
    float f[8]; unpack8(raw, f);
    u32x4 o; o.x = pk2(f[0] * sc, f[1] * sc); o.y = pk2(f[2] * sc, f[3] * sc); o.z = pk2(f[4] * sc, f[5] * sc); o.w = pk2(f[6] * sc, f[7] * sc);
    return __builtin_bit_cast(bf16x8, o);
}
__device__ __forceinline__ void dsa_idx_unit(const Params& p, LAS unsigned char* lds, int b, int qb) {
    const int tid = threadIdx.x, lane = tid & 63, wave = __builtin_amdgcn_readfirstlane(tid >> 6);
    const int t0 = qb * 32, qh = wave & 1, kr = wave >> 1, q = lane & 15, g = lane >> 4;
    LAS unsigned short* SC = (LAS unsigned short*)lds;
    LAS unsigned* MK = (LAS unsigned*)(lds + DSA_MK_OFF);
    const bf16_t* proj = (const bf16_t*)(p.ws + WS_PROJ); const float* aux = (const float*)(p.ws + WS_AUX); unsigned* mask = (unsigned*)(p.ws + WS_MASK);
    {
        const size_t qrow = (size_t)(b * SEQ + t0 + 16 * qh + q);
        bf16x8 Qf[16][2]; unsigned sgn = 0u;
#pragma unroll
        for (int h = 0; h < 16; ++h) {
            const float w = aux[qrow * AUXP + h]; const float aw = fabsf(w) * (1.f / 32.f); if (w < 0.f) sgn |= 1u << h;
#pragma unroll
            for (int s = 0; s < 2; ++s) Qf[h][s] = pack8_scaled(*(const u32x4*)(proj + qrow * NP + C_QI + h * 64 + 32 * s + 8 * g), aw);
        }
        const int nkt = 2 * qb + 1 + qh;
        const bf16_t* kbase = proj + (size_t)(b * SEQ + q) * NP + C_KI + 8 * g;
        for (int kt = kr; kt < nkt; kt += 4) {
            const bf16_t* kp = kbase + (size_t)(16 * kt) * NP;
            const bf16x8 A0 = *(const bf16x8*)kp, A1 = *(const bf16x8*)(kp + 32);
            f32x4 sc = {0.f, 0.f, 0.f, 0.f};
#pragma unroll
            for (int h = 0; h < 16; ++h) {
                f32x4 acc = {0.f, 0.f, 0.f, 0.f};
                acc = __builtin_amdgcn_mfma_f32_16x16x32_bf16(A0, Qf[h][0], acc, 0, 0, 0);
                acc = __builtin_amdgcn_mfma_f32_16x16x32_bf16(A1, Qf[h][1], acc, 0, 0, 0);
                const float sg = ((sgn >> h) & 1u) ? -1.f : 1.f;
                sc[0] += sg * fmaxf(acc[0], 0.f); sc[1] += sg * fmaxf(acc[1], 0.f); sc[2] += sg * fmaxf(acc[2], 0.f); sc[3] += sg * fmaxf(acc[3], 0.f);
            }
            const unsigned lo = (unsigned)__builtin_bit_cast(unsigned short, (half_t)sc[0]) | ((unsigned)__builtin_bit_cast(unsigned short, (half_t)sc[1]) << 16);
            const unsigned hi = (unsigned)__builtin_bit_cast(unsigned short, (half_t)sc[2]) | ((unsigned)__builtin_bit_cast(unsigned short, (half_t)sc[3]) << 16);
            *(LAS unsigned long long*)(SC + (16 * qh + q) * SCP + 16 * kt + 4 * g) = (unsigned long long)lo | ((unsigned long long)hi << 32);
        }
    }
    __syncthreads();
    for (int qi = 0; qi < 4; ++qi) {
        const int ql = wave * 4 + qi, qpos = t0 + ql;
        const int nv = qpos + 1 - 32 * lane;
        const unsigned vm = nv >= 32 ? 0xffffffffu : (nv <= 0 ? 0u : ((1u << nv) - 1u));
        unsigned word = vm;
        if (qpos >= 256) {
            const LAS u32x4* src = (const LAS u32x4*)(SC + ql * SCP + 32 * lane);
            unsigned key[32];
#pragma unroll
            for (int c = 0; c < 4; ++c) {
                const u32x4 v = src[c];
#pragma unroll
                for (int e = 0; e < 4; ++e) {
                    unsigned x = v[e];
                    const unsigned neg = ((x >> 15) & 0x00010001u) * 0xFFFFu;
                    x ^= (neg | 0x80008000u);
                    key[8 * c + 2 * e] = x & 0xFFFFu; key[8 * c + 2 * e + 1] = x >> 16;
                }
            }
#pragma unroll
            for (int j = 0; j < 32; ++j) if (j >= nv) key[j] = 0u;
            unsigned prefix = 0u;
            for (int bit = 15; bit >= 0; --bit) {
                const unsigned cand = prefix | (1u << bit);
                int c = 0;
#pragma unroll
                for (int j = 0; j < 32; ++j) c += __popcll(__ballot(key[j] >= cand));
                if (c >= 256) prefix = cand;
            }
            int cgt = 0, ceq = 0;
#pragma unroll
            for (int j = 0; j < 32; ++j) { cgt += __popcll(__ballot(key[j] > prefix)); ceq += (key[j] == prefix) ? 1 : 0; }
            const int need = 256 - cgt;
            int run = wave_excl_scan_i(ceq, lane);
            word = 0u;
#pragma unroll
            for (int j = 0; j < 32; ++j) {
                if (key[j] > prefix) word |= (1u << j);
                else if (key[j] == prefix) { if (run < need) word |= (1u << j); ++run; }
            }
            word &= vm;
        }
        MK[ql * 65 + lane] = word;
    }
    __syncthreads();
}
typedef float f32x16 __attribute__((ext_vector_type(16)));
typedef short s16x4 __attribute__((ext_vector_type(4)));
constexpr int KVP = 272, KVT = 32 * KVP;
constexpr int DSA_BD_OFF = DSA_MK_OFF + 32 * 65 * 4;
static_assert(DSA_BD_OFF + 8 * 128 * 4 <= SCR_BYTES, "LDS map");
__device__ __forceinline__ s16x4 tr16(const LAS unsigned char* p) { return __builtin_bit_cast(s16x4, __builtin_amdgcn_ds_read_tr16_b64_v4i16((LAS s16x4*)p)); }
__device__ __forceinline__ void dsa_fill_bias(const Params& p, LAS unsigned char* lds) {
    LAS float* BD = (LAS float*)(lds + DSA_BD_OFF);
    for (int i = threadIdx.x; i < 1024; i += NTHR) { const int h = i >> 7, n = i & 127; BD[i] = p.rel_table[(int)c_bucket[n] * 8 + h] * 1.4426950408889634f; }
    __syncthreads();
}
__device__ __forceinline__ void dsa_attn_stage(const Params& p, LAS unsigned char* lds, int b, int qb) {
    const int tid = threadIdx.x, lane = tid & 63, wave = __builtin_amdgcn_readfirstlane(tid >> 6);
    const int g = wave >> 2, r = lane & 31, hh = lane >> 5, t0 = qb * 32;
    const LAS unsigned* MK = (const LAS unsigned*)(lds + DSA_MK_OFF);
    const LAS float* BD = (const LAS float*)(lds + DSA_BD_OFF) + wave * 128;
    const bf16_t* proj = (const bf16_t*)(p.ws + WS_PROJ); bf16_t* mixed = (bf16_t*)(p.ws + WS_MIXED);
    const size_t qrow = (size_t)(b * SEQ + t0 + r);
    bf16x8 Qf[4];
#pragma unroll
    for (int s = 0; s < 4; ++s) Qf[s] = *(const bf16x8*)(proj + qrow * NP + C_Q + wave * 64 + 16 * s + 8 * hh);
    f32x16 O0, O1;
#pragma unroll
    for (int i = 0; i < 16; ++i) { O0[i] = 0.f; O1[i] = 0.f; }
    float m = -1e30f, l = 0.f;
    const float c31 = BD[127];
    const int nkt = qb + 1, qpos = t0 + r;
    const int skey = tid >> 4, sch = tid & 15;
    const bf16_t* sbase = proj + (size_t)(b * SEQ + skey) * NP + C_K + 16 * sch;
    const unsigned sdst = (unsigned)(skey * KVP + (sch & 7) * 32 + (sch >> 3) * KVT);
    u32x4 st0 = *(const u32x4*)sbase, st1 = *(const u32x4*)(sbase + 8);
    *(LAS u32x4*)(lds + sdst) = st0; *(LAS u32x4*)(lds + sdst + 16) = st1;
    __syncthreads();
    const int i16 = lane & 15, G1 = (lane >> 4) & 1;
    const unsigned vlane = (unsigned)((4 * hh + (i16 >> 2)) * KVP + g * 128 + (16 * G1 + 4 * (i16 & 3)) * 2);
    const unsigned klane = (unsigned)(r * KVP + g * 128 + hh * 16);
    for (int kt = 0; kt < nkt; ++kt) {
        const int cur = kt & 1;
        const bool more = (kt + 1 < nkt);
        if (more) { const bf16_t* sp = sbase + (size_t)(32 * (kt + 1)) * NP; st0 = *(const u32x4*)sp; st1 = *(const u32x4*)(sp + 8); }
        const LAS unsigned char* Kb = lds + cur * (2 * KVT); const LAS unsigned char* Vb = Kb + KVT;
        f32x16 acc;
#pragma unroll
        for (int i = 0; i < 16; ++i) acc[i] = 0.f;
#pragma unroll
        for (int s = 0; s < 4; ++s) { const bf16x8 Kf = *(const LAS bf16x8*)(Kb + klane + s * 32); acc = __builtin_amdgcn_mfma_f32_32x32x16_bf16(Kf, Qf[s], acc, 0, 0, 0); }
        const unsigned wsh = MK[r * 65 + kt] >> (4 * hh);
        const int kb0 = 32 * kt + 4 * hh;
        float x[16];
        if (t0 - 32 * kt - 31 >= 113) {
#pragma unroll
            for (int i = 0; i < 16; ++i) x[i] = acc[i] * 0.18033688011112042f + c31;
        } else {
#pragma unroll
            for (int i = 0; i < 16; ++i) { int d = qpos - (kb0 + (i & 3) + 8 * (i >> 2)); d = d < 0 ? 0 : (d > 127 ? 127 : d); x[i] = acc[i] * 0.18033688011112042f + BD[d]; }
        }
        float tmax = -INFINITY;
#pragma unroll
        for (int i = 0; i < 16; ++i) { x[i] = ((wsh >> ((i & 3) + 8 * (i >> 2))) & 1u) ? x[i] : -INFINITY; tmax = fmaxf(tmax, x[i]); }
        tmax = fmaxf(tmax, __shfl_xor(tmax, 32));
        if (!__all(tmax - m <= 8.f)) {
            const float mn = fmaxf(m, tmax), alpha = __builtin_amdgcn_exp2f(m - mn);
#pragma unroll
            for (int i = 0; i < 16; ++i) { O0[i] *= alpha; O1[i] *= alpha; }
            l *= alpha; m = mn;
        }
        float ps = 0.f;
#pragma unroll
        for (int i = 0; i < 16; ++i) { x[i] = __builtin_amdgcn_exp2f(x[i] - m); ps += x[i]; }
        l += ps;
        u32x4 pw0, pw1;
        pw0.x = pk2(x[0], x[1]); pw0.y = pk2(x[2], x[3]); pw0.z = pk2(x[4], x[5]); pw0.w = pk2(x[6], x[7]);
        pw1.x = pk2(x[8], x[9]); pw1.y = pk2(x[10], x[11]); pw1.z = pk2(x[12], x[13]); pw1.w = pk2(x[14], x[15]);
        const bf16x8 P0 = __builtin_bit_cast(bf16x8, pw0), P1 = __builtin_bit_cast(bf16x8, pw1);
#pragma unroll
        for (int s = 0; s < 2; ++s) {
            const bf16x8 Ps = s ? P1 : P0;
#pragma unroll
            for (int c = 0; c < 2; ++c) {
                const s16x4 lo = tr16(Vb + vlane + (16 * s) * KVP + c * 64), hi = tr16(Vb + vlane + (16 * s + 8) * KVP + c * 64);
                const bf16x8 Vf = (bf16x8){lo[0], lo[1], lo[2], lo[3], hi[0], hi[1], hi[2], hi[3]};
                if (c == 0) O0 = __builtin_amdgcn_mfma_f32_32x32x16_bf16(Vf, Ps, O0, 0, 0, 0);
                else O1 = __builtin_amdgcn_mfma_f32_32x32x16_bf16(Vf, Ps, O1, 0, 0, 0);
            }
        }
        if (more) { LAS unsigned char* d = lds + (cur ^ 1) * (2 * KVT) + sdst; *(LAS u32x4*)d = st0; *(LAS u32x4*)(d + 16) = st1; }
        __syncthreads();
    }
    l += __shfl_xor(l, 32);
    const float inv = 1.f / l;
#pragma unroll
    for (int c = 0; c < 2; ++c)
#pragma unroll
        for (int rg = 0; rg < 4; ++rg) {
            const int d0 = 32 * c + 8 * rg + 4 * hh;
            const unsigned long long zz = *(const unsigned long long*)(proj + qrow * NP + C_ZA + wave * 64 + d0);
            const float z0 = bf2f((unsigned short)(zz & 0xffff)), z1 = bf2f((unsigned short)((zz >> 16) & 0xffff)), z2 = bf2f((unsigned short)((zz >> 32) & 0xffff)), z3 = bf2f((unsigned short)(zz >> 48));
            const float o0 = (c ? O1[4 * rg] : O0[4 * rg]) * inv, o1 = (c ? O1[4 * rg + 1] : O0[4 * rg + 1]) * inv, o2 = (c ? O1[4 * rg + 2] : O0[4 * rg + 2]) * inv, o3 = (c ? O1[4 * rg + 3] : O0[4 * rg + 3]) * inv;
            const unsigned long long w = (unsigned long long)pk2(o0 * silu_f(z0), o1 * silu_f(z1)) | ((unsigned long long)pk2(o2 * silu_f(z2), o3 * silu_f(z3)) << 32);
            *(unsigned long long*)(mixed + qrow * D_MODEL + wave * 64 + d0) = w;
        }
}
__device__ __forceinline__ void dsa_unit_of(int w, int k, int& b, int& qb) {
    const int u = w + 256 * k; b = u & 31; const int a = (w >> 5) & 7; const int j = 8 * k + ((k & 1) ? 7 - a : a); qb = 63 - j;
}

constexpr int N_PHASES = 5;
struct Args { Params p; int ph_lo, ph_hi; };
__global__ void __launch_bounds__(NTHR, 2) mk_fwd(Args a) {
    extern __shared__ __attribute__((aligned(16))) unsigned char lds_raw[];
    LAS unsigned char* lds = (LAS unsigned char*)lds_raw;
    const Params& p = a.p;
    volatile LAS unsigned* MISC = (volatile LAS unsigned*)(lds + MISC_OFF);
    for (int u = threadIdx.x; u < (LDS_BYTES - SCR_BYTES) / 4; u += NTHR) ((LAS unsigned*)(lds + SCR_BYTES))[u] = 0u;
    __syncthreads();
    const int lo = a.ph_lo, hi = a.ph_hi;
    const bool multi = (hi - lo) > 1;
    XcdBarrier bar; bar.bar = (unsigned*)(p.ws + WS_CTL) + CW_BAR; bar.x = 0; bar.st = nullptr;
    if (multi) bar = xcd_barrier_post((unsigned*)(p.ws + WS_CTL) + CW_BAR, MISC + 8);
#define IN(k) (lo <= (k) && (k) < hi)
#define SEAM(k) do { if (IN(k) && IN((k) + 1)) xcd_barrier(bar); } while (0)
    if (IN(0)) { ph_prologue(p, lds); __syncthreads(); }
    SEAM(0);
    if (IN(1)) {
        pg8::Gemm g{(const bf16_t*)(p.ws + WS_XN), (const bf16_t*)(p.ws + WS_WINT), MP, NP, 1024};
        pg8::StaticOrder S; S.init(MP, NP, gridDim.x, blockIdx.x);
        EpiIn E{(bf16_t*)(p.ws + WS_PROJ), (float*)(p.ws + WS_AUX), p.out};
        pg8::gemm_phase<EpiIn, pg8::StaticOrder, true, true>(lds, g, S, E);
    }
    SEAM(1);
    if (IN(2)) {
        for (int u = blockIdx.x; u < BATCH * 4; u += gridDim.x) nv_gdn_unit<0>(p, lds, u);
        for (int u = (int)gridDim.x - 1 - (int)blockIdx.x; u < DEC_BATCH; u += gridDim.x) nv_sample_unit(p, lds, u);
        for (int u = blockIdx.x; u < DEC_BATCH * 4; u += gridDim.x) nv_gdn_unit<1>(p, lds, u);
        dsa_fill_bias(p, lds);
        if (gridDim.x == 256) { for (int k = 0; k < 8; ++k) { int b, qb; dsa_unit_of(blockIdx.x, k, b, qb); dsa_idx_unit(p, lds, b, qb); dsa_attn_stage(p, lds, b, qb); } }
        else { for (int u = blockIdx.x; u < BATCH * 64; u += gridDim.x) { dsa_idx_unit(p, lds, u & 31, 63 - (u >> 5)); dsa_attn_stage(p, lds, u & 31, 63 - (u >> 5)); } }
    }
    SEAM(2);
    if (IN(3)) {
        pg8::Gemm g{(const bf16_t*)(p.ws + WS_MIXED), (const bf16_t*)(p.ws + WS_WOUTT), MP, 1024, 1024};
        pg8::StaticOrder S; S.init(MP, 1024, gridDim.x, blockIdx.x);
        EpiOut E{p.x_prompt, p.x_sample, p.out, (float*)(p.ws + WS_ROWSS)};
        pg8::gemm_phase<EpiOut, pg8::StaticOrder, true, true>(lds, g, S, E);
    }
    SEAM(3);
    if (IN(4)) ph_final_norm(p);
#undef IN
#undef SEAM
}

#ifndef MK_N_LAUNCHES
#define MK_N_LAUNCHES 1
#endif
extern "C" void kernel_launch(void* const* d_in, const int* in_sizes, int n_in, void* d_out, int out_size, void* d_ws, size_t ws_size, hipStream_t stream) {
    static int grid = 0;
    if (grid == 0) {
        if (n_in != 17 || (size_t)out_size != O_END || ws_size < WS_END) { fprintf(stderr, "kernel_launch: unexpected shapes n_in %d out %d ws %zu\n", n_in, out_size, ws_size); grid = -1; return; }
        int dev = 0, cus = 0, per_cu = 0;
        if (hipGetDevice(&dev) != hipSuccess || hipDeviceGetAttribute(&cus, hipDeviceAttributeMultiprocessorCount, dev) != hipSuccess) { grid = -1; return; }
        if (hipFuncSetAttribute((const void*)mk_fwd, hipFuncAttributeMaxDynamicSharedMemorySize, LDS_BYTES) != hipSuccess) { fprintf(stderr, "kernel_launch: hipFuncSetAttribute failed\n"); grid = -1; return; }
        if (hipOccupancyMaxActiveBlocksPerMultiprocessor(&per_cu, (const void*)mk_fwd, NTHR, LDS_BYTES) != hipSuccess || per_cu < 1) { fprintf(stderr, "kernel_launch: occupancy query says %d blocks per CU\n", per_cu); (void)hipGetLastError(); }
        grid = cus;
    }
    if (grid < 0) return;
    Args a{};
    Params& p = a.p;
    p.x_prompt = (const float*)d_in[0]; p.x_sample = (const float*)d_in[1]; p.cache_k = (const float*)d_in[2]; p.cache_v = (const float*)d_in[3]; p.cache_kidx = (const float*)d_in[4];
    p.state_ssm = (const float*)d_in[5]; p.state_conv = (const float*)d_in[6]; p.page_table = (const int*)d_in[7]; p.norm_in = (const float*)d_in[8]; p.w_in = (const float*)d_in[9];
    p.conv_w = (const float*)d_in[10]; p.a_log = (const float*)d_in[11]; p.dt_bias = (const float*)d_in[12]; p.gdn_norm = (const float*)d_in[13]; p.w_out = (const float*)d_in[14];
    p.rel_table = (const float*)d_in[15]; p.norm_final = (const float*)d_in[16]; p.out = (float*)d_out; p.ws = (unsigned char*)d_ws;
    (void)hipMemsetAsync((char*)d_ws + WS_CTL, 0, CTL_BYTES, stream);
#if MK_N_LAUNCHES == 1
    a.ph_lo = 0; a.ph_hi = N_PHASES;
    hipLaunchKernelGGL(mk_fwd, dim3(grid), dim3(NTHR), LDS_BYTES, stream, a);
#else
    for (int k = 0; k < N_PHASES; ++k) { a.ph_lo = k; a.ph_hi = k + 1; hipLaunchKernelGGL(mk_fwd, dim3(grid), dim3(NTHR), LDS_BYTES, stream, a); }
#endif
}
```

```cpp
#include <hip/hip_runtime.h>
#include <cstdio>
#include <cstdint>

#define LAS __attribute__((address_space(3)))
#define GAS __attribute__((address_space(1)))
typedef unsigned short bf16_t;
typedef short bf16x8 __attribute__((ext_vector_type(8)));
typedef float f32x4 __attribute__((ext_vector_type(4)));
typedef unsigned u32x4 __attribute__((ext_vector_type(4)));
typedef float f32x2 __attribute__((ext_vector_type(2)));

constexpr int D_MODEL = 1024, BATCH = 32, SEQ = 2048, DEC_BATCH = 128, PAST = 8192, PAGE = 128, NPAGES = 64;
constexpr int MPROMPT = BATCH * SEQ;
constexpr int MVALID = MPROMPT + DEC_BATCH;
constexpr int MP = MPROMPT + 256;
constexpr int NP = 4608;
constexpr int C_Q = 0, C_K = 512, C_V = 640, C_ZA = 768, C_QI = 1280, C_KI = 2304, C_WI = 2368, C_AG = 2384, C_BG = 2388, C_QKV = 2560, C_ZG = 4096;
constexpr int AUXP = 32;
constexpr size_t O_YP = 0, O_YS = 67108864, O_KP = 67239936, O_VP = 75628544, O_KIP = 84017152, O_SSMP = 88211456, O_CP = 90308608,
                 O_KS = 90456064, O_VS = 90472448, O_KIS = 90488832, O_SSMS = 90497024, O_CS = 98885632, O_END = 99475456;
constexpr size_t MiB = 1u << 20;
constexpr size_t WS_CTL = 0, CTL_BYTES = 1 * MiB;
constexpr size_t WS_ROWSS = 512 * 1024;
constexpr size_t WS_WINT = 2 * MiB;
constexpr size_t WS_WOUTT = 12 * MiB;
constexpr size_t WS_XN = 16 * MiB;
constexpr size_t WS_PROJ = 146 * MiB;
constexpr size_t WS_AUX = 726 * MiB;
constexpr size_t WS_MIXED = 736 * MiB;
constexpr size_t WS_MASK = 866 * MiB;
constexpr size_t WS_DBG = 900 * MiB;
constexpr size_t WS_DBGACC = 256 * 1024;
constexpr size_t WS_GDN = 1200 * MiB;
constexpr size_t WS_CD = 1586 * MiB;
constexpr size_t WS_END = 1588 * MiB;

__constant__ unsigned char c_bucket[128] = {0, 1, 2, 3, 4, 5, 6, 7, 8, 9, 10, 11, 12, 13, 14, 15, 16, 16, 16, 17, 17, 18, 18, 18, 19, 19, 19, 20, 20, 20, 20, 21, 21, 21, 21, 22, 22, 22, 22, 22, 23, 23, 23, 23, 23, 23, 24, 24, 24, 24, 24, 24, 25, 25, 25, 25, 25, 25, 25, 26, 26, 26, 26, 26, 26, 26, 26, 27, 27, 27, 27, 27, 27, 27, 27, 27, 27, 28, 28, 28, 28, 28, 28, 28, 28, 28, 28, 29, 29, 29, 29, 29, 29, 29, 29, 29, 29, 29, 29, 30, 30, 30, 30, 30, 30, 30, 30, 30, 30, 30, 30, 30, 30, 31, 31, 31, 31, 31, 31, 31, 31, 31, 31, 31, 31, 31, 31, 31};

__device__ __forceinline__ float bf2f(unsigned short b) { return __builtin_bit_cast(float, (unsigned)b << 16); }
__device__ __forceinline__ unsigned f2bf(float f) { unsigned u = __builtin_bit_cast(unsigned, f); return (u + 0x7fffu + ((u >> 16) & 1u)) >> 16; }
__device__ __forceinline__ unsigned pk2(float lo, float hi) { return f2bf(lo) | (f2bf(hi) << 16); }
__device__ __forceinline__ float wave_sum(float v) {
#pragma unroll
    for (int o = 1; o < 64; o <<= 1) v += __shfl_xor(v, o);
    return v;
}
__device__ __forceinline__ int wave_sum_i(int v) {
#pragma unroll
    for (int o = 1; o < 64; o <<= 1) v += __shfl_xor(v, o);
    return v;
}
__device__ __forceinline__ float wave_max(float v) {
#pragma unroll
    for (int o = 1; o < 64; o <<= 1) v = fmaxf(v, __shfl_xor(v, o));
    return v;
}
__device__ __forceinline__ int wave_excl_scan_i(int v, int lane) {
    int x = v;
#pragma unroll
    for (int o = 1; o < 64; o <<= 1) { int y = __shfl_up(x, o); if (lane >= o) x += y; }
    return x - v;
}
__device__ __forceinline__ unsigned f2key(float f) { unsigned u = __builtin_bit_cast(unsigned, f); return (u & 0x80000000u) ? ~u : (u | 0x80000000u); }
__device__ __forceinline__ float silu_f(float z) { return z / (1.f + __expf(-z)); }
__device__ __forceinline__ void unpack8(const u32x4 w, float* f) {
    f[0] = __builtin_bit_cast(float, w.x << 16); f[1] = __builtin_bit_cast(float, w.x & 0xffff0000u);
    f[2] = __builtin_bit_cast(float, w.y << 16); f[3] = __builtin_bit_cast(float, w.y & 0xffff0000u);
    f[4] = __builtin_bit_cast(float, w.z << 16); f[5] = __builtin_bit_cast(float, w.z & 0xffff0000u);
    f[6] = __builtin_bit_cast(float, w.w << 16); f[7] = __builtin_bit_cast(float, w.w & 0xffff0000u);
}

namespace pg8 {
#define PG8_LAS __attribute__((address_space(3)))
constexpr int BM = 256, BK = 64, HALF = 128, HTB = HALF * BK * 2, STAGE_BYTES = 8 * HTB, NXCD = 8, WGM = 8;
__host__ __device__ __forceinline__ int lds_byte(int r, int c) { const int st = (r >> 4) * 2 + (c >> 5), rr = r & 15, cc = c & 31, ob = rr * 64 + cc * 2; return st * 1024 + (ob ^ (((ob >> 9) & 1) << 5)); }
__host__ __device__ __forceinline__ void stage_rc(int b, int& R, int& C) { const int st = b / 1024, sb = b % 1024, swz = sb ^ (((sb >> 9) & 1) << 5); R = (st >> 1) * 16 + swz / 64; C = (st & 1) * 32 + (swz % 64) / 2; }
__host__ __device__ __forceinline__ int perm32(int rho) { const int n = rho >> 4, i = rho & 15; return 8 * (i >> 2) + 4 * n + (i & 3); }
struct Unit { int pm, pn; };
struct Gemm { const bf16_t* A; const bf16_t* Bt; int M, N, K; };
struct StaticOrder {
    int nM, nN, nwg, G, c;
    __host__ __device__ void init(int M, int N, int G_, int c_) { nM = M / BM; nN = N / BM; nwg = nM * nN; G = G_; c = c_; }
    __host__ __device__ bool next(int i, Unit& u) const {
        const long L = (long)i * G + c; if (L >= nwg) return false;
        int wgid = (int)L; { const int q = nwg / NXCD, r = nwg % NXCD, xcd = wgid % NXCD, off = wgid / NXCD; wgid = (xcd < r ? xcd * (q + 1) : r * (q + 1) + (xcd - r) * q) + off; }
        const int nig = WGM * nN, gid = wgid / nig, fm = gid * WGM, gsz = (nM - fm) < WGM ? (nM - fm) : WGM;
        u.pm = fm + ((wgid % nig) % gsz); u.pn = (wgid % nig) / gsz; return true;
    }
    __device__ __forceinline__ void a_ready(const Unit&) const {}
    __device__ __forceinline__ void done(const Unit&) const {}
};
__device__ __forceinline__ unsigned cvt_pk_bf16(float lo, float hi) { unsigned r; asm volatile("v_cvt_pk_bf16_f32 %0, %1, %2" : "=v"(r) : "v"(lo), "v"(hi)); return r; }

template <class Epi, class Sched, bool ALIGN_EPI = false, bool SP2 = false>
__device__ __forceinline__ void gemm_phase(PG8_LAS unsigned char* lds, const Gemm g, const Sched& S, const Epi& E) {
    const int tid = threadIdx.x, wid = __builtin_amdgcn_readfirstlane(tid >> 6), lane = tid & 63, wr = wid >> 2, wc = wid & 3, fr = lane & 15, fq = lane >> 4;
    const int K = g.K, nt = K / BK;
    unsigned voffA[2], voffB[2];
#pragma unroll
    for (int i = 0; i < 2; ++i) { int R, C; stage_rc(tid * 16 + i * 8192, R, C); const int Rb = Epi::PERM ? ((R & ~31) + perm32(R & 31)) : R;
        voffA[i] = (unsigned)(R * K + C) * 2u; voffB[i] = (unsigned)(Rb * K + C) * 2u; }
    const size_t kstep = (size_t)(BK * 2);
    const size_t hstep = (size_t)HALF * K * 2;
    const size_t tstep = 2 * hstep;
    const unsigned ldsw = (unsigned)wid * 1024u;
    const int aoff = lds_byte(wr * 64 + fr, fq * 8), boff = lds_byte(wc * 32 + fr, fq * 8);
#define PG8_SA(b, h) (((b) * 2 + (h)) * HTB)
#define PG8_SB(b, h) ((4 + (b) * 2 + (h)) * HTB)
#define PG8_STAGE(bufoff, gbase, voff) do { _Pragma("unroll") for (int _i = 0; _i < 2; ++_i) \
        __builtin_amdgcn_global_load_lds((const unsigned*)((const char*)(gbase) + (voff)[_i]), (PG8_LAS unsigned*)(lds + (bufoff) + ldsw + _i * 8192), 16, 0, 0); } while (0)
#define PG8_LDA(dst, b, h) do { _Pragma("unroll") for (int m = 0; m < 4; ++m) _Pragma("unroll") for (int k = 0; k < 2; ++k) dst[m][k] = *(const PG8_LAS bf16x8*)(lds + PG8_SA(b, h) + aoff + m * 2048 + k * 1024); } while (0)
#define PG8_LDB(dst, b, h) do { _Pragma("unroll") for (int n = 0; n < 2; ++n) _Pragma("unroll") for (int k = 0; k < 2; ++k) dst[n][k] = *(const PG8_LAS bf16x8*)(lds + PG8_SB(b, h) + boff + n * 2048 + k * 1024); } while (0)
#define PG8_MMA(ai, bj, At, Bt) do { __builtin_amdgcn_s_setprio(1); _Pragma("unroll") for (int m = 0; m < 4; ++m) _Pragma("unroll") for (int n = 0; n < 2; ++n) _Pragma("unroll") for (int k = 0; k < 2; ++k) \
        acc[ai][bj][m][n] = __builtin_amdgcn_mfma_f32_16x16x32_bf16(Bt[n][k], At[m][k], acc[ai][bj][m][n], 0, 0, 0); __builtin_amdgcn_s_setprio(0); } while (0)
#define PG8_WAIT_V(n) asm volatile("s_waitcnt vmcnt(" #n ")" ::: "memory")
#define PG8_WAIT_L(n) asm volatile("s_waitcnt lgkmcnt(" #n ")" ::: "memory")
#define PG8_BAR __builtin_amdgcn_s_barrier()
#define PG8_SCHED __builtin_amdgcn_sched_barrier(0)
    Unit cur, nxt; int ui = 0;
    if (!S.next(0, cur)) return;
    f32x4 acc[2][2][4][2];
#pragma unroll
    for (int a = 0; a < 2; ++a)
#pragma unroll
        for (int b = 0; b < 2; ++b)
#pragma unroll
            for (int m = 0; m < 4; ++m)
#pragma unroll
                for (int n = 0; n < 2; ++n) acc[a][b][m][n] = (f32x4){0.f, 0.f, 0.f, 0.f};
    bf16x8 At[4][2], B0[2][2], B1[2][2];
    const char* cA = (const char*)g.A + (size_t)cur.pm * tstep; const char* cB = (const char*)g.Bt + (size_t)cur.pn * tstep;
    S.a_ready(cur);
    if constexpr (SP2) {
        PG8_STAGE(PG8_SB(0, 0), cB, voffB); PG8_STAGE(PG8_SB(0, 1), cB + hstep, voffB); PG8_STAGE(PG8_SA(0, 0), cA, voffA); PG8_STAGE(PG8_SA(0, 1), cA + hstep, voffA);
        if (wr == 1) PG8_BAR;
        PG8_WAIT_V(2); PG8_BAR;
        PG8_STAGE(PG8_SB(1, 0), cB + kstep, voffB); PG8_STAGE(PG8_SA(1, 0), cA + kstep, voffA); PG8_STAGE(PG8_SB(1, 1), cB + hstep + kstep, voffB);
        PG8_WAIT_V(6); PG8_BAR;
    } else {
        PG8_STAGE(PG8_SB(0, 0), cB, voffB); PG8_STAGE(PG8_SA(0, 0), cA, voffA); PG8_STAGE(PG8_SB(0, 1), cB + hstep, voffB); PG8_STAGE(PG8_SA(0, 1), cA + hstep, voffA);
        if (wr == 1) PG8_BAR;
        PG8_WAIT_V(4); PG8_BAR;
        PG8_STAGE(PG8_SB(1, 0), cB + kstep, voffB); PG8_STAGE(PG8_SA(1, 0), cA + kstep, voffA); PG8_STAGE(PG8_SB(1, 1), cB + hstep + kstep, voffB);
        PG8_WAIT_V(6); PG8_BAR;
    }
    for (;;) {
        const bool has_next = S.next(ui + 1, nxt);
        const char* nA = has_next ? (const char*)g.A + (size_t)nxt.pm * tstep : cA; const char* nB = has_next ? (const char*)g.Bt + (size_t)nxt.pn * tstep : cB;
        for (int t = 0; t < nt; t += 2) {
            const bool last = (t == nt - 2);
            const char* a1 = cA + (size_t)(t + 1) * kstep;
            const char* a2 = last ? nA : cA + (size_t)(t + 2) * kstep; const char* b2 = last ? nB : cB + (size_t)(t + 2) * kstep;
            const char* a3 = a2 + kstep; const char* b3 = b2 + kstep;
            if (last && has_next) S.a_ready(nxt);
            if constexpr (SP2) {
            PG8_LDB(B0, 0, 0); PG8_LDB(B1, 0, 1); PG8_SCHED; PG8_LDA(At, 0, 0); PG8_STAGE(PG8_SA(1, 1), a1 + hstep, voffA);
            PG8_WAIT_V(8); PG8_WAIT_L(0); PG8_BAR; PG8_MMA(0, 0, At, B0); PG8_MMA(0, 1, At, B1); PG8_BAR; PG8_SCHED;
            PG8_LDA(At, 0, 1); PG8_STAGE(PG8_SB(0, 0), b2, voffB); PG8_STAGE(PG8_SB(0, 1), b2 + hstep, voffB); PG8_STAGE(PG8_SA(0, 0), a2, voffA);
            PG8_WAIT_V(8); PG8_WAIT_L(0); PG8_BAR; PG8_MMA(1, 0, At, B0); PG8_MMA(1, 1, At, B1); PG8_BAR; PG8_SCHED;
            PG8_LDB(B0, 1, 0); PG8_LDB(B1, 1, 1); PG8_SCHED; PG8_LDA(At, 1, 0); PG8_STAGE(PG8_SA(0, 1), a2 + hstep, voffA);
            PG8_WAIT_V(8); PG8_WAIT_L(0); PG8_BAR; PG8_MMA(0, 0, At, B0); PG8_MMA(0, 1, At, B1); PG8_BAR; PG8_SCHED;
            PG8_LDA(At, 1, 1); PG8_STAGE(PG8_SB(1, 0), b3, voffB); PG8_STAGE(PG8_SB(1, 1), b3 + hstep, voffB); PG8_STAGE(PG8_SA(1, 0), a3, voffA);
            PG8_WAIT_V(8); PG8_WAIT_L(0); PG8_BAR; PG8_MMA(1, 0, At, B0); PG8_MMA(1, 1, At, B1); PG8_BAR; PG8_SCHED;
            } else {
            PG8_LDB(B0, 0, 0); PG8_SCHED; PG8_LDA(At, 0, 0); PG8_STAGE(PG8_SA(1, 1), a1 + hstep, voffA);
            PG8_WAIT_L(8); PG8_BAR; PG8_WAIT_L(0); PG8_MMA(0, 0, At, B0); PG8_BAR; PG8_SCHED;
            PG8_LDB(B1, 0, 1); PG8_STAGE(PG8_SB(0, 0), b2, voffB);
            PG8_BAR; PG8_WAIT_L(0); PG8_MMA(0, 1, At, B1); PG8_BAR;
            PG8_LDA(At, 0, 1); PG8_STAGE(PG8_SA(0, 0), a2, voffA);
            PG8_BAR; PG8_WAIT_L(0); PG8_MMA(1, 0, At, B0); PG8_BAR; PG8_SCHED;
            PG8_STAGE(PG8_SB(0, 1), b2 + hstep, voffB);
            PG8_WAIT_V(6); PG8_BAR; PG8_MMA(1, 1, At, B1); PG8_BAR;
            PG8_LDB(B0, 1, 0); PG8_SCHED; PG8_LDA(At, 1, 0); PG8_STAGE(PG8_SA(0, 1), a2 + hstep, voffA);
            PG8_WAIT_L(8); PG8_BAR; PG8_WAIT_L(0); PG8_MMA(0, 0, At, B0); PG8_BAR; PG8_SCHED;
            PG8_LDB(B1, 1, 1); PG8_STAGE(PG8_SB(1, 0), b3, voffB);
            PG8_BAR; PG8_WAIT_L(0); PG8_MMA(0, 1, At, B1); PG8_BAR;
            PG8_LDA(At, 1, 1); PG8_STAGE(PG8_SA(1, 0), a3, voffA);
            PG8_BAR; PG8_WAIT_L(0); PG8_MMA(1, 0, At, B0); PG8_BAR; PG8_SCHED;
            PG8_STAGE(PG8_SB(1, 1), b3 + hstep, voffB);
            PG8_WAIT_V(6); PG8_BAR; PG8_MMA(1, 1, At, B1); PG8_BAR;
            }
        }
        if constexpr (ALIGN_EPI) { if (wr == 0) PG8_BAR; }
        if constexpr (!Epi::AFTER_DRAIN) { E(acc, cur, wr, wc, fr, fq); S.done(cur); }
        if (!has_next) break;
#pragma unroll
        for (int a = 0; a < 2; ++a)
#pragma unroll
            for (int b = 0; b < 2; ++b)
#pragma unroll
                for (int m = 0; m < 4; ++m)
#pragma unroll
                    for (int n = 0; n < 2; ++n) acc[a][b][m][n] = (f32x4){0.f, 0.f, 0.f, 0.f};
        cur = nxt; cA = nA; cB = nB; ++ui;
        if constexpr (ALIGN_EPI) { if (wr == 1) PG8_BAR; }
    }
    PG8_WAIT_V(0);
    if constexpr (!ALIGN_EPI) { if (wr == 0) PG8_BAR; }
    PG8_BAR;
#undef PG8_SA
#undef PG8_SB
#undef PG8_STAGE
#undef PG8_LDA
#undef PG8_LDB
#undef PG8_MMA
#undef PG8_WAIT_V
#undef PG8_WAIT_L
#undef PG8_BAR
#undef PG8_SCHED
}
}

struct EpiIn {
    static constexpr bool PERM = true, AFTER_DRAIN = false;
    bf16_t* proj; float* aux; float* out;
    __device__ __forceinline__ void operator()(const f32x4 (&acc)[2][2][4][2], const pg8::Unit& u, int wr, int wc, int fr, int fq) const {
        const int row0 = u.pm * 256 + wr * 64 + fr, colb = u.pn * 256 + wc * 32 + 8 * fq, pn = u.pn;
#pragma unroll
        for (int ai = 0; ai < 2; ++ai)
#pragma unroll
            for (int m = 0; m < 4; ++m) {
                const int row = row0 + ai * 128 + m * 16;
#pragma unroll
                for (int bj = 0; bj < 2; ++bj) {
                    const int col = colb + bj * 128;
                    const f32x4 v0 = acc[ai][bj][m][0], v1 = acc[ai][bj][m][1];
                    u32x4 w; w.x = pg8::cvt_pk_bf16(v0[0], v0[1]); w.y = pg8::cvt_pk_bf16(v0[2], v0[3]); w.z = pg8::cvt_pk_bf16(v1[0], v1[1]); w.w = pg8::cvt_pk_bf16(v1[2], v1[3]);
                    *(u32x4*)(proj + (size_t)row * NP + col) = w;
                    float* dst = nullptr;
                    if (pn == 2) {
                        const int c = col - C_K; const int isv = c >= 128; const int cc = c & 127;
                        if (row < MPROMPT) dst = out + (isv ? O_VP : O_KP) + (size_t)row * 128 + cc;
                        else if (row < MVALID) dst = out + (isv ? O_VS : O_KS) + (size_t)(row - MPROMPT) * 128 + cc;
                    } else if (pn == 9) {
                        const int c = col - C_KI;
                        if (c < 64) {
                            if (row < MPROMPT) dst = out + O_KIP + (size_t)row * 64 + c;
                            else if (row < MVALID) dst = out + O_KIS + (size_t)(row - MPROMPT) * 64 + c;
                        } else if (c < 88) dst = aux + (size_t)row * AUXP + (c - 64);
                    } else if (pn >= 10 && pn <= 15) {
                        const int c = col - C_QKV;
                        if (row < MPROMPT) { const int t = row & (SEQ - 1); if (t >= SEQ - 3) dst = out + O_CP + ((size_t)(row >> 11) * 3 + (t - (SEQ - 3))) * 1536 + c; }
                        else if (row < MVALID) dst = out + O_CS + ((size_t)(row - MPROMPT) * 3 + 2) * 1536 + c;
                    }
                    if (dst) { *(f32x4*)dst = v0; *(f32x4*)(dst + 4) = v1; }
                }
            }
    }
};
struct EpiOut {
    static constexpr bool PERM = true, AFTER_DRAIN = false;
    const float* xp; const float* xs; float* out; float* rowss;
    __device__ __forceinline__ void operator()(const f32x4 (&acc)[2][2][4][2], const pg8::Unit& u, int wr, int wc, int fr, int fq) const {
        const int row0 = u.pm * 256 + wr * 64 + fr, colb = u.pn * 256 + wc * 32 + 8 * fq;
#pragma unroll
        for (int ai = 0; ai < 2; ++ai)
#pragma unroll
            for (int m = 0; m < 4; ++m) {
                const int row = row0 + ai * 128 + m * 16;
                float ss = 0.f;
                if (row < MVALID) {
                    const float* xr = row < MPROMPT ? xp + (size_t)row * D_MODEL : xs + (size_t)(row - MPROMPT) * D_MODEL;
#pragma unroll
                    for (int bj = 0; bj < 2; ++bj) {
                        const int col = colb + bj * 128;
                        f32x4 h0 = *(const f32x4*)(xr + col) + acc[ai][bj][m][0], h1 = *(const f32x4*)(xr + col + 4) + acc[ai][bj][m][1];
                        *(f32x4*)(out + (size_t)row * D_MODEL + col) = h0; *(f32x4*)(out + (size_t)row * D_MODEL + col + 4) = h1;
                        ss += (h0[0] * h0[0] + h0[1] * h0[1]) + (h0[2] * h0[2] + h0[3] * h0[3]) + (h1[0] * h1[0] + h1[1] * h1[1]) + (h1[2] * h1[2] + h1[3] * h1[3]);
                    }
                }
                ss += __shfl_xor(ss, 16); ss += __shfl_xor(ss, 32);
                if (fq == 0 && row < MVALID) atomicAdd(rowss + row, ss);
            }
    }
};

struct Params {
    const float* x_prompt; const float* x_sample; const float* cache_k; const float* cache_v; const float* cache_kidx; const float* state_ssm; const float* state_conv;
    const int* page_table; const float* norm_in; const float* w_in; const float* conv_w; const float* a_log; const float* dt_bias; const float* gdn_norm; const float* w_out;
    const float* rel_table; const float* norm_final; float* out; unsigned char* ws;
};

constexpr int NWAVES = 8, NTHR = 512;
constexpr int SCR_BYTES = 145408;
constexpr int MISC_OFF = SCR_BYTES + 320;
constexpr int LDS_BYTES = 147456;
constexpr int CW_BAR = 4096;
typedef GAS unsigned gu32;
#define RLX_AGENT __ATOMIC_RELAXED, __HIP_MEMORY_SCOPE_AGENT
#define LDS_WAIT() asm volatile("s_waitcnt lgkmcnt(0)" ::: "memory")

#define XB_TMO      128
#define XB_XCNT(j)  (256  + 64 * (j))
#define XB_XSUB(j)  (1280 + 64 * (j))
#define XB_XGEN(j)  (2304 + 64 * (j))
#define XB_TOP      3328
#define XB_TOPGEN   3392
#define XCD_BAR_WORDS 3456
#define XB_SPIN_CAP (1u << 22)
__device__ __forceinline__ unsigned xb_ld(unsigned* p)              { return __hip_atomic_load(p, __ATOMIC_RELAXED, __HIP_MEMORY_SCOPE_AGENT); }
__device__ __forceinline__ unsigned xb_add(unsigned* p, unsigned v) { return __hip_atomic_fetch_add(p, v, __ATOMIC_RELAXED, __HIP_MEMORY_SCOPE_AGENT); }
__device__ __forceinline__ unsigned xb_xcc_id() { return (unsigned)__builtin_amdgcn_s_getreg((3 << 11) | 20) & 0xFu; }
#define XB_SPIN(cond, bar) do { unsigned _sp = 0; while (cond) { __builtin_amdgcn_s_sleep(1); \
    if ((++_sp & 255u) == 0u) { if (xb_ld(&(bar)[XB_TMO])) break; if (_sp > XB_SPIN_CAP) { atomicAdd(&(bar)[XB_TMO], 1u); break; } } } } while (0)
struct XcdBarrier { unsigned* bar; unsigned x; volatile LAS unsigned* st; };
__device__ __forceinline__ XcdBarrier xcd_barrier_post(unsigned* bar, volatile LAS unsigned* st) {
    XcdBarrier b; b.bar = bar; b.x = xb_xcc_id(); b.st = st;
    if (threadIdx.x == 0) (void)xb_add(&bar[XB_XCNT(b.x)], 1u);
    return b;
}
__device__ __forceinline__ void xcd_barrier_complete(unsigned* bar, unsigned x, unsigned& nloc, unsigned& nx) {
    const unsigned G = gridDim.x * gridDim.y * gridDim.z;
    unsigned sum, cnt, mine, sp = 0u;
    for (;;) {
        sum = 0u; cnt = 0u; mine = 0u;
#pragma unroll
        for (unsigned j = 0; j < 16; ++j) { const unsigned c = xb_ld(&bar[XB_XCNT(j)]); sum += c; cnt += (c > 0u) ? 1u : 0u; mine = (j == x) ? c : mine; }
        if (sum == G) break;
        __builtin_amdgcn_s_sleep(1);
        if ((++sp & 255u) == 0u) { if (xb_ld(&bar[XB_TMO])) break; if (sp > XB_SPIN_CAP) { atomicAdd(&bar[XB_TMO], 1u); break; } }
    }
    nloc = mine > 0u ? mine : 1u; nx = cnt > 0u ? cnt : 1u;
}
__device__ __forceinline__ void xcd_barrier(const XcdBarrier& b) {
    asm volatile("s_waitcnt vmcnt(0)" ::: "memory");
    __syncthreads();
    if (threadIdx.x == 0) {
        unsigned* bar = b.bar;
        __builtin_amdgcn_s_waitcnt(0);
        unsigned nloc = b.st[0], nx = b.st[1];
        if (nloc == 0u) { xcd_barrier_complete(bar, b.x, nloc, nx); b.st[0] = nloc; b.st[1] = nx; }
        const unsigned old = xb_add(&bar[XB_XSUB(b.x)], 1u);
        const unsigned gen = old / nloc;
        if (old + 1u == (gen + 1u) * nloc) {
            __builtin_amdgcn_fence(__ATOMIC_RELEASE, "agent");
            asm volatile("s_waitcnt vmcnt(0)" ::: "memory");
            const unsigned og = xb_add(&bar[XB_TOP], 1u);
            const unsigned tg = og / nx;
            if (og + 1u == (tg + 1u) * nx) xb_add(&bar[XB_TOPGEN], 1u);
            else XB_SPIN(xb_ld(&bar[XB_TOPGEN]) == tg, bar);
            __builtin_amdgcn_fence(__ATOMIC_ACQUIRE, "agent");
            xb_add(&bar[XB_XGEN(b.x)], 1u);
            asm volatile("s_waitcnt vmcnt(0)" ::: "memory");
        } else {
            XB_SPIN(xb_ld(&bar[XB_XGEN(b.x)]) == gen, bar);
            __builtin_amdgcn_fence(__ATOMIC_ACQUIRE, "agent");
            asm volatile("s_waitcnt vmcnt(0)" ::: "memory");
        }
    }
    __syncthreads();
}

__device__ __forceinline__ int win_src_col(int n) {
    if (n < C_AG) return n;
    if (n < C_AG + 8) return n + 2048;
    if (n < C_QKV) return -1;
    return n - 176;
}
template <bool MAPPED>
__device__ __forceinline__ void transpose_item(const float* W, int K, int N, bf16_t* WT, LAS float* scr, int item, int nblk, int lane) {
    const int kb = item / nblk, nb = item % nblk, k0 = 64 * kb, n0 = 32 * nb;
    const int nd = n0 + (lane & 31); const int src = MAPPED ? win_src_col(nd) : nd;
#pragma unroll 8
    for (int i = 0; i < 32; ++i) { const int kk = 2 * i + (lane >> 5); scr[kk * 33 + (lane & 31)] = src >= 0 ? W[(size_t)(k0 + kk) * N + src] : 0.f; }
    LDS_WAIT();
    const int c = lane & 7;
#pragma unroll
    for (int j = 0; j < 4; ++j) { const int n = (lane >> 3) + 8 * j; const LAS float* s = scr + (8 * c) * 33 + n;
        u32x4 o; o.x = pk2(s[0 * 33], s[1 * 33]); o.y = pk2(s[2 * 33], s[3 * 33]); o.z = pk2(s[4 * 33], s[5 * 33]); o.w = pk2(s[6 * 33], s[7 * 33]);
        *(u32x4*)(WT + (size_t)(n0 + n) * K + k0 + 8 * c) = o; }
    LDS_WAIT();
}
__device__ __forceinline__ void ph_prologue(const Params& p, LAS unsigned char* lds) {
    const int tid = threadIdx.x, lane = tid & 63, wave = tid >> 6;
    const int gw = blockIdx.x * NWAVES + wave, NGW = gridDim.x * NWAVES;
    bf16_t* WINT = (bf16_t*)(p.ws + WS_WINT); bf16_t* WOUTT = (bf16_t*)(p.ws + WS_WOUTT); bf16_t* XN = (bf16_t*)(p.ws + WS_XN);
    LAS float* scr = (LAS float*)(lds + wave * 8448);
    constexpr int I_IN = (1024 / 64) * (NP / 32), I_OUT = (1024 / 64) * (1024 / 32);
    for (int it = gw; it < I_IN + I_OUT; it += NGW) {
        if (it < I_IN) transpose_item<true>(p.w_in, 1024, 4440, WINT, scr, it, NP / 32, lane);
        else transpose_item<false>(p.w_out, 1024, 1024, WOUTT, scr, it - I_IN, 1024 / 32, lane);
    }
    for (int m = gw; m < MP; m += NGW) {
        unsigned long long* o8 = (unsigned long long*)(XN + (size_t)m * D_MODEL) + lane;
        if (m >= MVALID) {
#pragma unroll
            for (int j = 0; j < 4; ++j) o8[64 * j] = 0ull;
            continue;
        }
        const float* xrow = m < MPROMPT ? p.x_prompt + (size_t)m * D_MODEL : p.x_sample + (size_t)(m - MPROMPT) * D_MODEL;
        const f32x4* xr = (const f32x4*)xrow + lane; const f32x4* gr = (const f32x4*)p.norm_in + lane;
        f32x4 v[4]; float s = 0.f;
#pragma unroll
        for (int j = 0; j < 4; ++j) { v[j] = xr[64 * j]; s += (v[j].x * v[j].x + v[j].y * v[j].y) + (v[j].z * v[j].z + v[j].w * v[j].w); }
        const float rs = rsqrtf(wave_sum(s) * (1.f / D_MODEL) + 1e-6f);
#pragma unroll
        for (int j = 0; j < 4; ++j) { const f32x4 g = gr[64 * j]; const f32x4 y = v[j] * rs * g;
            o8[64 * j] = (unsigned long long)pk2(y.x, y.y) | ((unsigned long long)pk2(y.z, y.w) << 32); }
    }
}
__device__ __forceinline__ void ph_final_norm(const Params& p) {
    const int lane = threadIdx.x & 63, gw = blockIdx.x * NWAVES + (threadIdx.x >> 6), NGW = gridDim.x * NWAVES;
    const float* rowss = (const float*)(p.ws + WS_ROWSS);
    for (int m = gw; m < MVALID; m += NGW) {
        float rs = rsqrtf(rowss[m] * (1.f / D_MODEL) + 1e-6f);
#ifdef DBG_CMP
        if (m >= MPROMPT) { const float* da = (const float*)(p.ws + WS_DBGACC); rs *= 1.f + sqrtf(100.f * da[0] / da[1]); }
#endif
        f32x4* yr = (f32x4*)(p.out + (size_t)m * D_MODEL) + lane; const f32x4* gr = (const f32x4*)p.norm_final + lane;
#pragma unroll
        for (int j = 0; j < 4; ++j) yr[64 * j] = yr[64 * j] * rs * gr[64 * j];
    }
}

__device__ __forceinline__ void nv_idx(const Params& p, LAS unsigned char* lds) {
    const int wave = threadIdx.x >> 6, lane = threadIdx.x & 63;
    LAS float* qs = (LAS float*)(lds + wave * 12800);
    LAS float* scl = qs + 1024;
    LAS float* wh = scl + 64 * 33;
    const bf16_t* proj = (const bf16_t*)(p.ws + WS_PROJ); const float* aux = (const float*)(p.ws + WS_AUX); unsigned* mask = (unsigned*)(p.ws + WS_MASK);
    for (int base = blockIdx.x * NWAVES; base < MPROMPT; base += gridDim.x * NWAVES) {
        const int r = base + wave, b = r >> 11, t = r & (SEQ - 1);
        const bf16_t* qrow = proj + (size_t)r * NP + C_QI;
        for (int i = lane; i < 1024; i += 64) qs[i] = bf2f(qrow[i]) * 0.125f;
        if (lane < 16) wh[lane] = aux[(size_t)r * AUXP + lane] * 0.25f;
        __syncthreads();
        for (int j = 0; j < 32; ++j) {
            const int s = 32 * lane + j;
            float sc = -1e30f;
            if (s <= t) {
                const u32x4* krow = (const u32x4*)(proj + (size_t)(b * SEQ + s) * NP + C_KI);
                float kf[64];
#pragma unroll
                for (int c = 0; c < 8; ++c) unpack8(krow[c], kf + 8 * c);
                sc = 0.f;
                for (int h = 0; h < 16; ++h) {
                    float dot = 0.f;
#pragma unroll
                    for (int d = 0; d < 64; ++d) dot += qs[h * 64 + d] * kf[d];
                    sc += fmaxf(dot, 0.f) * wh[h];
                }
            }
            scl[lane * 33 + j] = sc;
        }
        __syncthreads();
        unsigned key[32];
#pragma unroll
        for (int j = 0; j < 32; ++j) key[j] = f2key(scl[lane * 33 + j]);
        unsigned prefix = 0u;
        for (int bit = 31; bit >= 0; --bit) {
            const unsigned cand = prefix | (1u << bit);
            int c = 0;
#pragma unroll
            for (int j = 0; j < 32; ++j) c += (key[j] >= cand) ? 1 : 0;
            c = wave_sum_i(c);
            if (c >= 256) prefix = cand;
        }
        int cgt = 0, ceq = 0;
#pragma unroll
        for (int j = 0; j < 32; ++j) { cgt += (key[j] > prefix) ? 1 : 0; ceq += (key[j] == prefix) ? 1 : 0; }
        const int need = 256 - wave_sum_i(cgt);
        int run = wave_excl_scan_i(ceq, lane);
        unsigned word = 0u;
#pragma unroll
        for (int j = 0; j < 32; ++j) {
            if (key[j] > prefix) word |= (1u << j);
            else if (key[j] == prefix) { if (run < need) word |= (1u << j); ++run; }
        }
        const int nv = t + 1 - 32 * lane;
        const unsigned vm = nv >= 32 ? 0xffffffffu : (nv <= 0 ? 0u : ((1u << nv) - 1u));
        mask[(size_t)r * 64 + lane] = word & vm;
        __syncthreads();
    }
}

__device__ __forceinline__ void nv_attn(const Params& p, LAS unsigned char* lds, bf16_t* mixed) {
    const int wave = threadIdx.x >> 6, lane = threadIdx.x & 63;
    LAS float* bd = (LAS float*)lds;
    LAS float* qs = (LAS float*)(lds + 4096 + wave * 11264);
    LAS int* lst = (LAS int*)(qs + 512);
    LAS float* pl = (LAS float*)(lst + 256);
    const bf16_t* proj = (const bf16_t*)(p.ws + WS_PROJ); const unsigned* mask = (const unsigned*)(p.ws + WS_MASK);
    for (int i = threadIdx.x; i < 1024; i += NTHR) bd[i] = p.rel_table[(int)c_bucket[i >> 3] * 8 + (i & 7)];
    for (int base = blockIdx.x * NWAVES; base < MPROMPT; base += gridDim.x * NWAVES) {
        const int r = base + wave, b = r >> 11, t = r & (SEQ - 1);
        const bf16_t* qrow = proj + (size_t)r * NP + C_Q;
        for (int i = lane; i < 512; i += 64) qs[i] = bf2f(qrow[i]) * 0.125f;
        const unsigned word = mask[(size_t)r * 64 + lane];
        const int cnt = __popc(word);
        int pos = wave_excl_scan_i(cnt, lane);
        const int nsel = wave_sum_i(cnt);
        { unsigned w = word; while (w) { const int j = __ffs(w) - 1; lst[pos++] = 32 * lane + j; w &= w - 1u; } }
        __syncthreads();
        for (int i = lane; i < nsel; i += 64) {
            const int s = lst[i]; int dn = t - s; dn = dn > 127 ? 127 : dn;
            for (int g = 0; g < 2; ++g) {
                const u32x4* krow = (const u32x4*)(proj + (size_t)(b * SEQ + s) * NP + C_K + g * 64);
                float kf[64];
#pragma unroll
                for (int c = 0; c < 8; ++c) unpack8(krow[c], kf + 8 * c);
                for (int hh = 0; hh < 4; ++hh) {
                    const int h = g * 4 + hh; float dot = 0.f;
#pragma unroll
                    for (int d = 0; d < 64; ++d) dot += qs[h * 64 + d] * kf[d];
                    pl[h * 256 + i] = dot + bd[dn * 8 + h];
                }
            }
        }
        __syncthreads();
        for (int h = 0; h < 8; ++h) {
            float m = -3.0e38f;
            for (int i = lane; i < nsel; i += 64) m = fmaxf(m, pl[h * 256 + i]);
            m = wave_max(m);
            float sum = 0.f;
            for (int i = lane; i < nsel; i += 64) { const float e = __expf(pl[h * 256 + i] - m); pl[h * 256 + i] = e; sum += e; }
            const float inv = 1.f / wave_sum(sum);
            for (int i = lane; i < nsel; i += 64) pl[h * 256 + i] *= inv;
        }
        __syncthreads();
        for (int g = 0; g < 2; ++g) {
            float acc0 = 0.f, acc1 = 0.f, acc2 = 0.f, acc3 = 0.f;
            for (int i = 0; i < nsel; ++i) {
                const int s = lst[i];
                const float v = bf2f(proj[(size_t)(b * SEQ + s) * NP + C_V + g * 64 + lane]);
                acc0 += pl[(g * 4 + 0) * 256 + i] * v; acc1 += pl[(g * 4 + 1) * 256 + i] * v; acc2 += pl[(g * 4 + 2) * 256 + i] * v; acc3 += pl[(g * 4 + 3) * 256 + i] * v;
            }
            const bf16_t* zr = proj + (size_t)r * NP + C_ZA + g * 256 + lane; bf16_t* mr = mixed + (size_t)r * D_MODEL + g * 256 + lane;
            mr[0] = (bf16_t)f2bf(acc0 * silu_f(bf2f(zr[0]))); mr[64] = (bf16_t)f2bf(acc1 * silu_f(bf2f(zr[64])));
            mr[128] = (bf16_t)f2bf(acc2 * silu_f(bf2f(zr[128]))); mr[192] = (bf16_t)f2bf(acc3 * silu_f(bf2f(zr[192])));
        }
        __syncthreads();
    }
}

template <int MODE>
__device__ __forceinline__ void nv_gdn_unit(const Params& p, LAS unsigned char* lds, int unit, bf16_t* mixed, float* So) {
    LAS float* qkv_s = (LAS float*)lds;
    LAS float* red = qkv_s + 384;
    LAS float* sc = red + 1024;
    const int tid = threadIdx.x, lane = tid & 63, wave = tid >> 6;
    const int b = unit >> 2, h = unit & 3;
    const int T = MODE ? 1 : SEQ; const int row0 = MODE ? MPROMPT + b : b * SEQ;
    const int e = tid & 127, sl = tid >> 7;
    const bf16_t* proj = (const bf16_t*)(p.ws + WS_PROJ); const float* aux = (const float*)(p.ws + WS_AUX);
    float S[32];
#pragma unroll
    for (int i = 0; i < 32; ++i) S[i] = MODE ? p.state_ssm[((size_t)(b * 4 + h) * 128 + sl * 32 + i) * 128 + e] : 0.f;
    const int part = tid >> 7, ci = tid & 127, c = part * 512 + h * 128 + ci;
    float w0 = 0.f, w1 = 0.f, w2 = 0.f, w3 = 0.f, x0 = 0.f, x1 = 0.f, x2 = 0.f;
    if (tid < 384) {
        w0 = p.conv_w[0 * 1536 + c]; w1 = p.conv_w[1 * 1536 + c]; w2 = p.conv_w[2 * 1536 + c]; w3 = p.conv_w[3 * 1536 + c];
        if (MODE) { x0 = p.state_conv[((size_t)b * 3 + 0) * 1536 + c]; x1 = p.state_conv[((size_t)b * 3 + 1) * 1536 + c]; x2 = p.state_conv[((size_t)b * 3 + 2) * 1536 + c]; }
    }
    const float A = __expf(p.a_log[h]), dtb = p.dt_bias[h], gn = p.gdn_norm[e];
    for (int t = 0; t < T; ++t) {
        const size_t r = (size_t)(row0 + t);
        if (tid < 384) {
            float x3;
            if (MODE) x3 = p.out[O_CS + ((size_t)b * 3 + 2) * 1536 + c];
            else x3 = bf2f(proj[r * NP + C_QKV + c]);
            const float y = x0 * w0 + x1 * w1 + x2 * w2 + x3 * w3;
            x0 = x1; x1 = x2; x2 = x3;
            qkv_s[tid] = silu_f(y);
        }
        __syncthreads();
        if (wave == 0) { const float a = qkv_s[lane], a2 = qkv_s[lane + 64]; const float s = wave_sum(a * a + a2 * a2); if (lane == 0) sc[0] = s; }
        else if (wave == 1) { const float a = qkv_s[128 + lane], a2 = qkv_s[192 + lane]; const float s = wave_sum(a * a + a2 * a2); if (lane == 0) sc[1] = s; }
        else if (wave == 2) { const float s = wave_sum(qkv_s[lane] * qkv_s[128 + lane] + qkv_s[lane + 64] * qkv_s[192 + lane]); if (lane == 0) sc[2] = s; }
        __syncthreads();
        const float qn = rsqrtf(sc[0] + 1e-6f) * 0.08838834764831845f, kn = rsqrtf(sc[1] + 1e-6f), qk = sc[2] * qn * kn;
        const float ag = aux[r * AUXP + 16 + h], bg = aux[r * AUXP + 20 + h];
        const float xg = ag + dtb;
        const float sp = xg > 20.f ? xg : log1pf(__expf(xg));
        const float dec = __expf(-A * sp), beta = 1.f / (1.f + __expf(-bg));
        float pk = 0.f, pq = 0.f;
#pragma unroll
        for (int i = 0; i < 32; ++i) { const int d = sl * 32 + i; S[i] *= dec; pk += qkv_s[128 + d] * S[i]; pq += qkv_s[d] * S[i]; }
        red[sl * 128 + e] = pk * kn; red[512 + sl * 128 + e] = pq * qn;
        __syncthreads();
        const float kv = (red[e] + red[128 + e]) + (red[256 + e] + red[384 + e]);
        const float qS = (red[512 + e] + red[640 + e]) + (red[768 + e] + red[896 + e]);
        const float delta = (qkv_s[256 + e] - kv) * beta;
        const float o = qS + qk * delta;
#pragma unroll
        for (int i = 0; i < 32; ++i) { const int d = sl * 32 + i; S[i] += qkv_s[128 + d] * kn * delta; }
        if (sl == 0) { const float s = wave_sum(o * o); if (lane == 0) sc[4 + wave] = s; }
        __syncthreads();
        if (sl == 0) {
            const float rs = rsqrtf((sc[4] + sc[5]) * (1.f / 128.f) + 1e-6f);
            const float z = bf2f(proj[r * NP + C_ZG + h * 128 + e]);
            mixed[r * D_MODEL + 512 + h * 128 + e] = (bf16_t)f2bf(o * rs * gn * silu_f(z));
        }
    }
#pragma unroll
    for (int i = 0; i < 32; ++i) So[((size_t)(b * 4 + h) * 128 + sl * 32 + i) * 128 + e] = S[i];
    __syncthreads();
}

__device__ __forceinline__ void nv_sample_unit(const Params& p, LAS unsigned char* lds, int b) {
    LAS float* scs = (LAS float*)lds;
    LAS float* qs = scs + 8704;
    LAS float* wh = qs + 1024;
    LAS int* lst = (LAS int*)(wh + 16);
    LAS int* eql = lst + 256;
    LAS int* cnts = eql + 64;
    LAS float* pl = (LAS float*)(cnts + 16);
    LAS float* qa = pl + 2048;
    const int tid = threadIdx.x, lane = tid & 63, wave = tid >> 6;
    const size_t r = (size_t)MPROMPT + b;
    const bf16_t* proj = (const bf16_t*)(p.ws + WS_PROJ); const float* aux = (const float*)(p.ws + WS_AUX); bf16_t* mixed = (bf16_t*)(p.ws + WS_MIXED);
    for (int i = tid; i < 1024; i += NTHR) qs[i] = bf2f(proj[r * NP + C_QI + i]) * 0.125f;
    qa[tid] = bf2f(proj[r * NP + C_Q + tid]) * 0.125f;
    if (tid < 16) wh[tid] = aux[r * AUXP + tid] * 0.25f;
    if (tid < 16) cnts[tid] = 0;
    for (int i = tid; i < 2 * 1536; i += NTHR) p.out[O_CS + (size_t)b * 3 * 1536 + i] = p.state_conv[(size_t)b * 3 * 1536 + 1536 + i];
    __syncthreads();
    for (int i = 0; i < 17; ++i) {
        const int s = tid + 512 * i;
        float sc = -3.0e38f;
        if (s <= PAST) {
            const float* krow = s < PAST ? p.cache_kidx + ((size_t)p.page_table[b * NPAGES + (s >> 7)] * PAGE + (s & 127)) * 64 : p.out + O_KIS + (size_t)b * 64;
            float kf[64];
#pragma unroll
            for (int c = 0; c < 16; ++c) { const f32x4 v = ((const f32x4*)krow)[c]; kf[4 * c] = v.x; kf[4 * c + 1] = v.y; kf[4 * c + 2] = v.z; kf[4 * c + 3] = v.w; }
            sc = 0.f;
            for (int h = 0; h < 16; ++h) {
                float dot = 0.f;
#pragma unroll
                for (int d = 0; d < 64; ++d) dot += qs[h * 64 + d] * kf[d];
                sc += fmaxf(dot, 0.f) * wh[h];
            }
        }
        scs[s] = sc;
    }
    __syncthreads();
    unsigned key[17];
#pragma unroll
    for (int i = 0; i < 17; ++i) { const int s = tid + 512 * i; key[i] = s <= PAST ? f2key(scs[s]) : 0u; }
    unsigned prefix = 0u;
    for (int bit = 31; bit >= 0; --bit) {
        const unsigned cand = prefix | (1u << bit);
        int c = 0;
#pragma unroll
        for (int i = 0; i < 17; ++i) c += (key[i] >= cand) ? 1 : 0;
        c = wave_sum_i(c);
        if (lane == 0) cnts[8 + wave] = c;
        __syncthreads();
        int tot = 0;
#pragma unroll
        for (int w = 0; w < 8; ++w) tot += cnts[8 + w];
        __syncthreads();
        if (tot >= 256) prefix = cand;
    }
#pragma unroll
    for (int i = 0; i < 17; ++i) {
        const int s = tid + 512 * i;
        if (key[i] > prefix) { const int pos = atomicAdd((int*)&cnts[0], 1); if (pos < 256) lst[pos] = s; }
        else if (key[i] == prefix && s <= PAST) { const int pos = atomicAdd((int*)&cnts[1], 1); if (pos < 64) eql[pos] = s; }
    }
    __syncthreads();
    const int ngt = cnts[0], neq = cnts[1] < 64 ? cnts[1] : 64, need = 256 - ngt;
    __syncthreads();
    if (tid < neq) {
        const int s = eql[tid]; int rank = 0;
        for (int j = 0; j < neq; ++j) rank += (eql[j] < s) ? 1 : 0;
        if (rank < need) { const int pos = atomicAdd((int*)&cnts[0], 1); if (pos < 256) lst[pos] = s; }
    }
    __syncthreads();
    {
        const int i = tid & 255, g = tid >> 8;
        const int s = lst[i]; int dn = PAST - s; dn = dn > 127 ? 127 : dn;
        const float* krow = s < PAST ? p.cache_k + (((size_t)p.page_table[b * NPAGES + (s >> 7)] * PAGE + (s & 127)) * 2 + g) * 64 : p.out + O_KS + (size_t)b * 128 + g * 64;
        float kf[64];
#pragma unroll
        for (int c = 0; c < 16; ++c) { const f32x4 v = ((const f32x4*)krow)[c]; kf[4 * c] = v.x; kf[4 * c + 1] = v.y; kf[4 * c + 2] = v.z; kf[4 * c + 3] = v.w; }
        for (int hh = 0; hh < 4; ++hh) {
            const int h = g * 4 + hh; float dot = 0.f;
#pragma unroll
            for (int d = 0; d < 64; ++d) dot += qa[h * 64 + d] * kf[d];
            pl[h * 256 + i] = dot + p.rel_table[(int)c_bucket[dn] * 8 + h];
        }
    }
    __syncthreads();
    {
        const int h = wave;
        float v[4]; float m = -3.0e38f;
#pragma unroll
        for (int j = 0; j < 4; ++j) { v[j] = pl[h * 256 + lane + 64 * j]; m = fmaxf(m, v[j]); }
        m = wave_max(m);
        float sum = 0.f;
#pragma unroll
        for (int j = 0; j < 4; ++j) { v[j] = __expf(v[j] - m); sum += v[j]; }
        const float inv = 1.f / wave_sum(sum);
#pragma unroll
        for (int j = 0; j < 4; ++j) pl[h * 256 + lane + 64 * j] = v[j] * inv;
    }
    __syncthreads();
    {
        const int d = tid & 63, h = tid >> 6, g = h >> 2;
        float acc = 0.f;
        for (int i = 0; i < 256; ++i) {
            const int s = lst[i];
            const float* vrow = s < PAST ? p.cache_v + (((size_t)p.page_table[b * NPAGES + (s >> 7)] * PAGE + (s & 127)) * 2 + g) * 64 : p.out + O_VS + (size_t)b * 128 + g * 64;
            acc += pl[h * 256 + i] * vrow[d];
        }
        const float z = bf2f(proj[r * NP + C_ZA + h * 64 + d]);
        mixed[r * D_MODEL + h * 64 + d] = (bf16_t)f2bf(acc * silu_f(z));
    }
    __syncthreads();
}

typedef _Float16 half_t;
constexpr int SCP = 2048;
constexpr int DSA_MK_OFF = 32 * SCP * 2;
__device__ __forceinline__ bf16x8 pack8_scaled(const u32x4 raw, float sc) {
    float f[8]; unpack8(raw, f);
    u32x4 o; o.x = pk2(f[0] * sc, f[1] * sc); o.y = pk2(f[2] * sc, f[3] * sc); o.z = pk2(f[4] * sc, f[5] * sc); o.w = pk2(f[6] * sc, f[7] * sc);
    return __builtin_bit_cast(bf16x8, o);
}
__device__ __forceinline__ void dsa_idx_unit(const Params& p, LAS unsigned char* lds, int b, int qb) {
    const int tid = threadIdx.x, lane = tid & 63, wave = __builtin_amdgcn_readfirstlane(tid >> 6);
    const int t0 = qb * 32, qh = wave & 1, kr = wave >> 1, q = lane & 15, g = lane >> 4;
    LAS unsigned short* SC = (LAS unsigned short*)lds;
    LAS unsigned* MK = (LAS unsigned*)(lds + DSA_MK_OFF);
    const bf16_t* proj = (const bf16_t*)(p.ws + WS_PROJ); const float* aux = (const float*)(p.ws + WS_AUX); unsigned* mask = (unsigned*)(p.ws + WS_MASK);
    {
        const size_t qrow = (size_t)(b * SEQ + t0 + 16 * qh + q);
        bf16x8 Qf[16][2]; unsigned sgn = 0u;
#pragma unroll
        for (int h = 0; h < 16; ++h) {
            const float w = aux[qrow * AUXP + h]; const float aw = fabsf(w) * (1.f / 32.f); if (w < 0.f) sgn |= 1u << h;
#pragma unroll
            for (int s = 0; s < 2; ++s) Qf[h][s] = pack8_scaled(*(const u32x4*)(proj + qrow * NP + C_QI + h * 64 + 32 * s + 8 * g), aw);
        }
        const int nkt = 2 * qb + 1 + qh;
        const bf16_t* kbase = proj + (size_t)(b * SEQ + q) * NP + C_KI + 8 * g;
        for (int kt = kr; kt < nkt; kt += 4) {
            const bf16_t* kp = kbase + (size_t)(16 * kt) * NP;
            const bf16x8 A0 = *(const bf16x8*)kp, A1 = *(const bf16x8*)(kp + 32);
            f32x4 sc = {0.f, 0.f, 0.f, 0.f};
#pragma unroll
            for (int h = 0; h < 16; ++h) {
                f32x4 acc = {0.f, 0.f, 0.f, 0.f};
                acc = __builtin_amdgcn_mfma_f32_16x16x32_bf16(A0, Qf[h][0], acc, 0, 0, 0);
                acc = __builtin_amdgcn_mfma_f32_16x16x32_bf16(A1, Qf[h][1], acc, 0, 0, 0);
                const float sg = ((sgn >> h) & 1u) ? -1.f : 1.f;
                sc[0] += sg * fmaxf(acc[0], 0.f); sc[1] += sg * fmaxf(acc[1], 0.f); sc[2] += sg * fmaxf(acc[2], 0.f); sc[3] += sg * fmaxf(acc[3], 0.f);
            }
            const unsigned lo = (unsigned)__builtin_bit_cast(unsigned short, (half_t)sc[0]) | ((unsigned)__builtin_bit_cast(unsigned short, (half_t)sc[1]) << 16);
            const unsigned hi = (unsigned)__builtin_bit_cast(unsigned short, (half_t)sc[2]) | ((unsigned)__builtin_bit_cast(unsigned short, (half_t)sc[3]) << 16);
            *(LAS unsigned long long*)(SC + (16 * qh + q) * SCP + 16 * kt + 4 * g) = (unsigned long long)lo | ((unsigned long long)hi << 32);
        }
    }
    __syncthreads();
    for (int qi = 0; qi < 4; ++qi) {
        const int ql = wave * 4 + qi, qpos = t0 + ql;
        const int nv = qpos + 1 - 32 * lane;
        const unsigned vm = nv >= 32 ? 0xffffffffu : (nv <= 0 ? 0u : ((1u << nv) - 1u));
        unsigned word = vm;
        if (qpos >= 256) {
            const LAS u32x4* src = (const LAS u32x4*)(SC + ql * SCP + 32 * lane);
            unsigned key[32];
#pragma unroll
            for (int c = 0; c < 4; ++c) {
                const u32x4 v = src[c];
#pragma unroll
                for (int e = 0; e < 4; ++e) {
                    unsigned x = v[e];
                    const unsigned neg = ((x >> 15) & 0x00010001u) * 0xFFFFu;
                    x ^= (neg | 0x80008000u);
                    key[8 * c + 2 * e] = x & 0xFFFFu; key[8 * c + 2 * e + 1] = x >> 16;
                }
            }
#pragma unroll
            for (int j = 0; j < 32; ++j) if (j >= nv) key[j] = 0u;
            unsigned prefix = 0u;
            for (int bit = 15; bit >= 0; --bit) {
                const unsigned cand = prefix | (1u << bit);
                int c = 0;
#pragma unroll
                for (int j = 0; j < 32; ++j) c += __popcll(__ballot(key[j] >= cand));
                if (c >= 256) prefix = cand;
            }
            int cgt = 0, ceq = 0;
#pragma unroll
            for (int j = 0; j < 32; ++j) { cgt += __popcll(__ballot(key[j] > prefix)); ceq += (key[j] == prefix) ? 1 : 0; }
            const int need = 256 - cgt;
            int run = wave_excl_scan_i(ceq, lane);
            word = 0u;
#pragma unroll
            for (int j = 0; j < 32; ++j) {
                if (key[j] > prefix) word |= (1u << j);
                else if (key[j] == prefix) { if (run < need) word |= (1u << j); ++run; }
            }
            word &= vm;
        }
        MK[ql * 65 + lane] = word;
#ifdef DBG_CMP
        mask[(size_t)(b * SEQ + qpos) * 64 + lane] = word;
#endif
    }
    __syncthreads();
}
typedef float f32x16 __attribute__((ext_vector_type(16)));
typedef short s16x4 __attribute__((ext_vector_type(4)));
constexpr int KVP = 272, KVT = 32 * KVP;
constexpr int DSA_BD_OFF = DSA_MK_OFF + 32 * 65 * 4;
static_assert(DSA_BD_OFF + 8 * 128 * 4 <= SCR_BYTES, "LDS map");
__device__ __forceinline__ s16x4 tr16(const LAS unsigned char* p) { return __builtin_bit_cast(s16x4, __builtin_amdgcn_ds_read_tr16_b64_v4i16((LAS s16x4*)p)); }
__device__ __forceinline__ void dsa_fill_bias(const Params& p, LAS unsigned char* lds) {
    LAS float* BD = (LAS float*)(lds + DSA_BD_OFF);
    for (int i = threadIdx.x; i < 1024; i += NTHR) { const int h = i >> 7, n = i & 127; BD[i] = p.rel_table[(int)c_bucket[n] * 8 + h] * 1.4426950408889634f; }
    __syncthreads();
}
__device__ __forceinline__ void dsa_attn_stage(const Params& p, LAS unsigned char* lds, int b, int qb) {
    const int tid = threadIdx.x, lane = tid & 63, wave = __builtin_amdgcn_readfirstlane(tid >> 6);
    const int g = wave >> 2, r = lane & 31, hh = lane >> 5, t0 = qb * 32;
    const LAS unsigned* MK = (const LAS unsigned*)(lds + DSA_MK_OFF);
    const LAS float* BD = (const LAS float*)(lds + DSA_BD_OFF) + wave * 128;
    const bf16_t* proj = (const bf16_t*)(p.ws + WS_PROJ); bf16_t* mixed = (bf16_t*)(p.ws + WS_MIXED);
    const size_t qrow = (size_t)(b * SEQ + t0 + r);
    bf16x8 Qf[4];
#pragma unroll
    for (int s = 0; s < 4; ++s) Qf[s] = *(const bf16x8*)(proj + qrow * NP + C_Q + wave * 64 + 16 * s + 8 * hh);
    f32x16 O0, O1;
#pragma unroll
    for (int i = 0; i < 16; ++i) { O0[i] = 0.f; O1[i] = 0.f; }
    float m = -1e30f, l = 0.f;
    const float c31 = BD[127];
    const int nkt = qb + 1, qpos = t0 + r;
    const int skey = tid >> 4, sch = tid & 15;
    const bf16_t* sbase = proj + (size_t)(b * SEQ + skey) * NP + C_K + 16 * sch;
    const unsigned sdst = (unsigned)(skey * KVP + (sch & 7) * 32 + (sch >> 3) * KVT);
    u32x4 st0 = *(const u32x4*)sbase, st1 = *(const u32x4*)(sbase + 8);
    *(LAS u32x4*)(lds + sdst) = st0; *(LAS u32x4*)(lds + sdst + 16) = st1;
    __syncthreads();
    const int i16 = lane & 15, G1 = (lane >> 4) & 1;
    const unsigned vlane = (unsigned)((4 * hh + (i16 >> 2)) * KVP + g * 128 + (16 * G1 + 4 * (i16 & 3)) * 2);
    const unsigned klane = (unsigned)(r * KVP + g * 128 + hh * 16);
    for (int kt = 0; kt < nkt; ++kt) {
        const int cur = kt & 1;
        const bool more = (kt + 1 < nkt);
        if (more) { const bf16_t* sp = sbase + (size_t)(32 * (kt + 1)) * NP; st0 = *(const u32x4*)sp; st1 = *(const u32x4*)(sp + 8); }
        const LAS unsigned char* Kb = lds + cur * (2 * KVT); const LAS unsigned char* Vb = Kb + KVT;
        f32x16 acc;
#pragma unroll
        for (int i = 0; i < 16; ++i) acc[i] = 0.f;
#pragma unroll
        for (int s = 0; s < 4; ++s) { const bf16x8 Kf = *(const LAS bf16x8*)(Kb + klane + s * 32); acc = __builtin_amdgcn_mfma_f32_32x32x16_bf16(Kf, Qf[s], acc, 0, 0, 0); }
        const unsigned wsh = MK[r * 65 + kt] >> (4 * hh);
        const int kb0 = 32 * kt + 4 * hh;
        float x[16];
        if (t0 - 32 * kt - 31 >= 113) {
#pragma unroll
            for (int i = 0; i < 16; ++i) x[i] = acc[i] * 0.18033688011112042f + c31;
        } else {
#pragma unroll
            for (int i = 0; i < 16; ++i) { int d = qpos - (kb0 + (i & 3) + 8 * (i >> 2)); d = d < 0 ? 0 : (d > 127 ? 127 : d); x[i] = acc[i] * 0.18033688011112042f + BD[d]; }
        }
        float tmax = -INFINITY;
#pragma unroll
        for (int i = 0; i < 16; ++i) { x[i] = ((wsh >> ((i & 3) + 8 * (i >> 2))) & 1u) ? x[i] : -INFINITY; tmax = fmaxf(tmax, x[i]); }
        tmax = fmaxf(tmax, __shfl_xor(tmax, 32));
        if (!__all(tmax - m <= 8.f)) {
            const float mn = fmaxf(m, tmax), alpha = __builtin_amdgcn_exp2f(m - mn);
#pragma unroll
            for (int i = 0; i < 16; ++i) { O0[i] *= alpha; O1[i] *= alpha; }
            l *= alpha; m = mn;
        }
        float ps = 0.f;
#pragma unroll
        for (int i = 0; i < 16; ++i) { x[i] = __builtin_amdgcn_exp2f(x[i] - m); ps += x[i]; }
        l += ps;
        u32x4 pw0, pw1;
        pw0.x = pk2(x[0], x[1]); pw0.y = pk2(x[2], x[3]); pw0.z = pk2(x[4], x[5]); pw0.w = pk2(x[6], x[7]);
        pw1.x = pk2(x[8], x[9]); pw1.y = pk2(x[10], x[11]); pw1.z = pk2(x[12], x[13]); pw1.w = pk2(x[14], x[15]);
        const bf16x8 P0 = __builtin_bit_cast(bf16x8, pw0), P1 = __builtin_bit_cast(bf16x8, pw1);
#pragma unroll
        for (int s = 0; s < 2; ++s) {
            const bf16x8 Ps = s ? P1 : P0;
#pragma unroll
            for (int c = 0; c < 2; ++c) {
                const s16x4 lo = tr16(Vb + vlane + (16 * s) * KVP + c * 64), hi = tr16(Vb + vlane + (16 * s + 8) * KVP + c * 64);
                const bf16x8 Vf = (bf16x8){lo[0], lo[1], lo[2], lo[3], hi[0], hi[1], hi[2], hi[3]};
                if (c == 0) O0 = __builtin_amdgcn_mfma_f32_32x32x16_bf16(Vf, Ps, O0, 0, 0, 0);
                else O1 = __builtin_amdgcn_mfma_f32_32x32x16_bf16(Vf, Ps, O1, 0, 0, 0);
            }
        }
        if (more) { LAS unsigned char* d = lds + (cur ^ 1) * (2 * KVT) + sdst; *(LAS u32x4*)d = st0; *(LAS u32x4*)(d + 16) = st1; }
        __syncthreads();
    }
    l += __shfl_xor(l, 32);
    const float inv = 1.f / l;
#pragma unroll
    for (int c = 0; c < 2; ++c)
#pragma unroll
        for (int rg = 0; rg < 4; ++rg) {
            const int d0 = 32 * c + 8 * rg + 4 * hh;
            const unsigned long long zz = *(const unsigned long long*)(proj + qrow * NP + C_ZA + wave * 64 + d0);
            const float z0 = bf2f((unsigned short)(zz & 0xffff)), z1 = bf2f((unsigned short)((zz >> 16) & 0xffff)), z2 = bf2f((unsigned short)((zz >> 32) & 0xffff)), z3 = bf2f((unsigned short)(zz >> 48));
            const float o0 = (c ? O1[4 * rg] : O0[4 * rg]) * inv, o1 = (c ? O1[4 * rg + 1] : O0[4 * rg + 1]) * inv, o2 = (c ? O1[4 * rg + 2] : O0[4 * rg + 2]) * inv, o3 = (c ? O1[4 * rg + 3] : O0[4 * rg + 3]) * inv;
            const unsigned long long w = (unsigned long long)pk2(o0 * silu_f(z0), o1 * silu_f(z1)) | ((unsigned long long)pk2(o2 * silu_f(z2), o3 * silu_f(z3)) << 32);
            *(unsigned long long*)(mixed + qrow * D_MODEL + wave * 64 + d0) = w;
        }
}
__device__ __forceinline__ void dsa_unit_of(int w, int k, int& b, int& qb) {
    const int u = w + 256 * k; b = u & 31; const int a = (w >> 5) & 7; const int j = 8 * k + ((k & 1) ? 7 - a : a); qb = 63 - j;
}

constexpr int GP = 272, GP64 = 144;
constexpr int IMG_NEGW = 0, IMG_QD = 17408, IMG_KDT = 34816, IMG_AQK = 53248, IMG_BYTES = 65536;
constexpr size_t GDN_UNIT_BYTES = IMG_BYTES + 32768;
__device__ __forceinline__ int kperm(int c) { return (c & ~31) | (((c >> 2) & 3) << 3) | (((c >> 4) & 1) << 2) | (c & 3); }
constexpr int GL_QS = 0, GL_KS = 17408, GL_BM = 34816, GL_KDT = 100352, GL_AT = 118784, GL_GT = 135168, GL_AQK = 135936;
static_assert(GL_AQK + 9216 <= SCR_BYTES, "LDS map");
__device__ __forceinline__ void gdn_local_unit(const Params& p, LAS unsigned char* lds, int unit) {
    const int tid = threadIdx.x, lane = tid & 63, wave = __builtin_amdgcn_readfirstlane(tid >> 6);
    const int n = unit & 31, bh = unit >> 5, h = bh & 3, b = bh >> 2;
    const int row0 = b * SEQ + 64 * n;
    LAS float* GT = (LAS float*)(lds + GL_GT);
    LAS float* Bm = (LAS float*)(lds + GL_BM);
    LAS float* AT = (LAS float*)(lds + GL_AT);
    const bf16_t* proj = (const bf16_t*)(p.ws + WS_PROJ); const float* aux = (const float*)(p.ws + WS_AUX);
    unsigned char* img = p.ws + WS_GDN + (size_t)unit * GDN_UNIT_BYTES;
    if (wave == 0) {
        const size_t r = (size_t)(row0 + lane);
        const float ag = aux[r * AUXP + 16 + h], bg = aux[r * AUXP + 20 + h];
        const float xg = ag + p.dt_bias[h];
        const float sp = xg > 20.f ? xg : log1pf(__expf(xg));
        float gc = -__expf(p.a_log[h]) * sp;
#pragma unroll
        for (int o = 1; o < 64; o <<= 1) { const float y = __shfl_up(gc, o); if (lane >= o) gc += y; }
        GT[lane] = gc; GT[64 + lane] = 1.f / (1.f + __expf(-bg)); GT[128 + lane] = __expf(gc);
    }
    __syncthreads();
    {
        float f[3][8][2];
#pragma unroll
        for (int part = 0; part < 3; ++part) {
            const int ch = part * 512 + h * 128 + 2 * lane;
            float w[4][2];
#pragma unroll
            for (int j = 0; j < 4; ++j) { const f32x2 t = *(const f32x2*)(p.conv_w + j * 1536 + ch); w[j][0] = t.x; w[j][1] = t.y; }
            float x[11][2];
#pragma unroll
            for (int i = 0; i < 11; ++i) {
                const int tt = 64 * n + 8 * wave - 3 + i;
                unsigned v = 0u;
                if (tt >= 0) v = *(const unsigned*)(proj + (size_t)(b * SEQ + tt) * NP + C_QKV + ch);
                x[i][0] = __builtin_bit_cast(float, v << 16); x[i][1] = __builtin_bit_cast(float, v & 0xffff0000u);
            }
#pragma unroll
            for (int i = 0; i < 8; ++i) {
                const float y0 = x[i][0] * w[0][0] + x[i + 1][0] * w[1][0] + x[i + 2][0] * w[2][0] + x[i + 3][0] * w[3][0];
                const float y1 = x[i][1] * w[0][1] + x[i + 1][1] * w[1][1] + x[i + 2][1] * w[2][1] + x[i + 3][1] * w[3][1];
                f[part][i][0] = silu_f(y0); f[part][i][1] = silu_f(y1);
            }
        }
        const float glast = GT[63];
#pragma unroll
        for (int i = 0; i < 8; ++i) {
            const int t = 8 * wave + i;
            const float qn = rsqrtf(wave_sum(f[0][i][0] * f[0][i][0] + f[0][i][1] * f[0][i][1]) + 1e-6f) * 0.08838834764831845f;
            const float kn = rsqrtf(wave_sum(f[1][i][0] * f[1][i][0] + f[1][i][1] * f[1][i][1]) + 1e-6f);
            const float gc = GT[t], beta = GT[64 + t], eg = GT[128 + t], egl = __expf(glast - gc);
            const float q0 = f[0][i][0] * qn, q1 = f[0][i][1] * qn, k0 = f[1][i][0] * kn, k1 = f[1][i][1] * kn;
            *(LAS unsigned*)(lds + GL_QS + t * GP + 4 * lane) = pk2(q0, q1);
            *(LAS unsigned*)(lds + GL_KS + t * GP + 4 * lane) = pk2(k0, k1);
            *(LAS f32x2*)(Bm + t * 256 + 2 * lane) = (f32x2){f[2][i][0] * beta, f[2][i][1] * beta};
            *(LAS f32x2*)(Bm + t * 256 + 128 + 2 * lane) = (f32x2){k0 * beta * eg, k1 * beta * eg};
            *(unsigned*)(img + IMG_QD + t * GP + 2 * kperm(2 * lane)) = pk2(q0 * eg, q1 * eg);
            const int tp = kperm(t);
            *(LAS unsigned short*)(lds + GL_KDT + (2 * lane) * GP64 + 2 * tp) = (unsigned short)f2bf(k0 * egl);
            *(LAS unsigned short*)(lds + GL_KDT + (2 * lane + 1) * GP64 + 2 * tp) = (unsigned short)f2bf(k1 * egl);
        }
    }
    __syncthreads();
    {
        const int c = lane & 15, g = lane >> 4;
#pragma unroll
        for (int it = 0; it < 4; ++it) {
            const int idx = wave + 8 * it, which = idx >> 4, mi = (idx >> 2) & 3, nj = idx & 3;
            const LAS unsigned char* Ab = lds + (which ? GL_QS : GL_KS) + (16 * mi + c) * GP + 16 * g;
            const LAS unsigned char* Bb = lds + GL_KS + (16 * nj + c) * GP + 16 * g;
            f32x4 acc = {0.f, 0.f, 0.f, 0.f};
#pragma unroll
            for (int s2 = 0; s2 < 4; ++s2) acc = __builtin_amdgcn_mfma_f32_16x16x32_bf16(*(const LAS bf16x8*)(Ab + 64 * s2), *(const LAS bf16x8*)(Bb + 64 * s2), acc, 0, 0, 0);
            const int tc = 16 * nj + c; const float gcc = GT[tc];
            float val[4];
#pragma unroll
            for (int e = 0; e < 4; ++e) {
                const int t = 16 * mi + 4 * g + e;
                const float dec = __expf(fminf(GT[t] - gcc, 0.f));
                if (which == 0) val[e] = (t > tc) ? GT[64 + t] * acc[e] * dec : 0.f;
                else val[e] = (t >= tc) ? acc[e] * dec : 0.f;
            }
            if (which == 0) *(LAS f32x4*)(AT + tc * 64 + 16 * mi + 4 * g) = (f32x4){val[0], val[1], val[2], val[3]};
            else {
                const int tcp = kperm(tc);
#pragma unroll
                for (int e = 0; e < 4; ++e) *(LAS unsigned short*)(lds + GL_AQK + (16 * mi + 4 * g + e) * GP64 + 2 * tcp) = (unsigned short)f2bf(val[e]);
            }
        }
    }
    __syncthreads();
    if (wave < 4) {
        const int col = 64 * wave + lane;
        float U[64];
#pragma unroll
        for (int i = 0; i < 64; ++i) U[i] = Bm[i * 256 + col];
#pragma unroll
        for (int j = 0; j < 63; ++j) {
            const float uj = U[j];
#pragma unroll
            for (int q4 = (j + 1) >> 2; q4 < 16; ++q4) {
                const f32x4 a = *(const LAS f32x4*)(AT + j * 64 + 4 * q4);
                U[4 * q4] -= a[0] * uj; U[4 * q4 + 1] -= a[1] * uj; U[4 * q4 + 2] -= a[2] * uj; U[4 * q4 + 3] -= a[3] * uj;
            }
        }
        if (wave < 2) {
            float* Ug = (float*)(img + IMG_BYTES);
#pragma unroll
            for (int i = 0; i < 64; ++i) Ug[i * 128 + col] = U[i];
        } else {
            const int cp = kperm(col - 128);
#pragma unroll
            for (int i = 0; i < 64; ++i) *(unsigned short*)(img + IMG_NEGW + i * GP + 2 * cp) = (unsigned short)f2bf(-U[i]);
        }
    } else {
        const int t2 = tid - 256;
        for (int i = t2; i < (18432 + 9216) / 16; i += 256) {
            if (i < 1152) *(u32x4*)(img + IMG_KDT + 16 * i) = *(const LAS u32x4*)(lds + GL_KDT + 16 * i);
            else *(u32x4*)(img + IMG_AQK + 16 * (i - 1152)) = *(const LAS u32x4*)(lds + GL_AQK + 16 * (i - 1152));
        }
        if (t2 == 0) ((float*)(p.ws + WS_CD))[unit] = GT[128 + 63];
    }
    __syncthreads();
}

constexpr int GS_OX = IMG_BYTES;
__device__ __forceinline__ void gdn_seq_unit(const Params& p, LAS unsigned char* lds, int bh, bf16_t* mixed) {
    const int tid = threadIdx.x, lane = tid & 63, wave = __builtin_amdgcn_readfirstlane(tid >> 6);
    const int c = lane & 15, g = lane >> 4, h = bh & 3, b = bh >> 2, col0 = 16 * wave;
    const bf16_t* proj = (const bf16_t*)(p.ws + WS_PROJ);
    const unsigned char* ubase = p.ws + WS_GDN + (size_t)(bh * 32) * GDN_UNIT_BYTES;
    const float* cdp = (const float*)(p.ws + WS_CD) + bh * 32;
    LAS float* OX = (LAS float*)(lds + GS_OX);
    f32x4 S[8];
#pragma unroll
    for (int rb = 0; rb < 8; ++rb) S[rb] = (f32x4){0.f, 0.f, 0.f, 0.f};
    {
        u32x4 pre[8];
#pragma unroll
        for (int i = 0; i < 8; ++i) pre[i] = *(const u32x4*)(ubase + (size_t)(i * 512 + tid) * 16);
#pragma unroll
        for (int i = 0; i < 8; ++i) *(LAS u32x4*)(lds + (i * 512 + tid) * 16) = pre[i];
    }
    const float gn0 = p.gdn_norm[lane], gn1 = p.gdn_norm[lane + 64];
    __syncthreads();
    for (int n = 0; n < 32; ++n) {
        const unsigned char* ub = ubase + (size_t)n * GDN_UNIT_BYTES;
        u32x4 pre[8];
        if (n + 1 < 32) {
#pragma unroll
            for (int i = 0; i < 8; ++i) pre[i] = *(const u32x4*)(ub + GDN_UNIT_BYTES + (size_t)(i * 512 + tid) * 16);
        }
        const float* Ug = (const float*)(ub + IMG_BYTES);
        f32x4 vn[4], O[4];
#pragma unroll
        for (int mb = 0; mb < 4; ++mb) {
#pragma unroll
            for (int e = 0; e < 4; ++e) vn[mb][e] = Ug[(16 * mb + 4 * g + e) * 128 + col0 + c];
            O[mb] = (f32x4){0.f, 0.f, 0.f, 0.f};
        }
        const float cd = cdp[n];
        bf16x8 SB[4];
#pragma unroll
        for (int s2 = 0; s2 < 4; ++s2) {
            u32x4 w; w.x = pk2(S[2 * s2][0], S[2 * s2][1]); w.y = pk2(S[2 * s2][2], S[2 * s2][3]); w.z = pk2(S[2 * s2 + 1][0], S[2 * s2 + 1][1]); w.w = pk2(S[2 * s2 + 1][2], S[2 * s2 + 1][3]);
            SB[s2] = __builtin_bit_cast(bf16x8, w);
        }
        const LAS unsigned char* a128 = lds + c * GP + 16 * g;
        const LAS unsigned char* a64 = lds + c * GP64 + 16 * g;
#pragma unroll
        for (int mb = 0; mb < 4; ++mb)
#pragma unroll
            for (int s2 = 0; s2 < 4; ++s2) {
                vn[mb] = __builtin_amdgcn_mfma_f32_16x16x32_bf16(*(const LAS bf16x8*)(a128 + IMG_NEGW + 16 * mb * GP + 64 * s2), SB[s2], vn[mb], 0, 0, 0);
                O[mb] = __builtin_amdgcn_mfma_f32_16x16x32_bf16(*(const LAS bf16x8*)(a128 + IMG_QD + 16 * mb * GP + 64 * s2), SB[s2], O[mb], 0, 0, 0);
            }
        bf16x8 VB[2];
#pragma unroll
        for (int s2 = 0; s2 < 2; ++s2) {
            u32x4 w; w.x = pk2(vn[2 * s2][0], vn[2 * s2][1]); w.y = pk2(vn[2 * s2][2], vn[2 * s2][3]); w.z = pk2(vn[2 * s2 + 1][0], vn[2 * s2 + 1][1]); w.w = pk2(vn[2 * s2 + 1][2], vn[2 * s2 + 1][3]);
            VB[s2] = __builtin_bit_cast(bf16x8, w);
        }
#pragma unroll
        for (int mb = 0; mb < 4; ++mb)
#pragma unroll
            for (int s2 = 0; s2 < 2; ++s2) O[mb] = __builtin_amdgcn_mfma_f32_16x16x32_bf16(*(const LAS bf16x8*)(a64 + IMG_AQK + 16 * mb * GP64 + 64 * s2), VB[s2], O[mb], 0, 0, 0);
#pragma unroll
        for (int rb = 0; rb < 8; ++rb) {
            S[rb] = S[rb] * cd;
#pragma unroll
            for (int s2 = 0; s2 < 2; ++s2) S[rb] = __builtin_amdgcn_mfma_f32_16x16x32_bf16(*(const LAS bf16x8*)(a64 + IMG_KDT + 16 * rb * GP64 + 64 * s2), VB[s2], S[rb], 0, 0, 0);
        }
#pragma unroll
        for (int mb = 0; mb < 4; ++mb)
#pragma unroll
            for (int e = 0; e < 4; ++e) OX[(16 * mb + 4 * g + e) * 132 + col0 + c] = O[mb][e];
        __syncthreads();
#pragma unroll
        for (int i = 0; i < 8; ++i) {
            const int t = 8 * wave + i; const size_t r = (size_t)(b * SEQ + 64 * n + t);
            const float o0 = OX[t * 132 + lane], o1 = OX[t * 132 + 64 + lane];
            const float rs = rsqrtf(wave_sum(o0 * o0 + o1 * o1) * (1.f / 128.f) + 1e-6f);
            const float z0 = bf2f(proj[r * NP + C_ZG + h * 128 + lane]), z1 = bf2f(proj[r * NP + C_ZG + h * 128 + 64 + lane]);
            mixed[r * D_MODEL + 512 + h * 128 + lane] = (bf16_t)f2bf(o0 * rs * gn0 * silu_f(z0));
            mixed[r * D_MODEL + 512 + h * 128 + 64 + lane] = (bf16_t)f2bf(o1 * rs * gn1 * silu_f(z1));
        }
        if (n + 1 < 32) {
#pragma unroll
            for (int i = 0; i < 8; ++i) *(LAS u32x4*)(lds + (i * 512 + tid) * 16) = pre[i];
        }
        __syncthreads();
    }
    float* So = p.out + O_SSMP + (size_t)bh * 128 * 128;
#pragma unroll
    for (int rb = 0; rb < 8; ++rb)
#pragma unroll
        for (int e = 0; e < 4; ++e) So[(16 * rb + 4 * g + e) * 128 + col0 + c] = S[rb][e];
}

constexpr int N_PHASES = 6;
struct Args { Params p; int ph_lo, ph_hi; };
__global__ void __launch_bounds__(NTHR, 2) mk_fwd(Args a) {
    extern __shared__ __attribute__((aligned(16))) unsigned char lds_raw[];
    LAS unsigned char* lds = (LAS unsigned char*)lds_raw;
    const Params& p = a.p;
    volatile LAS unsigned* MISC = (volatile LAS unsigned*)(lds + MISC_OFF);
    for (int u = threadIdx.x; u < (LDS_BYTES - SCR_BYTES) / 4; u += NTHR) ((LAS unsigned*)(lds + SCR_BYTES))[u] = 0u;
    __syncthreads();
    const int lo = a.ph_lo, hi = a.ph_hi;
    const bool multi = (hi - lo) > 1;
    XcdBarrier bar; bar.bar = (unsigned*)(p.ws + WS_CTL) + CW_BAR; bar.x = 0; bar.st = nullptr;
    if (multi) bar = xcd_barrier_post((unsigned*)(p.ws + WS_CTL) + CW_BAR, MISC + 8);
#define IN(k) (lo <= (k) && (k) < hi)
#define SEAM(k) do { if (IN(k) && IN((k) + 1)) xcd_barrier(bar); } while (0)
    if (IN(0)) { ph_prologue(p, lds); __syncthreads(); }
    SEAM(0);
    if (IN(1)) {
        pg8::Gemm g{(const bf16_t*)(p.ws + WS_XN), (const bf16_t*)(p.ws + WS_WINT), MP, NP, 1024};
        pg8::StaticOrder S; S.init(MP, NP, gridDim.x, blockIdx.x);
        EpiIn E{(bf16_t*)(p.ws + WS_PROJ), (float*)(p.ws + WS_AUX), p.out};
        pg8::gemm_phase<EpiIn, pg8::StaticOrder, true, true>(lds, g, S, E);
    }
    SEAM(1);
    if (IN(2)) {
        for (int u = blockIdx.x; u < BATCH * 4 * 32; u += gridDim.x) gdn_local_unit(p, lds, u);
        dsa_fill_bias(p, lds);
        if (gridDim.x == 256) { for (int k = 0; k < 8; ++k) { int b, qb; dsa_unit_of(blockIdx.x, k, b, qb); dsa_idx_unit(p, lds, b, qb); dsa_attn_stage(p, lds, b, qb); } }
        else { for (int u = blockIdx.x; u < BATCH * 64; u += gridDim.x) { dsa_idx_unit(p, lds, u & 31, 63 - (u >> 5)); dsa_attn_stage(p, lds, u & 31, 63 - (u >> 5)); } }
    }
    SEAM(2);
    if (IN(3)) {
        const int G = gridDim.x, half = G / 2;
        if ((int)blockIdx.x < half) { for (int u = blockIdx.x; u < BATCH * 4; u += half) gdn_seq_unit(p, lds, u, (bf16_t*)(p.ws + WS_MIXED)); }
        else {
            for (int u = (int)blockIdx.x - half; u < DEC_BATCH; u += G - half) {
                nv_sample_unit(p, lds, u);
                for (int hh = 0; hh < 4; ++hh) nv_gdn_unit<1>(p, lds, 4 * u + hh, (bf16_t*)(p.ws + WS_MIXED), p.out + O_SSMS);
            }
        }
    }
    SEAM(3);
    if (IN(4)) {
        pg8::Gemm g{(const bf16_t*)(p.ws + WS_MIXED), (const bf16_t*)(p.ws + WS_WOUTT), MP, 1024, 1024};
        pg8::StaticOrder S; S.init(MP, 1024, gridDim.x, blockIdx.x);
        EpiOut E{p.x_prompt, p.x_sample, p.out, (float*)(p.ws + WS_ROWSS)};
        pg8::gemm_phase<EpiOut, pg8::StaticOrder, true, true>(lds, g, S, E);
    }
    SEAM(4);
#ifdef DBG_CMP
    if (IN(5)) {
        for (int u = blockIdx.x; u < BATCH * 4; u += gridDim.x) nv_gdn_unit<0>(p, lds, u, (bf16_t*)(p.ws + WS_DBG), (float*)(p.ws + WS_DBG + 200 * MiB));
        xcd_barrier(bar);
        {
            const bf16_t* A = (const bf16_t*)(p.ws + WS_MIXED); const bf16_t* R = (const bf16_t*)(p.ws + WS_DBG);
            float num = 0.f, den = 0.f;
            for (size_t i = (size_t)blockIdx.x * NTHR + threadIdx.x; i < (size_t)MPROMPT * 512; i += (size_t)gridDim.x * NTHR) {
                const size_t row = i >> 9, col = 512 + (i & 511); const float a = bf2f(A[row * D_MODEL + col]), r = bf2f(R[row * D_MODEL + col]);
                num += (a - r) * (a - r); den += r * r;
            }
            num = wave_sum(num); den = wave_sum(den);
            if ((threadIdx.x & 63) == 0) { atomicAdd((float*)(p.ws + WS_DBGACC), num); atomicAdd((float*)(p.ws + WS_DBGACC) + 1, den); }
        }
        xcd_barrier(bar);
    }
#endif
    if (IN(5)) ph_final_norm(p);
#undef IN
#undef SEAM
}

#ifndef MK_N_LAUNCHES
#define MK_N_LAUNCHES 1
#endif
extern "C" void kernel_launch(void* const* d_in, const int* in_sizes, int n_in, void* d_out, int out_size, void* d_ws, size_t ws_size, hipStream_t stream) {
    static int grid = 0;
    if (grid == 0) {
        if (n_in != 17 || (size_t)out_size != O_END || ws_size < WS_END) { fprintf(stderr, "kernel_launch: unexpected shapes n_in %d out %d ws %zu\n", n_in, out_size, ws_size); grid = -1; return; }
        int dev = 0, cus = 0, per_cu = 0;
        if (hipGetDevice(&dev) != hipSuccess || hipDeviceGetAttribute(&cus, hipDeviceAttributeMultiprocessorCount, dev) != hipSuccess) { grid = -1; return; }
        if (hipFuncSetAttribute((const void*)mk_fwd, hipFuncAttributeMaxDynamicSharedMemorySize, LDS_BYTES) != hipSuccess) { fprintf(stderr, "kernel_launch: hipFuncSetAttribute failed\n"); grid = -1; return; }
        if (hipOccupancyMaxActiveBlocksPerMultiprocessor(&per_cu, (const void*)mk_fwd, NTHR, LDS_BYTES) != hipSuccess || per_cu < 1) { fprintf(stderr, "kernel_launch: occupancy query says %d blocks per CU\n", per_cu); (void)hipGetLastError(); }
        grid = cus;
    }
    if (grid < 0) return;
    Args a{};
    Params& p = a.p;
    p.x_prompt = (const float*)d_in[0]; p.x_sample = (const float*)d_in[1]; p.cache_k = (const float*)d_in[2]; p.cache_v = (const float*)d_in[3]; p.cache_kidx = (const float*)d_in[4];
    p.state_ssm = (const float*)d_in[5]; p.state_conv = (const float*)d_in[6]; p.page_table = (const int*)d_in[7]; p.norm_in = (const float*)d_in[8]; p.w_in = (const float*)d_in[9];
    p.conv_w = (const float*)d_in[10]; p.a_log = (const float*)d_in[11]; p.dt_bias = (const float*)d_in[12]; p.gdn_norm = (const float*)d_in[13]; p.w_out = (const float*)d_in[14];
    p.rel_table = (const float*)d_in[15]; p.norm_final = (const float*)d_in[16]; p.out = (float*)d_out; p.ws = (unsigned char*)d_ws;
    (void)hipMemsetAsync((char*)d_ws + WS_CTL, 0, CTL_BYTES, stream);
#if MK_N_LAUNCHES == 1
    a.ph_lo = 0; a.ph_hi = N_PHASES;
    hipLaunchKernelGGL(mk_fwd, dim3(grid), dim3(NTHR), LDS_BYTES, stream, a);
#else
    for (int k = 0; k < N_PHASES; ++k) { a.ph_lo = k; a.ph_hi = k + 1; hipLaunchKernelGGL(mk_fwd, dim3(grid), dim3(NTHR), LDS_BYTES, stream, a); }
#endif
}
```

```cpp
#include <hip/hip_runtime.h>
#define TSEL1 3
#define TSEL2 4
#include <cstdio>
#include <cstdint>

#define LAS __attribute__((address_space(3)))
#define GAS __attribute__((address_space(1)))
typedef unsigned short bf16_t;
typedef short bf16x8 __attribute__((ext_vector_type(8)));
typedef float f32x4 __attribute__((ext_vector_type(4)));
typedef float f32x2 __attribute__((ext_vector_type(2)));
typedef unsigned u32x4 __attribute__((ext_vector_type(4)));

constexpr int D_MODEL = 1024, BATCH = 32, SEQ = 2048, DEC_BATCH = 128, PAST = 8192, PAGE = 128, NPAGES = 64;
constexpr int MPROMPT = BATCH * SEQ;
constexpr int MVALID = MPROMPT + DEC_BATCH;
constexpr int MP = MPROMPT + 256;
constexpr int NP = 4608;
constexpr int C_Q = 0, C_K = 512, C_V = 640, C_ZA = 768, C_QI = 1280, C_KI = 2304, C_WI = 2368, C_AG = 2384, C_BG = 2388, C_QKV = 2560, C_ZG = 4096;
constexpr int AUXP = 32;
constexpr size_t O_YP = 0, O_YS = 67108864, O_KP = 67239936, O_VP = 75628544, O_KIP = 84017152, O_SSMP = 88211456, O_CP = 90308608,
                 O_KS = 90456064, O_VS = 90472448, O_KIS = 90488832, O_SSMS = 90497024, O_CS = 98885632, O_END = 99475456;
constexpr size_t MiB = 1u << 20;
constexpr size_t WS_CTL = 0, CTL_BYTES = 1 * MiB;
constexpr size_t WS_ROWSS = 512 * 1024;
constexpr size_t WS_WINT = 2 * MiB;
constexpr size_t WS_WOUTT = 12 * MiB;
constexpr size_t WS_XN = 16 * MiB;
constexpr size_t WS_PROJ = 146 * MiB;
constexpr size_t WS_AUX = 726 * MiB;
constexpr size_t WS_MIXED = 736 * MiB;
constexpr size_t WS_MASK = 866 * MiB;
constexpr size_t WS_DBG = 900 * MiB;
constexpr size_t WS_DBGACC = 256 * 1024;
constexpr size_t WS_GDN = 1200 * MiB;
constexpr size_t WS_CD = 1586 * MiB;
constexpr size_t WS_MO = 1590 * MiB;
constexpr size_t WS_END = 1720 * MiB;

__constant__ unsigned char c_bucket[128] = {0, 1, 2, 3, 4, 5, 6, 7, 8, 9, 10, 11, 12, 13, 14, 15, 16, 16, 16, 17, 17, 18, 18, 18, 19, 19, 19, 20, 20, 20, 20, 21, 21, 21, 21, 22, 22, 22, 22, 22, 23, 23, 23, 23, 23, 23, 24, 24, 24, 24, 24, 24, 25, 25, 25, 25, 25, 25, 25, 26, 26, 26, 26, 26, 26, 26, 26, 27, 27, 27, 27, 27, 27, 27, 27, 27, 27, 28, 28, 28, 28, 28, 28, 28, 28, 28, 28, 29, 29, 29, 29, 29, 29, 29, 29, 29, 29, 29, 29, 30, 30, 30, 30, 30, 30, 30, 30, 30, 30, 30, 30, 30, 30, 31, 31, 31, 31, 31, 31, 31, 31, 31, 31, 31, 31, 31, 31, 31};

__device__ __forceinline__ float bf2f(unsigned short b) { return __builtin_bit_cast(float, (unsigned)b << 16); }
__device__ __forceinline__ unsigned f2bf(float f) { unsigned u = __builtin_bit_cast(unsigned, f); return (u + 0x7fffu + ((u >> 16) & 1u)) >> 16; }
typedef __bf16 bf16x2_t __attribute__((ext_vector_type(2)));
__device__ __forceinline__ unsigned pk2(float lo, float hi) { f32x2 v = {lo, hi}; bf16x2_t b = __builtin_convertvector(v, bf16x2_t); return __builtin_bit_cast(unsigned, b); }
template <int CTRL, int RM> __device__ __forceinline__ float dpp_z(float v) { return __builtin_bit_cast(float, __builtin_amdgcn_update_dpp(0, __builtin_bit_cast(int, v), CTRL, RM, 0xf, CTRL < 0x140)); }
template <int CTRL, int RM> __device__ __forceinline__ float dpp_k(float v) { const int iv = __builtin_bit_cast(int, v); return __builtin_bit_cast(float, __builtin_amdgcn_update_dpp(iv, iv, CTRL, RM, 0xf, false)); }
template <int CTRL, int RM> __device__ __forceinline__ int dpp_zi(int v) { return __builtin_amdgcn_update_dpp(0, v, CTRL, RM, 0xf, CTRL < 0x140); }
__device__ __forceinline__ int wave_incl_scan_dpp(int v) {
    v += dpp_zi<0x111, 0xf>(v); v += dpp_zi<0x112, 0xf>(v); v += dpp_zi<0x114, 0xf>(v); v += dpp_zi<0x118, 0xf>(v);
    v += dpp_zi<0x142, 0xa>(v); v += dpp_zi<0x143, 0xc>(v);
    return v;
}
__device__ __forceinline__ float wave_incl_scan_f(float v) {
    v += dpp_z<0x111, 0xf>(v); v += dpp_z<0x112, 0xf>(v); v += dpp_z<0x114, 0xf>(v); v += dpp_z<0x118, 0xf>(v);
    v += dpp_z<0x142, 0xa>(v); v += dpp_z<0x143, 0xc>(v);
    return v;
}
__device__ __forceinline__ float wave_sum_u(float v) {
    v += dpp_z<0x111, 0xf>(v); v += dpp_z<0x112, 0xf>(v); v += dpp_z<0x114, 0xf>(v); v += dpp_z<0x118, 0xf>(v);
    v += dpp_z<0x142, 0xa>(v); v += dpp_z<0x143, 0xc>(v);
    return __builtin_bit_cast(float, __builtin_amdgcn_readlane(__builtin_bit_cast(int, v), 63));
}
__device__ __forceinline__ float wave_sum(float v) {
#pragma unroll
    for (int o = 1; o < 64; o <<= 1) v += __shfl_xor(v, o);
    return v;
}
__device__ __forceinline__ int wave_sum_i(int v) {
#pragma unroll
    for (int o = 1; o < 64; o <<= 1) v += __shfl_xor(v, o);
    return v;
}
__device__ __forceinline__ float wave_max(float v) {
#pragma unroll
    for (int o = 1; o < 64; o <<= 1) v = fmaxf(v, __shfl_xor(v, o));
    return v;
}
__device__ __forceinline__ int wave_excl_scan_i(int v, int lane) {
    int x = v;
#pragma unroll
    for (int o = 1; o < 64; o <<= 1) { int y = __shfl_up(x, o); if (lane >= o) x += y; }
    return x - v;
}
__device__ __forceinline__ unsigned f2key(float f) { unsigned u = __builtin_bit_cast(unsigned, f); return (u & 0x80000000u) ? ~u : (u | 0x80000000u); }
__device__ __forceinline__ float silu_f(float z) { return z * __builtin_amdgcn_rcpf(1.f + __expf(-z)); }
__device__ __forceinline__ void unpack8(const u32x4 w, float* f) {
    f[0] = __builtin_bit_cast(float, w.x << 16); f[1] = __builtin_bit_cast(float, w.x & 0xffff0000u);
    f[2] = __builtin_bit_cast(float, w.y << 16); f[3] = __builtin_bit_cast(float, w.y & 0xffff0000u);
    f[4] = __builtin_bit_cast(float, w.z << 16); f[5] = __builtin_bit_cast(float, w.z & 0xffff0000u);
    f[6] = __builtin_bit_cast(float, w.w << 16); f[7] = __builtin_bit_cast(float, w.w & 0xffff0000u);
}

namespace pg8 {
#define PG8_LAS __attribute__((address_space(3)))
constexpr int BM = 256, BK = 64, HALF = 128, HTB = HALF * BK * 2, STAGE_BYTES = 8 * HTB, NXCD = 8, WGM = 8;
__host__ __device__ __forceinline__ int lds_byte(int r, int c) { const int st = (r >> 4) * 2 + (c >> 5), rr = r & 15, cc = c & 31, ob = rr * 64 + cc * 2; return st * 1024 + (ob ^ (((ob >> 9) & 1) << 5)); }
__host__ __device__ __forceinline__ void stage_rc(int b, int& R, int& C) { const int st = b / 1024, sb = b % 1024, swz = sb ^ (((sb >> 9) & 1) << 5); R = (st >> 1) * 16 + swz / 64; C = (st & 1) * 32 + (swz % 64) / 2; }
__host__ __device__ __forceinline__ int perm32(int rho) { const int n = rho >> 4, i = rho & 15; return 8 * (i >> 2) + 4 * n + (i & 3); }
struct Unit { int pm, pn; };
struct Gemm { const bf16_t* A; const bf16_t* Bt; int M, N, K; };
struct StaticOrder {
    int nM, nN, nwg, G, c;
    __host__ __device__ void init(int M, int N, int G_, int c_) { nM = M / BM; nN = N / BM; nwg = nM * nN; G = G_; c = c_; }
    __host__ __device__ bool next(int i, Unit& u) const {
        const long L = (long)i * G + c; if (L >= nwg) return false;
        int wgid = (int)L; { const int q = nwg / NXCD, r = nwg % NXCD, xcd = wgid % NXCD, off = wgid / NXCD; wgid = (xcd < r ? xcd * (q + 1) : r * (q + 1) + (xcd - r) * q) + off; }
        const int nig = WGM * nN, gid = wgid / nig, fm = gid * WGM, gsz = (nM - fm) < WGM ? (nM - fm) : WGM;
        u.pm = fm + ((wgid % nig) % gsz); u.pn = (wgid % nig) / gsz; return true;
    }
    __device__ __forceinline__ void a_ready(const Unit&) const {}
    __device__ __forceinline__ void done(const Unit&) const {}
};
__device__ __forceinline__ unsigned cvt_pk_bf16(float lo, float hi) { unsigned r; asm volatile("v_cvt_pk_bf16_f32 %0, %1, %2" : "=v"(r) : "v"(lo), "v"(hi)); return r; }

template <class Epi, class Sched, bool ALIGN_EPI = false, bool SP2 = false>
__device__ __forceinline__ void gemm_phase(PG8_LAS unsigned char* lds, const Gemm g, const Sched& S, const Epi& E) {
    const int tid = threadIdx.x, wid = __builtin_amdgcn_readfirstlane(tid >> 6), lane = tid & 63, wr = wid >> 2, wc = wid & 3, fr = lane & 15, fq = lane >> 4;
    const int K = g.K, nt = K / BK;
    unsigned voffA[2], voffB[2];
#pragma unroll
    for (int i = 0; i < 2; ++i) { int R, C; stage_rc(tid * 16 + i * 8192, R, C); const int Rb = Epi::PERM ? ((R & ~31) + perm32(R & 31)) : R;
        voffA[i] = (unsigned)(R * K + C) * 2u; voffB[i] = (unsigned)(Rb * K + C) * 2u; }
    const size_t kstep = (size_t)(BK * 2);
    const size_t hstep = (size_t)HALF * K * 2;
    const size_t tstep = 2 * hstep;
    const unsigned ldsw = (unsigned)wid * 1024u;
    const int aoff = lds_byte(wr * 64 + fr, fq * 8), boff = lds_byte(wc * 32 + fr, fq * 8);
#define PG8_SA(b, h) (((b) * 2 + (h)) * HTB)
#define PG8_SB(b, h) ((4 + (b) * 2 + (h)) * HTB)
#define PG8_STAGE(bufoff, gbase, voff) do { _Pragma("unroll") for (int _i = 0; _i < 2; ++_i) \
        __builtin_amdgcn_global_load_lds((const unsigned*)((const char*)(gbase) + (voff)[_i]), (PG8_LAS unsigned*)(lds + (bufoff) + ldsw + _i * 8192), 16, 0, 0); } while (0)
#define PG8_LDA(dst, b, h) do { _Pragma("unroll") for (int m = 0; m < 4; ++m) _Pragma("unroll") for (int k = 0; k < 2; ++k) dst[m][k] = *(const PG8_LAS bf16x8*)(lds + PG8_SA(b, h) + aoff + m * 2048 + k * 1024); } while (0)
#define PG8_LDB(dst, b, h) do { _Pragma("unroll") for (int n = 0; n < 2; ++n) _Pragma("unroll") for (int k = 0; k < 2; ++k) dst[n][k] = *(const PG8_LAS bf16x8*)(lds + PG8_SB(b, h) + boff + n * 2048 + k * 1024); } while (0)
#define PG8_MMA(ai, bj, At, Bt) do { __builtin_amdgcn_s_setprio(1); _Pragma("unroll") for (int m = 0; m < 4; ++m) _Pragma("unroll") for (int n = 0; n < 2; ++n) _Pragma("unroll") for (int k = 0; k < 2; ++k) \
        acc[ai][bj][m][n] = __builtin_amdgcn_mfma_f32_16x16x32_bf16(Bt[n][k], At[m][k], acc[ai][bj][m][n], 0, 0, 0); __builtin_amdgcn_s_setprio(0); } while (0)
#define PG8_WAIT_V(n) asm volatile("s_waitcnt vmcnt(" #n ")" ::: "memory")
#define PG8_WAIT_L(n) asm volatile("s_waitcnt lgkmcnt(" #n ")" ::: "memory")
#define PG8_BAR __builtin_amdgcn_s_barrier()
#define PG8_SCHED __builtin_amdgcn_sched_barrier(0)
    Unit cur, nxt; int ui = 0;
    if (!S.next(0, cur)) return;
    f32x4 acc[2][2][4][2];
#pragma unroll
    for (int a = 0; a < 2; ++a)
#pragma unroll
        for (int b = 0; b < 2; ++b)
#pragma unroll
            for (int m = 0; m < 4; ++m)
#pragma unroll
                for (int n = 0; n < 2; ++n) acc[a][b][m][n] = (f32x4){0.f, 0.f, 0.f, 0.f};
    bf16x8 At[4][2], B0[2][2], B1[2][2];
    const char* cA = (const char*)g.A + (size_t)cur.pm * tstep; const char* cB = (const char*)g.Bt + (size_t)cur.pn * tstep;
    S.a_ready(cur);
    if constexpr (SP2) {
        PG8_STAGE(PG8_SB(0, 0), cB, voffB); PG8_STAGE(PG8_SB(0, 1), cB + hstep, voffB); PG8_STAGE(PG8_SA(0, 0), cA, voffA); PG8_STAGE(PG8_SA(0, 1), cA + hstep, voffA);
        if (wr == 1) PG8_BAR;
        PG8_WAIT_V(2); PG8_BAR;
        PG8_STAGE(PG8_SB(1, 0), cB + kstep, voffB); PG8_STAGE(PG8_SA(1, 0), cA + kstep, voffA); PG8_STAGE(PG8_SB(1, 1), cB + hstep + kstep, voffB);
        PG8_WAIT_V(6); PG8_BAR;
    } else {
        PG8_STAGE(PG8_SB(0, 0), cB, voffB); PG8_STAGE(PG8_SA(0, 0), cA, voffA); PG8_STAGE(PG8_SB(0, 1), cB + hstep, voffB); PG8_STAGE(PG8_SA(0, 1), cA + hstep, voffA);
        if (wr == 1) PG8_BAR;
        PG8_WAIT_V(4); PG8_BAR;
        PG8_STAGE(PG8_SB(1, 0), cB + kstep, voffB); PG8_STAGE(PG8_SA(1, 0), cA + kstep, voffA); PG8_STAGE(PG8_SB(1, 1), cB + hstep + kstep, voffB);
        PG8_WAIT_V(6); PG8_BAR;
    }
    for (;;) {
        const bool has_next = S.next(ui + 1, nxt);
        const char* nA = has_next ? (const char*)g.A + (size_t)nxt.pm * tstep : cA; const char* nB = has_next ? (const char*)g.Bt + (size_t)nxt.pn * tstep : cB;
        for (int t = 0; t < nt; t += 2) {
            const bool last = (t == nt - 2);
            const char* a1 = cA + (size_t)(t + 1) * kstep;
            const char* a2 = last ? nA : cA + (size_t)(t + 2) * kstep; const char* b2 = last ? nB : cB + (size_t)(t + 2) * kstep;
            const char* a3 = a2 + kstep; const char* b3 = b2 + kstep;
            if (last && has_next) S.a_ready(nxt);
            if constexpr (SP2) {
            PG8_LDB(B0, 0, 0); PG8_LDB(B1, 0, 1); PG8_SCHED; PG8_LDA(At, 0, 0); PG8_STAGE(PG8_SA(1, 1), a1 + hstep, voffA);
            PG8_WAIT_V(8); PG8_WAIT_L(0); PG8_BAR; PG8_MMA(0, 0, At, B0); PG8_MMA(0, 1, At, B1); PG8_BAR; PG8_SCHED;
            PG8_LDA(At, 0, 1); PG8_STAGE(PG8_SB(0, 0), b2, voffB); PG8_STAGE(PG8_SB(0, 1), b2 + hstep, voffB); PG8_STAGE(PG8_SA(0, 0), a2, voffA);
            PG8_WAIT_V(8); PG8_WAIT_L(0); PG8_BAR; PG8_MMA(1, 0, At, B0); PG8_MMA(1, 1, At, B1); PG8_BAR; PG8_SCHED;
            PG8_LDB(B0, 1, 0); PG8_LDB(B1, 1, 1); PG8_SCHED; PG8_LDA(At, 1, 0); PG8_STAGE(PG8_SA(0, 1), a2 + hstep, voffA);
            PG8_WAIT_V(8); PG8_WAIT_L(0); PG8_BAR; PG8_MMA(0, 0, At, B0); PG8_MMA(0, 1, At, B1); PG8_BAR; PG8_SCHED;
            PG8_LDA(At, 1, 1); PG8_STAGE(PG8_SB(1, 0), b3, voffB); PG8_STAGE(PG8_SB(1, 1), b3 + hstep, voffB); PG8_STAGE(PG8_SA(1, 0), a3, voffA);
            PG8_WAIT_V(8); PG8_WAIT_L(0); PG8_BAR; PG8_MMA(1, 0, At, B0); PG8_MMA(1, 1, At, B1); PG8_BAR; PG8_SCHED;
            } else {
            PG8_LDB(B0, 0, 0); PG8_SCHED; PG8_LDA(At, 0, 0); PG8_STAGE(PG8_SA(1, 1), a1 + hstep, voffA);
            PG8_WAIT_L(8); PG8_BAR; PG8_WAIT_L(0); PG8_MMA(0, 0, At, B0); PG8_BAR; PG8_SCHED;
            PG8_LDB(B1, 0, 1); PG8_STAGE(PG8_SB(0, 0), b2, voffB);
            PG8_BAR; PG8_WAIT_L(0); PG8_MMA(0, 1, At, B1); PG8_BAR;
            PG8_LDA(At, 0, 1); PG8_STAGE(PG8_SA(0, 0), a2, voffA);
            PG8_BAR; PG8_WAIT_L(0); PG8_MMA(1, 0, At, B0); PG8_BAR; PG8_SCHED;
            PG8_STAGE(PG8_SB(0, 1), b2 + hstep, voffB);
            PG8_WAIT_V(6); PG8_BAR; PG8_MMA(1, 1, At, B1); PG8_BAR;
            PG8_LDB(B0, 1, 0); PG8_SCHED; PG8_LDA(At, 1, 0); PG8_STAGE(PG8_SA(0, 1), a2 + hstep, voffA);
            PG8_WAIT_L(8); PG8_BAR; PG8_WAIT_L(0); PG8_MMA(0, 0, At, B0); PG8_BAR; PG8_SCHED;
            PG8_LDB(B1, 1, 1); PG8_STAGE(PG8_SB(1, 0), b3, voffB);
            PG8_BAR; PG8_WAIT_L(0); PG8_MMA(0, 1, At, B1); PG8_BAR;
            PG8_LDA(At, 1, 1); PG8_STAGE(PG8_SA(1, 0), a3, voffA);
            PG8_BAR; PG8_WAIT_L(0); PG8_MMA(1, 0, At, B0); PG8_BAR; PG8_SCHED;
            PG8_STAGE(PG8_SB(1, 1), b3 + hstep, voffB);
            PG8_WAIT_V(6); PG8_BAR; PG8_MMA(1, 1, At, B1); PG8_BAR;
            }
        }
        if constexpr (ALIGN_EPI) { if (wr == 0) PG8_BAR; }
        if constexpr (!Epi::AFTER_DRAIN) { E(acc, cur, wr, wc, fr, fq); S.done(cur); }
        if (!has_next) break;
#pragma unroll
        for (int a = 0; a < 2; ++a)
#pragma unroll
            for (int b = 0; b < 2; ++b)
#pragma unroll
                for (int m = 0; m < 4; ++m)
#pragma unroll
                    for (int n = 0; n < 2; ++n) acc[a][b][m][n] = (f32x4){0.f, 0.f, 0.f, 0.f};
        cur = nxt; cA = nA; cB = nB; ++ui;
        if constexpr (ALIGN_EPI) { if (wr == 1) PG8_BAR; }
    }
    PG8_WAIT_V(0);
    if constexpr (!ALIGN_EPI) { if (wr == 0) PG8_BAR; }
    PG8_BAR;
#undef PG8_SA
#undef PG8_SB
#undef PG8_STAGE
#undef PG8_LDA
#undef PG8_LDB
#undef PG8_MMA
#undef PG8_WAIT_V
#undef PG8_WAIT_L
#undef PG8_BAR
#undef PG8_SCHED
}
}

struct EpiIn {
    static constexpr bool PERM = true, AFTER_DRAIN = false;
    bf16_t* proj; float* aux; float* out;
    __device__ __forceinline__ void operator()(const f32x4 (&acc)[2][2][4][2], const pg8::Unit& u, int wr, int wc, int fr, int fq) const {
        const int row0 = u.pm * 256 + wr * 64 + fr, colb = u.pn * 256 + wc * 32 + 8 * fq, pn = u.pn;
#pragma unroll
        for (int ai = 0; ai < 2; ++ai)
#pragma unroll
            for (int m = 0; m < 4; ++m) {
                const int row = row0 + ai * 128 + m * 16;
#pragma unroll
                for (int bj = 0; bj < 2; ++bj) {
                    const int col = colb + bj * 128;
                    const f32x4 v0 = acc[ai][bj][m][0], v1 = acc[ai][bj][m][1];
                    u32x4 w; w.x = pg8::cvt_pk_bf16(v0[0], v0[1]); w.y = pg8::cvt_pk_bf16(v0[2], v0[3]); w.z = pg8::cvt_pk_bf16(v1[0], v1[1]); w.w = pg8::cvt_pk_bf16(v1[2], v1[3]);
                    *(u32x4*)(proj + (size_t)row * NP + col) = w;
                    float* dst = nullptr;
                    if (pn == 2) {
                        const int c = col - C_K; const int isv = c >= 128; const int cc = c & 127;
                        if (row < MPROMPT) dst = out + (isv ? O_VP : O_KP) + (size_t)row * 128 + cc;
                        else if (row < MVALID) dst = out + (isv ? O_VS : O_KS) + (size_t)(row - MPROMPT) * 128 + cc;
                    } else if (pn == 9) {
                        const int c = col - C_KI;
                        if (c < 64) {
                            if (row < MPROMPT) dst = out + O_KIP + (size_t)row * 64 + c;
                            else if (row < MVALID) dst = out + O_KIS + (size_t)(row - MPROMPT) * 64 + c;
                        } else if (c < 88) dst = aux + (size_t)row * AUXP + (c - 64);
                    } else if (pn >= 10 && pn <= 15) {
                        const int c = col - C_QKV;
                        if (row < MPROMPT) { const int t = row & (SEQ - 1); if (t >= SEQ - 3) dst = out + O_CP + ((size_t)(row >> 11) * 3 + (t - (SEQ - 3))) * 1536 + c; }
                        else if (row < MVALID) dst = out + O_CS + ((size_t)(row - MPROMPT) * 3 + 2) * 1536 + c;
                    }
                    if (dst) { __builtin_nontemporal_store(v0, (f32x4*)dst); __builtin_nontemporal_store(v1, (f32x4*)(dst + 4)); }
                }
            }
    }
};
struct EpiOut {
    static constexpr bool PERM = true, AFTER_DRAIN = false;
    bf16_t* mo;
    __device__ __forceinline__ void operator()(const f32x4 (&acc)[2][2][4][2], const pg8::Unit& u, int wr, int wc, int fr, int fq) const {
        const int row0 = u.pm * 256 + wr * 64 + fr, colb = u.pn * 256 + wc * 32 + 8 * fq;
#pragma unroll
        for (int ai = 0; ai < 2; ++ai)
#pragma unroll
            for (int m = 0; m < 4; ++m) {
                const int row = row0 + ai * 128 + m * 16;
#pragma unroll
                for (int bj = 0; bj < 2; ++bj) {
                    const f32x4 v0 = acc[ai][bj][m][0], v1 = acc[ai][bj][m][1];
                    u32x4 w; w.x = pg8::cvt_pk_bf16(v0[0], v0[1]); w.y = pg8::cvt_pk_bf16(v0[2], v0[3]); w.z = pg8::cvt_pk_bf16(v1[0], v1[1]); w.w = pg8::cvt_pk_bf16(v1[2], v1[3]);
                    *(u32x4*)(mo + (size_t)row * D_MODEL + colb + bj * 128) = w;
                }
            }
    }
};

struct Params {
    const float* x_prompt; const float* x_sample; const float* cache_k; const float* cache_v; const float* cache_kidx; const float* state_ssm; const float* state_conv;
    const int* page_table; const float* norm_in; const float* w_in; const float* conv_w; const float* a_log; const float* dt_bias; const float* gdn_norm; const float* w_out;
    const float* rel_table; const float* norm_final; float* out; unsigned char* ws;
};

constexpr int NWAVES = 8, NTHR = 512;
constexpr int SCR_BYTES = 145408;
constexpr int MISC_OFF = SCR_BYTES + 320;
constexpr int LDS_BYTES = 147456;
constexpr int CW_BAR = 4096;
typedef GAS unsigned gu32;
#define RLX_AGENT __ATOMIC_RELAXED, __HIP_MEMORY_SCOPE_AGENT
#define LDS_WAIT() asm volatile("s_waitcnt lgkmcnt(0)" ::: "memory")

#define XB_TMO      128
#define XB_XCNT(j)  (256  + 64 * (j))
#define XB_XSUB(j)  (1280 + 64 * (j))
#define XB_XGEN(j)  (2304 + 64 * (j))
#define XB_TOP      3328
#define XB_TOPGEN   3392
#define XCD_BAR_WORDS 3456
#define XB_SPIN_CAP (1u << 22)
__device__ __forceinline__ unsigned xb_ld(unsigned* p)              { return __hip_atomic_load(p, __ATOMIC_RELAXED, __HIP_MEMORY_SCOPE_AGENT); }
__device__ __forceinline__ unsigned xb_add(unsigned* p, unsigned v) { return __hip_atomic_fetch_add(p, v, __ATOMIC_RELAXED, __HIP_MEMORY_SCOPE_AGENT); }
__device__ __forceinline__ unsigned xb_xcc_id() { return (unsigned)__builtin_amdgcn_s_getreg((3 << 11) | 20) & 0xFu; }
#define XB_SPIN(cond, bar) do { unsigned _sp = 0; while (cond) { __builtin_amdgcn_s_sleep(1); \
    if ((++_sp & 255u) == 0u) { if (xb_ld(&(bar)[XB_TMO])) break; if (_sp > XB_SPIN_CAP) { atomicAdd(&(bar)[XB_TMO], 1u); break; } } } } while (0)
struct XcdBarrier { unsigned* bar; unsigned x; volatile LAS unsigned* st; };
__device__ __forceinline__ XcdBarrier xcd_barrier_post(unsigned* bar, volatile LAS unsigned* st) {
    XcdBarrier b; b.bar = bar; b.x = xb_xcc_id(); b.st = st;
    if (threadIdx.x == 0) (void)xb_add(&bar[XB_XCNT(b.x)], 1u);
    return b;
}
__device__ __forceinline__ void xcd_barrier_complete(unsigned* bar, unsigned x, unsigned& nloc, unsigned& nx) {
    const unsigned G = gridDim.x * gridDim.y * gridDim.z;
    unsigned sum, cnt, mine, sp = 0u;
    for (;;) {
        sum = 0u; cnt = 0u; mine = 0u;
#pragma unroll
        for (unsigned j = 0; j < 16; ++j) { const unsigned c = xb_ld(&bar[XB_XCNT(j)]); sum += c; cnt += (c > 0u) ? 1u : 0u; mine = (j == x) ? c : mine; }
        if (sum == G) break;
        __builtin_amdgcn_s_sleep(1);
        if ((++sp & 255u) == 0u) { if (xb_ld(&bar[XB_TMO])) break; if (sp > XB_SPIN_CAP) { atomicAdd(&bar[XB_TMO], 1u); break; } }
    }
    nloc = mine > 0u ? mine : 1u; nx = cnt > 0u ? cnt : 1u;
}
__device__ __forceinline__ void xcd_barrier(const XcdBarrier& b) {
    asm volatile("s_waitcnt vmcnt(0)" ::: "memory");
    __syncthreads();
    if (threadIdx.x == 0) {
        unsigned* bar = b.bar;
        __builtin_amdgcn_s_waitcnt(0);
        unsigned nloc = b.st[0], nx = b.st[1];
        if (nloc == 0u) { xcd_barrier_complete(bar, b.x, nloc, nx); b.st[0] = nloc; b.st[1] = nx; }
        const unsigned old = xb_add(&bar[XB_XSUB(b.x)], 1u);
        const unsigned gen = old / nloc;
        if (old + 1u == (gen + 1u) * nloc) {
            __builtin_amdgcn_fence(__ATOMIC_RELEASE, "agent");
            asm volatile("s_waitcnt vmcnt(0)" ::: "memory");
            const unsigned og = xb_add(&bar[XB_TOP], 1u);
            const unsigned tg = og / nx;
            if (og + 1u == (tg + 1u) * nx) xb_add(&bar[XB_TOPGEN], 1u);
            else XB_SPIN(xb_ld(&bar[XB_TOPGEN]) == tg, bar);
            __builtin_amdgcn_fence(__ATOMIC_ACQUIRE, "agent");
            xb_add(&bar[XB_XGEN(b.x)], 1u);
            asm volatile("s_waitcnt vmcnt(0)" ::: "memory");
        } else {
            XB_SPIN(xb_ld(&bar[XB_XGEN(b.x)]) == gen, bar);
            __builtin_amdgcn_fence(__ATOMIC_ACQUIRE, "agent");
            asm volatile("s_waitcnt vmcnt(0)" ::: "memory");
        }
    }
    __syncthreads();
}

__device__ __forceinline__ int win_src_col(int n) {
    if (n < C_AG) return n;
    if (n < C_AG + 8) return n + 2048;
    if (n < C_QKV) return -1;
    return n - 176;
}
template <bool MAPPED>
__device__ __forceinline__ void transpose_item(const float* W, int K, int N, bf16_t* WT, LAS float* scr, int item, int nblk, int lane) {
    const int kb = item / nblk, nb = item % nblk, k0 = 64 * kb, n0 = 32 * nb;
    const int nd = n0 + (lane & 31); const int src = MAPPED ? win_src_col(nd) : nd;
#pragma unroll 8
    for (int i = 0; i < 32; ++i) { const int kk = 2 * i + (lane >> 5); scr[kk * 33 + (lane & 31)] = src >= 0 ? W[(size_t)(k0 + kk) * N + src] : 0.f; }
    LDS_WAIT();
    const int c = lane & 7;
#pragma unroll
    for (int j = 0; j < 4; ++j) { const int n = (lane >> 3) + 8 * j; const LAS float* s = scr + (8 * c) * 33 + n;
        u32x4 o; o.x = pk2(s[0 * 33], s[1 * 33]); o.y = pk2(s[2 * 33], s[3 * 33]); o.z = pk2(s[4 * 33], s[5 * 33]); o.w = pk2(s[6 * 33], s[7 * 33]);
        *(u32x4*)(WT + (size_t)(n0 + n) * K + k0 + 8 * c) = o; }
    LDS_WAIT();
}
__device__ __forceinline__ void ph_prologue(const Params& p, LAS unsigned char* lds) {
    const int tid = threadIdx.x, lane = tid & 63, wave = tid >> 6;
    const int gw = blockIdx.x * NWAVES + wave, NGW = gridDim.x * NWAVES;
    bf16_t* WINT = (bf16_t*)(p.ws + WS_WINT); bf16_t* WOUTT = (bf16_t*)(p.ws + WS_WOUTT); bf16_t* XN = (bf16_t*)(p.ws + WS_XN);
    LAS float* scr = (LAS float*)(lds + wave * 8448);
    constexpr int I_IN = (1024 / 64) * (NP / 32), I_OUT = (1024 / 64) * (1024 / 32);
    for (int it = gw; it < I_IN + I_OUT; it += NGW) {
        if (it < I_IN) transpose_item<true>(p.w_in, 1024, 4440, WINT, scr, it, NP / 32, lane);
        else transpose_item<false>(p.w_out, 1024, 1024, WOUTT, scr, it - I_IN, 1024 / 32, lane);
    }
    f32x4 gv[4];
#pragma unroll
    for (int j = 0; j < 4; ++j) gv[j] = ((const f32x4*)p.norm_in)[lane + 64 * j];
    for (int m0 = 4 * gw; m0 < MP; m0 += 4 * NGW) {
        if (m0 >= MVALID) {
#pragma unroll
            for (int rr = 0; rr < 4; ++rr) { unsigned long long* o8 = (unsigned long long*)(XN + (size_t)(m0 + rr) * D_MODEL) + lane;
#pragma unroll
                for (int j = 0; j < 4; ++j) o8[64 * j] = 0ull; }
            continue;
        }
        f32x4 v[4][4];
#pragma unroll
        for (int rr = 0; rr < 4; ++rr) {
            const int m = m0 + rr;
            const f32x4* xr = (const f32x4*)(m < MPROMPT ? p.x_prompt + (size_t)m * D_MODEL : p.x_sample + (size_t)(m - MPROMPT) * D_MODEL) + lane;
#pragma unroll
            for (int j = 0; j < 4; ++j) v[rr][j] = __builtin_nontemporal_load(xr + 64 * j);
        }
#pragma unroll
        for (int rr = 0; rr < 4; ++rr) {
            float ss = 0.f;
#pragma unroll
            for (int j = 0; j < 4; ++j) ss += (v[rr][j].x * v[rr][j].x + v[rr][j].y * v[rr][j].y) + (v[rr][j].z * v[rr][j].z + v[rr][j].w * v[rr][j].w);
            const float ms = wave_sum_u(ss) * (1.f / D_MODEL) + 1e-6f;
            const float rs = rsqrtf(ms);
            if (lane == 0) ((float*)(p.ws + WS_ROWSS))[m0 + rr] = ms * rs;
            unsigned long long* o8 = (unsigned long long*)(XN + (size_t)(m0 + rr) * D_MODEL) + lane;
#pragma unroll
            for (int j = 0; j < 4; ++j) { const f32x4 y = v[rr][j] * rs * gv[j]; o8[64 * j] = (unsigned long long)pk2(y.x, y.y) | ((unsigned long long)pk2(y.z, y.w) << 32); }
        }
    }
}
__device__ __forceinline__ void ph_final_norm(const Params& p) {
    const int lane = threadIdx.x & 63, gw = blockIdx.x * NWAVES + (threadIdx.x >> 6), NGW = gridDim.x * NWAVES;
    const bf16_t* mo = (const bf16_t*)(p.ws + WS_MO); const bf16_t* XN = (const bf16_t*)(p.ws + WS_XN); const float* rowsc = (const float*)(p.ws + WS_ROWSS);
    f32x4 gv[4], ig[4];
#pragma unroll
    for (int j = 0; j < 4; ++j) { gv[j] = ((const f32x4*)p.norm_final)[lane + 64 * j]; const f32x4 t = ((const f32x4*)p.norm_in)[lane + 64 * j]; ig[j] = (f32x4){1.f / t.x, 1.f / t.y, 1.f / t.z, 1.f / t.w}; }
    for (int m0 = 4 * gw; m0 < MVALID; m0 += 4 * NGW) {
        f32x4 h[4][4];
#pragma unroll
        for (int rr = 0; rr < 4; ++rr) {
            const int m = m0 + rr;
            const unsigned long long* xr = (const unsigned long long*)(XN + (size_t)m * D_MODEL) + lane;
            const unsigned long long* mr = (const unsigned long long*)(mo + (size_t)m * D_MODEL) + lane;
            const float sc = rowsc[m];
#pragma unroll
            for (int j = 0; j < 4; ++j) {
                const unsigned long long xv = __builtin_nontemporal_load(xr + 64 * j), mv = __builtin_nontemporal_load(mr + 64 * j);
                const f32x4 xf = (f32x4){bf2f((unsigned short)(xv & 0xffff)), bf2f((unsigned short)((xv >> 16) & 0xffff)), bf2f((unsigned short)((xv >> 32) & 0xffff)), bf2f((unsigned short)(xv >> 48))};
                const f32x4 mf = (f32x4){bf2f((unsigned short)(mv & 0xffff)), bf2f((unsigned short)((mv >> 16) & 0xffff)), bf2f((unsigned short)((mv >> 32) & 0xffff)), bf2f((unsigned short)(mv >> 48))};
                h[rr][j] = xf * ig[j] * sc + mf;
            }
        }
#pragma unroll
        for (int rr = 0; rr < 4; ++rr) {
            float ss = 0.f;
#pragma unroll
            for (int j = 0; j < 4; ++j) ss += (h[rr][j].x * h[rr][j].x + h[rr][j].y * h[rr][j].y) + (h[rr][j].z * h[rr][j].z + h[rr][j].w * h[rr][j].w);
            float rs = rsqrtf(wave_sum_u(ss) * (1.f / D_MODEL) + 1e-6f);
#ifdef DBG_CMP
            if (m0 + rr >= MPROMPT) { const float* da = (const float*)(p.ws + WS_DBGACC); rs *= 1.f + sqrtf(100.f * da[0] / da[1]); }
#endif
#ifdef DBG_TIME
            if (m0 + rr >= MPROMPT) { const float* da = (const float*)(p.ws + WS_DBGACC); rs *= 1.f + sqrtf(da[4] * 1e-4f); }
#endif
            f32x4* yr = (f32x4*)(p.out + (size_t)(m0 + rr) * D_MODEL) + lane;
#pragma unroll
            for (int j = 0; j < 4; ++j) __builtin_nontemporal_store(h[rr][j] * rs * gv[j], yr + 64 * j);
        }
    }
}

#ifdef DBG_CMP
__device__ __forceinline__ void nv_attn(const Params& p, LAS unsigned char* lds, bf16_t* mixed) {
    const int wave = threadIdx.x >> 6, lane = threadIdx.x & 63;
    LAS float* bd = (LAS float*)lds;
    LAS float* qs = (LAS float*)(lds + 4096 + wave * 11264);
    LAS int* lst = (LAS int*)(qs + 512);
    LAS float* pl = (LAS float*)(lst + 256);
    const bf16_t* proj = (const bf16_t*)(p.ws + WS_PROJ); const unsigned* mask = (const unsigned*)(p.ws + WS_MASK);
    for (int i = threadIdx.x; i < 1024; i += NTHR) bd[i] = p.rel_table[(int)c_bucket[i >> 3] * 8 + (i & 7)];
    for (int base = blockIdx.x * NWAVES; base < MPROMPT; base += gridDim.x * NWAVES) {
        const int r = base + wave, b = r >> 11, t = r & (SEQ - 1);
        const bf16_t* qrow = proj + (size_t)r * NP + C_Q;
        for (int i = lane; i < 512; i += 64) qs[i] = bf2f(qrow[i]) * 0.125f;
        const unsigned word = mask[(size_t)r * 64 + lane];
        const int cnt = __popc(word);
        int pos = wave_excl_scan_i(cnt, lane);
        const int nsel = wave_sum_i(cnt);
        { unsigned w = word; while (w) { const int j = __ffs(w) - 1; lst[pos++] = 32 * lane + j; w &= w - 1u; } }
        __syncthreads();
        for (int i = lane; i < nsel; i += 64) {
            const int s = lst[i]; int dn = t - s; dn = dn > 127 ? 127 : dn;
            for (int g = 0; g < 2; ++g) {
                const u32x4* krow = (const u32x4*)(proj + (size_t)(b * SEQ + s) * NP + C_K + g * 64);
                float kf[64];
#pragma unroll
                for (int c = 0; c < 8; ++c) unpack8(krow[c], kf + 8 * c);
                for (int hh = 0; hh < 4; ++hh) {
                    const int h = g * 4 + hh; float dot = 0.f;
#pragma unroll
                    for (int d = 0; d < 64; ++d) dot += qs[h * 64 + d] * kf[d];
                    pl[h * 256 + i] = dot + bd[dn * 8 + h];
                }
            }
        }
        __syncthreads();
        for (int h = 0; h < 8; ++h) {
            float m = -3.0e38f;
            for (int i = lane; i < nsel; i += 64) m = fmaxf(m, pl[h * 256 + i]);
            m = wave_max(m);
            float sum = 0.f;
            for (int i = lane; i < nsel; i += 64) { const float e = __expf(pl[h * 256 + i] - m); pl[h * 256 + i] = e; sum += e; }
            const float inv = 1.f / wave_sum(sum);
            for (int i = lane; i < nsel; i += 64) pl[h * 256 + i] *= inv;
        }
        __syncthreads();
        for (int g = 0; g < 2; ++g) {
            float acc0 = 0.f, acc1 = 0.f, acc2 = 0.f, acc3 = 0.f;
            for (int i = 0; i < nsel; ++i) {
                const int s = lst[i];
                const float v = bf2f(proj[(size_t)(b * SEQ + s) * NP + C_V + g * 64 + lane]);
                acc0 += pl[(g * 4 + 0) * 256 + i] * v; acc1 += pl[(g * 4 + 1) * 256 + i] * v; acc2 += pl[(g * 4 + 2) * 256 + i] * v; acc3 += pl[(g * 4 + 3) * 256 + i] * v;
            }
            const bf16_t* zr = proj + (size_t)r * NP + C_ZA + g * 256 + lane; bf16_t* mr = mixed + (size_t)r * D_MODEL + g * 256 + lane;
            mr[0] = (bf16_t)f2bf(acc0 * silu_f(bf2f(zr[0]))); mr[64] = (bf16_t)f2bf(acc1 * silu_f(bf2f(zr[64])));
            mr[128] = (bf16_t)f2bf(acc2 * silu_f(bf2f(zr[128]))); mr[192] = (bf16_t)f2bf(acc3 * silu_f(bf2f(zr[192])));
        }
        __syncthreads();
    }
}

#endif
template <int MODE>
__device__ __forceinline__ void nv_gdn_unit(const Params& p, LAS unsigned char* lds, int unit, bf16_t* mixed, float* So) {
    LAS float* qkv_s = (LAS float*)lds;
    LAS float* red = qkv_s + 384;
    LAS float* sc = red + 1024;
    int tid = threadIdx.x; asm volatile("" : "+v"(tid)); const int lane = tid & 63, wave = tid >> 6;
    const int b = unit >> 2, h = unit & 3;
    const int T = MODE ? 1 : SEQ; const int row0 = MODE ? MPROMPT + b : b * SEQ;
    const int e = tid & 127, sl = tid >> 7;
    const bf16_t* proj = (const bf16_t*)(p.ws + WS_PROJ); const float* aux = (const float*)(p.ws + WS_AUX);
    float S[32];
#pragma unroll
    for (int i = 0; i < 32; ++i) S[i] = MODE ? p.state_ssm[((size_t)(b * 4 + h) * 128 + sl * 32 + i) * 128 + e] : 0.f;
    const int part = tid >> 7, ci = tid & 127, c = part * 512 + h * 128 + ci;
    float w0 = 0.f, w1 = 0.f, w2 = 0.f, w3 = 0.f, x0 = 0.f, x1 = 0.f, x2 = 0.f;
    if (tid < 384) {
        w0 = p.conv_w[0 * 1536 + c]; w1 = p.conv_w[1 * 1536 + c]; w2 = p.conv_w[2 * 1536 + c]; w3 = p.conv_w[3 * 1536 + c];
        if (MODE) { x0 = p.state_conv[((size_t)b * 3 + 0) * 1536 + c]; x1 = p.state_conv[((size_t)b * 3 + 1) * 1536 + c]; x2 = p.state_conv[((size_t)b * 3 + 2) * 1536 + c]; }
    }
    const float A = __expf(p.a_log[h]), dtb = p.dt_bias[h], gn = p.gdn_norm[e];
    for (int t = 0; t < T; ++t) {
        const size_t r = (size_t)(row0 + t);
        if (tid < 384) {
            float x3;
            if (MODE) x3 = p.out[O_CS + ((size_t)b * 3 + 2) * 1536 + c];
            else x3 = bf2f(proj[r * NP + C_QKV + c]);
            const float y = x0 * w0 + x1 * w1 + x2 * w2 + x3 * w3;
            x0 = x1; x1 = x2; x2 = x3;
            qkv_s[tid] = silu_f(y);
        }
        __syncthreads();
        if (wave == 0) { const float a = qkv_s[lane], a2 = qkv_s[lane + 64]; const float s = wave_sum(a * a + a2 * a2); if (lane == 0) sc[0] = s; }
        else if (wave == 1) { const float a = qkv_s[128 + lane], a2 = qkv_s[192 + lane]; const float s = wave_sum(a * a + a2 * a2); if (lane == 0) sc[1] = s; }
        else if (wave == 2) { const float s = wave_sum(qkv_s[lane] * qkv_s[128 + lane] + qkv_s[lane + 64] * qkv_s[192 + lane]); if (lane == 0) sc[2] = s; }
        __syncthreads();
        const float qn = rsqrtf(sc[0] + 1e-6f) * 0.08838834764831845f, kn = rsqrtf(sc[1] + 1e-6f), qk = sc[2] * qn * kn;
        const float ag = aux[r * AUXP + 16 + h], bg = aux[r * AUXP + 20 + h];
        const float xg = ag + dtb;
        const float sp = xg > 20.f ? xg : log1pf(__expf(xg));
        const float dec = __expf(-A * sp), beta = 1.f / (1.f + __expf(-bg));
        float pk = 0.f, pq = 0.f;
#pragma unroll
        for (int i = 0; i < 32; ++i) { const int d = sl * 32 + i; S[i] *= dec; pk += qkv_s[128 + d] * S[i]; pq += qkv_s[d] * S[i]; }
        red[sl * 128 + e] = pk * kn; red[512 + sl * 128 + e] = pq * qn;
        __syncthreads();
        const float kv = (red[e] + red[128 + e]) + (red[256 + e] + red[384 + e]);
        const float qS = (red[512 + e] + red[640 + e]) + (red[768 + e] + red[896 + e]);
        const float delta = (qkv_s[256 + e] - kv) * beta;
        const float o = qS + qk * delta;
#pragma unroll
        for (int i = 0; i < 32; ++i) { const int d = sl * 32 + i; S[i] += qkv_s[128 + d] * kn * delta; }
        if (sl == 0) { const float s = wave_sum(o * o); if (lane == 0) sc[4 + wave] = s; }
        __syncthreads();
        if (sl == 0) {
            const float rs = rsqrtf((sc[4] + sc[5]) * (1.f / 128.f) + 1e-6f);
            const float z = bf2f(proj[r * NP + C_ZG + h * 128 + e]);
            mixed[r * D_MODEL + 512 + h * 128 + e] = (bf16_t)f2bf(o * rs * gn * silu_f(z));
        }
    }
#pragma unroll
    for (int i = 0; i < 32; ++i) So[((size_t)(b * 4 + h) * 128 + sl * 32 + i) * 128 + e] = S[i];
    __syncthreads();
}

typedef _Float16 half_t;
constexpr int SCP = 2048;
constexpr int DSA_MK_OFF = 32 * SCP * 2;
__device__ __forceinline__ bf16x8 pack8_scaled(const u32x4 raw, float sc) {
    float f[8]; unpack8(raw, f);
    u32x4 o; o.x = pk2(f[0] * sc, f[1] * sc); o.y = pk2(f[2] * sc, f[3] * sc); o.z = pk2(f[4] * sc, f[5] * sc); o.w = pk2(f[6] * sc, f[7] * sc);
    return __builtin_bit_cast(bf16x8, o);
}
constexpr int DSA_KV_OFF = 81920;
struct IdxPre { u32x4 raw[4][2]; float aw[4]; };
__device__ __forceinline__ void dsa_idx_pre_load(const Params& p, int b, int qb, IdxPre& a) {
    int tid = threadIdx.x; asm volatile("" : "+v"(tid)); const int lane = tid & 63, wave = __builtin_amdgcn_readfirstlane(tid >> 6);
    const int qh = wave & 1, kr = wave >> 1, q = lane & 15, g = lane >> 4;
    const bf16_t* proj = (const bf16_t*)(p.ws + WS_PROJ); const float* aux = (const float*)(p.ws + WS_AUX);
    const size_t qrow = (size_t)(b * SEQ + qb * 32 + 16 * qh + q);
#pragma unroll
    for (int hh = 0; hh < 4; ++hh) {
        const int h = 4 * kr + hh;
        a.aw[hh] = aux[qrow * AUXP + h];
#pragma unroll
        for (int s = 0; s < 2; ++s) a.raw[hh][s] = *(const u32x4*)(proj + qrow * NP + C_QI + h * 64 + 32 * s + 8 * g);
    }
}
__device__ __forceinline__ void dsa_idx_pre_store(LAS unsigned char* lds, const IdxPre& a) {
    int tid = threadIdx.x; asm volatile("" : "+v"(tid)); const int lane = tid & 63, wave = __builtin_amdgcn_readfirstlane(tid >> 6);
    const int qh = wave & 1, kr = wave >> 1;
    LAS unsigned char* QS = lds;
    LAS u32x4* QP = (LAS u32x4*)(lds + 65536);
    float ql[2][8];
#pragma unroll
    for (int s = 0; s < 2; ++s)
#pragma unroll
        for (int j = 0; j < 8; ++j) ql[s][j] = 0.f;
#pragma unroll
    for (int hh = 0; hh < 4; ++hh) {
        const int h = 4 * kr + hh;
        const float aw = a.aw[hh] * (1.f / 64.f);
#pragma unroll
        for (int s = 0; s < 2; ++s) {
            float f[8]; unpack8(a.raw[hh][s], f);
#pragma unroll
            for (int j = 0; j < 8; ++j) { f[j] *= aw; ql[s][j] += f[j]; }
            u32x4 o; o.x = pk2(f[0], f[1]); o.y = pk2(f[2], f[3]); o.z = pk2(f[4], f[5]); o.w = pk2(f[6], f[7]);
            *(LAS u32x4*)(QS + ((((qh * 16 + h) * 2 + s) * 64 + lane) * 16)) = o;
        }
    }
#pragma unroll
    for (int s = 0; s < 2; ++s) { u32x4 o; o.x = pk2(ql[s][0], ql[s][1]); o.y = pk2(ql[s][2], ql[s][3]); o.z = pk2(ql[s][4], ql[s][5]); o.w = pk2(ql[s][6], ql[s][7]); QP[((qh * 4 + kr) * 2 + s) * 64 + lane] = o; }
}
__device__ __forceinline__ void dsa_idx_unit(const Params& p, LAS unsigned char* lds, int b, int qb, bool prebuilt) {
    int tid = threadIdx.x; asm volatile("" : "+v"(tid)); const int lane = tid & 63, wave = __builtin_amdgcn_readfirstlane(tid >> 6);
    const int t0 = qb * 32, qh = wave & 1, kr = wave >> 1, q = lane & 15, g = lane >> 4;
    LAS unsigned short* SC = (LAS unsigned short*)lds;
    LAS unsigned* MK = (LAS unsigned*)(lds + DSA_MK_OFF);
    const bf16_t* proj = (const bf16_t*)(p.ws + WS_PROJ); const float* aux = (const float*)(p.ws + WS_AUX); unsigned* mask = (unsigned*)(p.ws + WS_MASK);
    if (qb >= 8) {
        const size_t qrow = (size_t)(b * SEQ + t0 + 16 * qh + q);
        bf16x8 Qf[16][2], QL[2]; float sgf[16];
        {
            const LAS unsigned char* QS = lds; const LAS u32x4* QP = (const LAS u32x4*)(lds + 65536);
            if (!prebuilt) { IdxPre ip; dsa_idx_pre_load(p, b, qb, ip); dsa_idx_pre_store(lds, ip); }
            __syncthreads();
#pragma unroll
            for (int h = 0; h < 16; ++h) {
                sgf[h] = aux[qrow * AUXP + h] < 0.f ? -1.f : 1.f;
#pragma unroll
                for (int s = 0; s < 2; ++s) Qf[h][s] = *(const LAS bf16x8*)(QS + ((((qh * 16 + h) * 2 + s) * 64 + lane) * 16));
            }
#pragma unroll
            for (int s = 0; s < 2; ++s) {
                float t[8], f[8];
                unpack8(QP[((qh * 4 + 0) * 2 + s) * 64 + lane], t);
#pragma unroll
                for (int k2 = 1; k2 < 4; ++k2) { unpack8(QP[((qh * 4 + k2) * 2 + s) * 64 + lane], f);
#pragma unroll
                    for (int j = 0; j < 8; ++j) t[j] += f[j]; }
                u32x4 o; o.x = pk2(t[0], t[1]); o.y = pk2(t[2], t[3]); o.z = pk2(t[4], t[5]); o.w = pk2(t[6], t[7]); QL[s] = __builtin_bit_cast(bf16x8, o);
            }
            __syncthreads();
        }
        const int nkt = 2 * qb + 1 + qh;
        const bf16_t* kbase = proj + (size_t)(b * SEQ + q) * NP + C_KI + 8 * g;
        bf16x8 A0 = {}, A1 = {}, B0 = {}, B1 = {}, C0 = {}, C1 = {};
        { const bf16_t* kp = kbase + (size_t)(16 * kr) * NP;
          A0 = *(const bf16x8*)kp; A1 = *(const bf16x8*)(kp + 32);
          B0 = *(const bf16x8*)(kp + (size_t)64 * NP); B1 = *(const bf16x8*)(kp + (size_t)64 * NP + 32); }
        auto tile = [&](const bf16x8& U0, const bf16x8& U1, bf16x8& L0, bf16x8& L1, const int kt) __attribute__((always_inline)) {
            { const int kl = kt + 8 < nkt ? kt + 8 : nkt - 1;
              const bf16_t* kp = kbase + (size_t)(16 * kl) * NP; L0 = *(const bf16x8*)kp; L1 = *(const bf16x8*)(kp + 32); }
            f32x4 acA[4], acB[4];
            float s0 = 0.f, s1 = 0.f, s2 = 0.f, s3 = 0.f;
#define IDX_SB __builtin_amdgcn_sched_barrier(0)
#define IDX_M(AC, G, J) do { if ((((J)) & 1) == 0) { const f32x4 z_ = {0.f, 0.f, 0.f, 0.f}; AC[(J) >> 1] = __builtin_amdgcn_mfma_f32_16x16x32_bf16(U0, Qf[4 * (G) + ((J) >> 1)][0], z_, 0, 0, 0); } \
                             else AC[(J) >> 1] = __builtin_amdgcn_mfma_f32_16x16x32_bf16(U1, Qf[4 * (G) + ((J) >> 1)][1], AC[(J) >> 1], 0, 0, 0); IDX_SB; } while (0)
#define IDX_F(AC, G, J) do { if ((((J)) & 1) == 0) asm volatile("v_fma_f32 %0, |%2|, %4, %0\n\tv_fma_f32 %1, |%3|, %4, %1" : "+v"(s0), "+v"(s1) : "v"(AC[(J) >> 1][0]), "v"(AC[(J) >> 1][1]), "v"(sgf[4 * (G) + ((J) >> 1)])); \
                             else asm volatile("v_fma_f32 %0, |%2|, %4, %0\n\tv_fma_f32 %1, |%3|, %4, %1" : "+v"(s2), "+v"(s3) : "v"(AC[(J) >> 1][2]), "v"(AC[(J) >> 1][3]), "v"(sgf[4 * (G) + ((J) >> 1)])); IDX_SB; } while (0)
            IDX_SB;
#pragma unroll
            for (int j = 0; j < 8; ++j) IDX_M(acA, 0, j);
#pragma unroll
            for (int j = 0; j < 8; ++j) { IDX_M(acB, 1, j); IDX_F(acA, 0, j); }
#pragma unroll
            for (int j = 0; j < 8; ++j) { IDX_M(acA, 2, j); IDX_F(acB, 1, j); }
#pragma unroll
            for (int j = 0; j < 8; ++j) { IDX_M(acB, 3, j); IDX_F(acA, 2, j); }
            f32x4 lin = {0.f, 0.f, 0.f, 0.f};
            lin = __builtin_amdgcn_mfma_f32_16x16x32_bf16(U0, QL[0], lin, 0, 0, 0); IDX_SB;
            lin = __builtin_amdgcn_mfma_f32_16x16x32_bf16(U1, QL[1], lin, 0, 0, 0); IDX_SB;
            asm volatile("s_nop 7"); IDX_SB;
#pragma unroll
            for (int j = 0; j < 8; ++j) IDX_F(acB, 3, j);
#undef IDX_M
#undef IDX_F
#undef IDX_SB
            const f32x2 sc01 = {lin[0] + s0, lin[1] + s1}, sc23 = {lin[2] + s2, lin[3] + s3};
            unsigned short hv[4] = {__builtin_bit_cast(unsigned short, (half_t)sc01[0]), __builtin_bit_cast(unsigned short, (half_t)sc01[1]), __builtin_bit_cast(unsigned short, (half_t)sc23[0]), __builtin_bit_cast(unsigned short, (half_t)sc23[1])};
            if (kt == 2 * qb + qh) {
#pragma unroll
                for (int e = 0; e < 4; ++e) hv[e] = (4 * g + e > q) ? (unsigned short)0xFC00u : hv[e];
            }
            const unsigned lo = (unsigned)hv[0] | ((unsigned)hv[1] << 16), hi = (unsigned)hv[2] | ((unsigned)hv[3] << 16);
            *(LAS unsigned long long*)(SC + (16 * qh + q) * SCP + 16 * kt + 4 * g) = (unsigned long long)lo | ((unsigned long long)hi << 32);
        };
        if (wave >= 4) __builtin_amdgcn_s_sleep(7);
        for (int kt = kr;;) {
            tile(A0, A1, C0, C1, kt); kt += 4; if (kt >= nkt) break;
            tile(B0, B1, A0, A1, kt); kt += 4; if (kt >= nkt) break;
            tile(C0, C1, B0, B1, kt); kt += 4; if (kt >= nkt) break;
        }
        if (qh == 0 && kr == ((2 * qb + 1) & 3)) *(LAS unsigned long long*)(SC + q * SCP + 16 * (2 * qb + 1) + 4 * g) = 0xFC00FC00FC00FC00ull;
    }
    __syncthreads();
}
__device__ __forceinline__ void dsa_select_unit(const Params& p, LAS unsigned char* lds, int b, int qb) {
    int tid = threadIdx.x; asm volatile("" : "+v"(tid)); const int lane = tid & 63, wave = __builtin_amdgcn_readfirstlane(tid >> 6);
    const int t0 = qb * 32;
    LAS unsigned short* SC = (LAS unsigned short*)lds;
    LAS unsigned* MK = (LAS unsigned*)(lds + DSA_MK_OFF);
    unsigned* mask = (unsigned*)(p.ws + WS_MASK); (void)mask; (void)b;
    if (t0 < 256) {
#pragma unroll
        for (int qi = 0; qi < 4; ++qi) {
            const int ql = wave * 4 + qi, nv = t0 + ql + 1 - 32 * lane;
            MK[ql * 65 + lane] = nv >= 32 ? 0xffffffffu : (nv <= 0 ? 0u : ((1u << nv) - 1u));
#ifdef DBG_CMP
            mask[(size_t)(b * SEQ + t0 + ql) * 64 + lane] = MK[ql * 65 + lane];
#endif
        }
    } else {
        const bool lv = lane <= qb;
        auto load_planes = [&](const int ql, unsigned (&kp)[16]) __attribute__((always_inline)) {
            const LAS u32x4* src = (const LAS u32x4*)(SC + ql * SCP + 32 * lane);
#pragma unroll
            for (int c = 0; c < 4; ++c) {
                const u32x4 v = src[c];
#pragma unroll
                for (int e = 0; e < 4; ++e) {
                    unsigned x = v[e];
                    const unsigned neg = ((x >> 15) & 0x00010001u) * 0xFFFFu;
                    x ^= (neg | 0x80008000u);
                    kp[4 * c + e] = lv ? x : 0u;
                }
            }
#define SEL_TSTEP(J, M) _Pragma("unroll") for (int k = 0; k < 16; ++k) if (!(k & (J))) { const unsigned t = ((kp[k] >> (J)) ^ kp[k + (J)]) & (M); kp[k + (J)] ^= t; kp[k] ^= t << (J); }
            SEL_TSTEP(8, 0x00FF00FFu) SEL_TSTEP(4, 0x0F0F0F0Fu) SEL_TSTEP(2, 0x33333333u) SEL_TSTEP(1, 0x55555555u)
#undef SEL_TSTEP
        };
        auto shuf = [](unsigned x) -> unsigned {
            unsigned t = (x ^ (x >> 8)) & 0x0000FF00u; x = x ^ t ^ (t << 8);
            t = (x ^ (x >> 4)) & 0x00F000F0u; x = x ^ t ^ (t << 4);
            t = (x ^ (x >> 2)) & 0x0C0C0C0Cu; x = x ^ t ^ (t << 2);
            t = (x ^ (x >> 1)) & 0x22222222u; x = x ^ t ^ (t << 1);
            return x;
        };
#pragma unroll 1
        for (int pp = 0; pp < 2; ++pp) {
            const int ql0 = wave * 4 + 2 * pp, ql1 = ql0 + 1;
            unsigned kp0[16], kp1[16];
            load_planes(ql0, kp0); load_planes(ql1, kp1);
            unsigned alive0 = 0xFFFFFFFFu, gt0 = 0u, alive1 = 0xFFFFFFFFu, gt1 = 0u; int cnt0 = 0, cnt1 = 0;
#pragma unroll
            for (int bit = 15; bit >= 0; --bit) {
                const unsigned x0 = alive0 & kp0[bit], x1 = alive1 & kp1[bit];
                const int tot = __builtin_amdgcn_readlane(wave_incl_scan_dpp((int)((unsigned)__popc(x0) | ((unsigned)__popc(x1) << 16))), 63);
                const int tot0 = tot & 0xffff, tot1 = (int)((unsigned)tot >> 16);
                const bool one0 = cnt0 + tot0 >= 256, one1 = cnt1 + tot1 >= 256;
                const unsigned nsel0 = one0 ? 0u : 0xFFFFFFFFu, nsel1 = one1 ? 0u : 0xFFFFFFFFu;
                gt0 |= x0 & nsel0; gt1 |= x1 & nsel1;
                alive0 &= kp0[bit] ^ nsel0; alive1 &= kp1[bit] ^ nsel1;
                cnt0 += one0 ? 0 : tot0; cnt1 += one1 ? 0 : tot1;
            }
            const unsigned wgt0 = shuf(gt0), wgt1 = shuf(gt1);
            unsigned weq0 = shuf(alive0), weq1 = shuf(alive1);
            const int ceq0 = __popc(weq0), ceq1 = __popc(weq1);
            const unsigned sc2 = (unsigned)wave_incl_scan_dpp((int)((unsigned)ceq0 | ((unsigned)ceq1 << 16)));
            int take0 = (256 - cnt0) - ((int)(sc2 & 0xffffu) - ceq0), take1 = (256 - cnt1) - ((int)(sc2 >> 16) - ceq1);
            unsigned word0 = wgt0, word1 = wgt1;
            if (take0 >= ceq0) word0 |= weq0;
            else { while (take0 > 0) { const unsigned bl = weq0 & (0u - weq0); word0 |= bl; weq0 ^= bl; --take0; } }
            if (take1 >= ceq1) word1 |= weq1;
            else { while (take1 > 0) { const unsigned bl = weq1 & (0u - weq1); word1 |= bl; weq1 ^= bl; --take1; } }
            MK[ql0 * 65 + lane] = word0; MK[ql1 * 65 + lane] = word1;
#ifdef DBG_CMP
            mask[(size_t)(b * SEQ + t0 + ql0) * 64 + lane] = word0; mask[(size_t)(b * SEQ + t0 + ql1) * 64 + lane] = word1;
#endif
        }
    }
    __syncthreads();
}
typedef float f32x16 __attribute__((ext_vector_type(16)));
typedef short s16x4 __attribute__((ext_vector_type(4)));
constexpr int KVP = 272, KVT = 32 * KVP;
constexpr int DSA_BD_OFF = DSA_MK_OFF + 32 * 65 * 4;
static_assert(DSA_BD_OFF + 8 * 128 * 4 <= SCR_BYTES, "LDS map");
__device__ __forceinline__ float max3f(float a, float b, float c) { float r; asm("v_max3_f32 %0, %1, %2, %3" : "=v"(r) : "v"(a), "v"(b), "v"(c)); return r; }
template <int POS> __device__ __forceinline__ float mask_bit(float v, int w) {
    int m; asm("v_bfe_i32 %0, %1, %2, 1" : "=v"(m) : "v"(w), "n"(POS)); return __builtin_bit_cast(float, __builtin_bit_cast(int, v) & m);
}
__device__ __forceinline__ void swap32(float& a, float& b) { asm volatile("s_nop 1\n\tv_permlane32_swap_b32 %0, %1\n\ts_nop 1" : "+v"(a), "+v"(b)); }
__device__ __forceinline__ s16x4 tr16(const LAS unsigned char* p) { return __builtin_bit_cast(s16x4, __builtin_amdgcn_ds_read_tr16_b64_v4i16((LAS s16x4*)p)); }
__device__ __forceinline__ void dsa_fill_bias(const Params& p, LAS unsigned char* lds) {
    LAS float* BD = (LAS float*)(lds + DSA_BD_OFF);
    for (int i = threadIdx.x; i < 1024; i += NTHR) { const int h = i >> 7, n = i & 127; BD[i] = p.rel_table[(int)c_bucket[n] * 8 + h] * 1.4426950408889634f; }
    __syncthreads();
}
struct AttnPre { bf16x8 Qf[4]; u32x4 t0v, t1v, sa0, sa1, sb0, sb1; };
__device__ __forceinline__ void dsa_attn_pre(const Params& p, int b, int qb, AttnPre& a) {
    int tid = threadIdx.x; asm volatile("" : "+v"(tid)); const int lane = tid & 63, wave = __builtin_amdgcn_readfirstlane(tid >> 6);
    const int r = lane & 31, hh = lane >> 5, t0 = qb * 32, nkt = qb + 1;
    const bf16_t* proj = (const bf16_t*)(p.ws + WS_PROJ);
    const size_t qrow = (size_t)(b * SEQ + t0 + r);
#pragma unroll
    for (int s = 0; s < 4; ++s) a.Qf[s] = *(const bf16x8*)(proj + qrow * NP + C_Q + wave * 64 + 16 * s + 8 * hh);
    const int skey = tid >> 4, sch = tid & 15;
    const bf16_t* sbase = proj + (size_t)(b * SEQ + skey) * NP + C_K + 16 * sch;
    a.t0v = *(const u32x4*)sbase; a.t1v = *(const u32x4*)(sbase + 8);
    { const bf16_t* sp = sbase + (size_t)(32 * (1 < nkt ? 1 : nkt - 1)) * NP; a.sa0 = *(const u32x4*)sp; a.sa1 = *(const u32x4*)(sp + 8); }
    { const bf16_t* sp = sbase + (size_t)(32 * (2 < nkt ? 2 : nkt - 1)) * NP; a.sb0 = *(const u32x4*)sp; a.sb1 = *(const u32x4*)(sp + 8); }
}
__device__ __forceinline__ void dsa_attn_stage(const Params& p, LAS unsigned char* lds, int b, int qb, const AttnPre& pre) {
    int tid = threadIdx.x; asm volatile("" : "+v"(tid)); const int lane = tid & 63, wave = __builtin_amdgcn_readfirstlane(tid >> 6);
    const int g = wave >> 2, r = lane & 31, hh = lane >> 5, t0 = qb * 32;
    const LAS unsigned* MK = (const LAS unsigned*)(lds + DSA_MK_OFF);
    const LAS float* BD = (const LAS float*)(lds + DSA_BD_OFF) + wave * 128;
    const bf16_t* proj = (const bf16_t*)(p.ws + WS_PROJ); bf16_t* mixed = (bf16_t*)(p.ws + WS_MIXED);
    const size_t qrow = (size_t)(b * SEQ + t0 + r);
    bf16x8 Qf[4];
#pragma unroll
    for (int s = 0; s < 4; ++s) Qf[s] = pre.Qf[s];
    f32x16 O0, O1;
#pragma unroll
    for (int i = 0; i < 16; ++i) { O0[i] = 0.f; O1[i] = 0.f; }
    float m = 0.f, l = 0.f;
    const float c31 = BD[127];
    const int nkt = qb + 1, qpos = t0 + r;
    const int skey = tid >> 4, sch = tid & 15;
    const bf16_t* sbase = proj + (size_t)(b * SEQ + skey) * NP + C_K + 16 * sch;
    const unsigned sdst = (unsigned)(skey * KVP + (sch & 7) * 32 + (sch >> 3) * KVT);
    u32x4 sa0 = pre.sa0, sa1 = pre.sa1, sb0 = pre.sb0, sb1 = pre.sb1, sc0 = {}, sc1 = {};
    LAS unsigned char* kvb = lds + DSA_KV_OFF;
    *(LAS u32x4*)(kvb + sdst) = pre.t0v; *(LAS u32x4*)(kvb + sdst + 16) = pre.t1v;
    __syncthreads();
    const int i16 = lane & 15, G1 = (lane >> 4) & 1;
    const unsigned vlane = (unsigned)((4 * hh + (i16 >> 2)) * KVP + g * 128 + (16 * G1 + 4 * (i16 & 3)) * 2);
    const unsigned klane = (unsigned)(r * KVP + g * 128 + hh * 16);
    auto tile = [&](const int kt, const u32x4& W0, const u32x4& W1, u32x4& L0, u32x4& L1) __attribute__((always_inline)) {
        const int cur = kt & 1;
        { const bf16_t* sp = sbase + (size_t)(32 * (kt + 3 < nkt ? kt + 3 : nkt - 1)) * NP; L0 = *(const u32x4*)sp; L1 = *(const u32x4*)(sp + 8); }
        const LAS unsigned char* Kb = kvb + cur * (2 * KVT); const LAS unsigned char* Vb = Kb + KVT;
        f32x16 acc;
#pragma unroll
        for (int i = 0; i < 16; ++i) acc[i] = 0.f;
#pragma unroll
        for (int s = 0; s < 4; ++s) { const bf16x8 Kf = *(const LAS bf16x8*)(Kb + klane + s * 32); acc = __builtin_amdgcn_mfma_f32_32x32x16_bf16(Kf, Qf[s], acc, 0, 0, 0); }
        const int wsh = (int)(MK[r * 65 + kt] >> (4 * hh));
        const int kb0 = 32 * kt + 4 * hh;
        float x[16];
        if (t0 - 32 * kt - 31 >= 113) {
            const float cm = c31 - m;
#pragma unroll
            for (int i = 0; i < 16; ++i) x[i] = acc[i] * 0.18033688011112042f + cm;
        } else {
#pragma unroll
            for (int i = 0; i < 16; ++i) { int d = qpos - (kb0 + (i & 3) + 8 * (i >> 2)); d = d < 0 ? 0 : (d > 127 ? 127 : d); x[i] = acc[i] * 0.18033688011112042f + (BD[d] - m); }
        }
        float tmax = max3f(max3f(max3f(x[0], x[1], x[2]), max3f(x[3], x[4], x[5]), max3f(x[6], x[7], x[8])), max3f(x[9], x[10], x[11]), max3f(max3f(x[12], x[13], x[14]), x[15], x[15]));
        { float ta = tmax, tb = tmax; swap32(ta, tb); tmax = fmaxf(ta, tb); }
        if (!__all(tmax <= 8.f)) {
            const float up = fmaxf(tmax, 0.f), alpha = __builtin_amdgcn_exp2f(-up);
#pragma unroll
            for (int i = 0; i < 16; ++i) { O0[i] *= alpha; O1[i] *= alpha; x[i] -= up; }
            l *= alpha; m += up;
        }
#define PEXP(i) x[i] = mask_bit<((i) & 3) + 8 * ((i) >> 2)>(__builtin_amdgcn_exp2f(x[i]), wsh)
        PEXP(0); PEXP(1); PEXP(2); PEXP(3); PEXP(4); PEXP(5); PEXP(6); PEXP(7); PEXP(8); PEXP(9); PEXP(10); PEXP(11); PEXP(12); PEXP(13); PEXP(14); PEXP(15);
#undef PEXP
        const float ps = ((x[0] + x[1]) + (x[2] + x[3])) + ((x[4] + x[5]) + (x[6] + x[7])) + (((x[8] + x[9]) + (x[10] + x[11])) + ((x[12] + x[13]) + (x[14] + x[15])));
        l += ps;
        u32x4 pw0, pw1;
        pw0.x = pk2(x[0], x[1]); pw0.y = pk2(x[2], x[3]); pw0.z = pk2(x[4], x[5]); pw0.w = pk2(x[6], x[7]);
        pw1.x = pk2(x[8], x[9]); pw1.y = pk2(x[10], x[11]); pw1.z = pk2(x[12], x[13]); pw1.w = pk2(x[14], x[15]);
        const bf16x8 P0 = __builtin_bit_cast(bf16x8, pw0), P1 = __builtin_bit_cast(bf16x8, pw1);
#pragma unroll
        for (int s = 0; s < 2; ++s) {
            const bf16x8 Ps = s ? P1 : P0;
#pragma unroll
            for (int c = 0; c < 2; ++c) {
                const s16x4 lo = tr16(Vb + vlane + (16 * s) * KVP + c * 64), hi = tr16(Vb + vlane + (16 * s + 8) * KVP + c * 64);
                const bf16x8 Vf = (bf16x8){lo[0], lo[1], lo[2], lo[3], hi[0], hi[1], hi[2], hi[3]};
                if (c == 0) O0 = __builtin_amdgcn_mfma_f32_32x32x16_bf16(Vf, Ps, O0, 0, 0, 0);
                else O1 = __builtin_amdgcn_mfma_f32_32x32x16_bf16(Vf, Ps, O1, 0, 0, 0);
            }
        }
        { LAS unsigned char* d = kvb + (cur ^ 1) * (2 * KVT) + sdst; *(LAS u32x4*)d = W0; *(LAS u32x4*)(d + 16) = W1; }
        __syncthreads();
    };
    for (int kt = 0;;) {
        tile(kt, sa0, sa1, sc0, sc1); if (++kt >= nkt) break;
        tile(kt, sb0, sb1, sa0, sa1); if (++kt >= nkt) break;
        tile(kt, sc0, sc1, sb0, sb1); if (++kt >= nkt) break;
    }
    { float la = l, lb = l; swap32(la, lb); l = la + lb; }
    const float inv = __builtin_amdgcn_rcpf(l);
#pragma unroll
    for (int c = 0; c < 2; ++c)
#pragma unroll
        for (int rg = 0; rg < 4; ++rg) {
            const int d0 = 32 * c + 8 * rg + 4 * hh;
            const unsigned long long zz = *(const unsigned long long*)(proj + qrow * NP + C_ZA + wave * 64 + d0);
            const float z0 = bf2f((unsigned short)(zz & 0xffff)), z1 = bf2f((unsigned short)((zz >> 16) & 0xffff)), z2 = bf2f((unsigned short)((zz >> 32) & 0xffff)), z3 = bf2f((unsigned short)(zz >> 48));
            const float o0 = (c ? O1[4 * rg] : O0[4 * rg]) * inv, o1 = (c ? O1[4 * rg + 1] : O0[4 * rg + 1]) * inv, o2 = (c ? O1[4 * rg + 2] : O0[4 * rg + 2]) * inv, o3 = (c ? O1[4 * rg + 3] : O0[4 * rg + 3]) * inv;
            const unsigned long long w = (unsigned long long)pk2(o0 * silu_f(z0), o1 * silu_f(z1)) | ((unsigned long long)pk2(o2 * silu_f(z2), o3 * silu_f(z3)) << 32);
            *(unsigned long long*)(mixed + qrow * D_MODEL + wave * 64 + d0) = w;
        }
}
__device__ __forceinline__ void dsa_unit_of(int w, int k, int& b, int& qb) {
    const int u = w + 256 * k; b = u & 31; const int a = (w >> 5) & 7; const int j = 8 * k + ((k & 1) ? 7 - a : a); qb = 63 - j;
}

constexpr int GP = 272, GP64 = 144;
constexpr int IMG_NEGW = 0, IMG_QD = 17408, IMG_KDT = 34816, IMG_AQK = 53248, IMG_BYTES = 65536;
constexpr size_t GDN_UNIT_BYTES = IMG_BYTES + 32768;
__device__ __forceinline__ int kperm(int c) { return (c & ~31) | (((c >> 2) & 3) << 3) | (((c >> 4) & 1) << 2) | (c & 3); }
constexpr int GL_QS = 0, GL_KS = 17408, GL_NEGW = 0, GL_BM = 34816, BMPF = 260, GL_KDT = 101376, GL_AQK = 119808, GL_MA = 129024, GL_ADT = 138240, GL_DD = 142336, GL_GT = 144384;
static_assert(GL_GT + 768 <= SCR_BYTES && GL_BM + 64 * BMPF * 4 == GL_KDT && GL_KDT + 18432 == GL_AQK && GL_AQK + 9216 == GL_MA && GL_MA + 9216 == GL_ADT && GL_ADT + 4096 == GL_DD && GL_DD + 2048 == GL_GT, "LDS map");
__device__ __forceinline__ bf16x8 pack_acc(const f32x4 a, const f32x4 b) {
    u32x4 w; w.x = pk2(a[0], a[1]); w.y = pk2(a[2], a[3]); w.z = pk2(b[0], b[1]); w.w = pk2(b[2], b[3]);
    return __builtin_bit_cast(bf16x8, w);
}
struct GdnPre { unsigned raw[3][11]; float ag, bg; };
__device__ __forceinline__ void gdn_local_load(const Params& p, int unit, int lane, int wave, GdnPre& q) {
    const int n = unit & 31, bh = unit >> 5, h = bh & 3, b = bh >> 2;
    const bf16_t* proj = (const bf16_t*)(p.ws + WS_PROJ); const float* aux = (const float*)(p.ws + WS_AUX);
#pragma unroll
    for (int part = 0; part < 3; ++part) {
        const int ch = part * 512 + h * 128 + 2 * lane;
#pragma unroll
        for (int i = 0; i < 11; ++i) {
            const int tt = 64 * n + 8 * wave - 3 + i;
            q.raw[part][i] = tt >= 0 ? *(const unsigned*)(proj + (size_t)(b * SEQ + tt) * NP + C_QKV + ch) : 0u;
        }
    }
    const size_t r = (size_t)(b * SEQ + 64 * n + lane);
    q.ag = aux[r * AUXP + 16 + h]; q.bg = aux[r * AUXP + 20 + h];
}
__device__ __forceinline__ void gdn_local_unit(const Params& p, LAS unsigned char* lds, int unit, int next_unit, GdnPre& pre) {
    int tid = threadIdx.x; asm volatile("" : "+v"(tid)); const int lane = tid & 63, wave = __builtin_amdgcn_readfirstlane(tid >> 6);
    const int n = unit & 31, bh = unit >> 5, h = bh & 3, b = bh >> 2;
    const GdnPre cur = pre;
    if (next_unit >= 0) gdn_local_load(p, next_unit, lane, wave, pre);
    const int row0 = b * SEQ + 64 * n;
    LAS float* GT = (LAS float*)(lds + GL_GT);
    LAS float* Bm = (LAS float*)(lds + GL_BM);
    const bf16_t* proj = (const bf16_t*)(p.ws + WS_PROJ); const float* aux = (const float*)(p.ws + WS_AUX);
    unsigned char* img = p.ws + WS_GDN + (size_t)unit * GDN_UNIT_BYTES;
    if (wave == 0) {
        const float ag = cur.ag, bg = cur.bg;
        const float xg = ag + p.dt_bias[h];
        const float sp = xg > 20.f ? xg : __logf(1.f + __expf(xg));
        const float gc = wave_incl_scan_f(-__expf(p.a_log[h]) * sp);
        GT[lane] = gc; GT[64 + lane] = __builtin_amdgcn_rcpf(1.f + __expf(-bg)); GT[128 + lane] = __expf(gc);
    }
    __syncthreads();
    {
        float f[3][8][2];
#pragma unroll
        for (int part = 0; part < 3; ++part) {
            const int ch = part * 512 + h * 128 + 2 * lane;
            float w[4][2];
#pragma unroll
            for (int j = 0; j < 4; ++j) { const f32x2 t = *(const f32x2*)(p.conv_w + j * 1536 + ch); w[j][0] = t.x; w[j][1] = t.y; }
            float x[11][2];
#pragma unroll
            for (int i = 0; i < 11; ++i) { const unsigned v = cur.raw[part][i]; x[i][0] = __builtin_bit_cast(float, v << 16); x[i][1] = __builtin_bit_cast(float, v & 0xffff0000u); }
#pragma unroll
            for (int i = 0; i < 8; ++i) {
                const float y0 = x[i][0] * w[0][0] + x[i + 1][0] * w[1][0] + x[i + 2][0] * w[2][0] + x[i + 3][0] * w[3][0];
                const float y1 = x[i][1] * w[0][1] + x[i + 1][1] * w[1][1] + x[i + 2][1] * w[2][1] + x[i + 3][1] * w[3][1];
                f[part][i][0] = silu_f(y0); f[part][i][1] = silu_f(y1);
            }
        }
        const float glast = GT[63];
#pragma unroll
        for (int i = 0; i < 8; ++i) {
            const int t = 8 * wave + i;
            const float qn = rsqrtf(wave_sum_u(f[0][i][0] * f[0][i][0] + f[0][i][1] * f[0][i][1]) + 1e-6f) * 0.08838834764831845f;
            const float kn = rsqrtf(wave_sum_u(f[1][i][0] * f[1][i][0] + f[1][i][1] * f[1][i][1]) + 1e-6f);
            const float gc = GT[t], beta = GT[64 + t], eg = GT[128 + t], egl = __expf(glast - gc);
            const float q0 = f[0][i][0] * qn, q1 = f[0][i][1] * qn, k0 = f[1][i][0] * kn, k1 = f[1][i][1] * kn;
            *(LAS unsigned*)(lds + GL_QS + t * GP + 4 * lane) = pk2(q0, q1);
            *(LAS unsigned*)(lds + GL_KS + t * GP + 4 * lane) = pk2(k0, k1);
            *(LAS f32x2*)(Bm + t * BMPF + 2 * lane) = (f32x2){f[2][i][0] * beta, f[2][i][1] * beta};
            *(LAS f32x2*)(Bm + t * BMPF + 128 + 2 * lane) = (f32x2){k0 * beta * eg, k1 * beta * eg};
            __builtin_nontemporal_store(pk2(q0 * eg, q1 * eg), (unsigned*)(img + IMG_QD + t * GP + 2 * kperm(2 * lane)));
            const int tp = kperm(t);
            const unsigned kd = pk2(k0 * egl, k1 * egl);
            *(LAS unsigned short*)(lds + GL_KDT + (2 * lane) * GP64 + 2 * tp) = (unsigned short)(kd & 0xffffu);
            *(LAS unsigned short*)(lds + GL_KDT + (2 * lane + 1) * GP64 + 2 * tp) = (unsigned short)(kd >> 16);
        }
    }
    __syncthreads();
    {
        const int c = lane & 15, g = lane >> 4;
#pragma unroll
        for (int it = 0; it < 4; ++it) {
            const int idx = wave + 8 * (it & 1), which = it >> 1, mi = idx >> 2, nj = idx & 3;
            const LAS unsigned char* Ab = lds + (which ? GL_QS : GL_KS) + (16 * mi + c) * GP + 16 * g;
            const LAS unsigned char* Bb = lds + GL_KS + (16 * nj + c) * GP + 16 * g;
            f32x4 acc = {0.f, 0.f, 0.f, 0.f};
#pragma unroll
            for (int s2 = 0; s2 < 4; ++s2) acc = __builtin_amdgcn_mfma_f32_16x16x32_bf16(*(const LAS bf16x8*)(Ab + 64 * s2), *(const LAS bf16x8*)(Bb + 64 * s2), acc, 0, 0, 0);
            const int tc = 16 * nj + c; const float gcc = GT[tc];
            f32x4 val;
#pragma unroll
            for (int e = 0; e < 4; ++e) {
                const int t = 16 * mi + 4 * g + e;
                const float dec = __expf(fminf(GT[t] - gcc, 0.f));
                if (which == 0) val[e] = (t > tc) ? GT[64 + t] * acc[e] * dec : 0.f;
                else val[e] = (t >= tc) ? acc[e] * dec : 0.f;
            }
            const int tcp = kperm(tc);
            if (which == 0) {
                if (mi == nj) *(LAS f32x4*)(lds + GL_ADT + ((mi * 16 + c) * 16 + 4 * g) * 4) = val;
#pragma unroll
                for (int e = 0; e < 4; ++e) *(LAS unsigned short*)(lds + GL_MA + (16 * mi + 4 * g + e) * GP64 + 2 * tcp) = (unsigned short)(mi == nj ? 0u : (pk2(-val[e], 0.f) & 0xffffu));
            } else {
#pragma unroll
                for (int e = 0; e < 4; ++e) *(LAS unsigned short*)(lds + GL_AQK + (16 * mi + 4 * g + e) * GP64 + 2 * tcp) = (unsigned short)(pk2(val[e], 0.f) & 0xffffu);
            }
        }
    }
    __syncthreads();
    {
        const int c = lane & 15, g = lane >> 4;
        {
            float T[16];
#pragma unroll
            for (int i = 0; i < 16; ++i) T[i] = (i == c) ? 1.f : 0.f;
            const LAS float* adt = (const LAS float*)(lds + GL_ADT) + g * 256;
#pragma unroll
            for (int j = 0; j < 15; ++j) {
                const float tj = T[j];
#pragma unroll
                for (int q4 = (j + 1) >> 2; q4 < 4; ++q4) {
                    const f32x4 a = *(const LAS f32x4*)(adt + j * 16 + 4 * q4);
                    T[4 * q4] -= a[0] * tj; T[4 * q4 + 1] -= a[1] * tj; T[4 * q4 + 2] -= a[2] * tj; T[4 * q4 + 3] -= a[3] * tj;
                }
            }
            LAS unsigned short* dd = (LAS unsigned short*)(lds + GL_DD) + wave * 0 + g * 256 + c;
#pragma unroll
            for (int i = 0; i < 16; ++i) dd[i * 16] = (unsigned short)(pk2(T[i], 0.f) & 0xffffu);
        }
        LDS_WAIT();
        const f32x4 z4 = {0.f, 0.f, 0.f, 0.f};
#pragma unroll
        for (int j2 = 0; j2 < 2; ++j2) {
            const int nb = 2 * wave + j2;
            f32x4 X[4];
#pragma unroll
            for (int r = 0; r < 4; ++r) {
                f32x4 R;
#pragma unroll
                for (int e = 0; e < 4; ++e) R[e] = Bm[(16 * r + 4 * g + e) * BMPF + 16 * nb + c];
                if (r >= 1) R = __builtin_amdgcn_mfma_f32_16x16x32_bf16(*(const LAS bf16x8*)(lds + GL_MA + (16 * r + c) * GP64 + 16 * g), pack_acc(X[0], r >= 2 ? X[1] : z4), R, 0, 0, 0);
                if (r == 3) R = __builtin_amdgcn_mfma_f32_16x16x32_bf16(*(const LAS bf16x8*)(lds + GL_MA + (16 * r + c) * GP64 + 64 + 16 * g), pack_acc(X[2], z4), R, 0, 0, 0);
                const unsigned long long dq = *(const LAS unsigned long long*)(lds + GL_DD + ((r * 16 + c) * 16 + 4 * g) * 2);
                u32x4 dw; dw.x = (unsigned)dq; dw.y = (unsigned)(dq >> 32); dw.z = 0u; dw.w = 0u;
                X[r] = __builtin_amdgcn_mfma_f32_16x16x32_bf16(__builtin_bit_cast(bf16x8, dw), pack_acc(R, z4), z4, 0, 0, 0);
                if (wave < 4) __builtin_nontemporal_store(X[r], (f32x4*)(img + IMG_BYTES) + (nb * 4 + r) * 64 + lane);
                else {
                    const int cp = kperm(16 * (nb - 8) + c);
#pragma unroll
                    for (int e = 0; e < 4; ++e) *(LAS unsigned short*)(lds + GL_NEGW + (16 * r + 4 * g + e) * GP + 2 * cp) = (unsigned short)(pk2(-X[r][e], 0.f) & 0xffffu);
                }
            }
        }
    }
    __syncthreads();
    for (int i = tid; i < (18432 + 9216 + 17408) / 16; i += NTHR) {
        if (i < 1728) { const u32x4 v = *(const LAS u32x4*)(lds + GL_KDT + 16 * i); if (i < 1152) __builtin_nontemporal_store(v, (u32x4*)(img + IMG_KDT + 16 * i)); else __builtin_nontemporal_store(v, (u32x4*)(img + IMG_AQK + 16 * (i - 1152))); }
        else __builtin_nontemporal_store(*(const LAS u32x4*)(lds + GL_NEGW + 16 * (i - 1728)), (u32x4*)(img + IMG_NEGW + 16 * (i - 1728)));
    }
    if (tid == 0) ((float*)(p.ws + WS_CD))[unit] = GT[128 + 63];
    __syncthreads();
}

constexpr int GS_PS = 2 * IMG_BYTES, GS_RS = GS_PS + 4096;
static_assert(GS_RS + 2048 <= SCR_BYTES, "LDS map");
__device__ __forceinline__ void gdn_seq_unit(const Params& p, LAS unsigned char* lds, int bh, bf16_t* mixed) {
    int tid = threadIdx.x; asm volatile("" : "+v"(tid)); const int lane = tid & 63, wave = __builtin_amdgcn_readfirstlane(tid >> 6);
    const int c = lane & 15, g = lane >> 4, h = bh & 3, b = bh >> 2, col0 = 16 * wave;
    const bf16_t* proj = (const bf16_t*)(p.ws + WS_PROJ);
    const unsigned char* ubase = p.ws + WS_GDN + (size_t)(bh * 32) * GDN_UNIT_BYTES;
    const float* cdp = (const float*)(p.ws + WS_CD) + bh * 32;
    LAS float* RS = (LAS float*)(lds + GS_RS) + wave * 64;
    f32x4 S[8];
#pragma unroll
    for (int rb = 0; rb < 8; ++rb) S[rb] = (f32x4){0.f, 0.f, 0.f, 0.f};
    {
        u32x4 pre[8];
#pragma unroll
        for (int i = 0; i < 8; ++i) pre[i] = __builtin_nontemporal_load((const u32x4*)(ubase + (size_t)(i * 512 + tid) * 16));
#pragma unroll
        for (int i = 0; i < 8; ++i) *(LAS u32x4*)(lds + (i * 512 + tid) * 16) = pre[i];
    }
    const float gnc = p.gdn_norm[col0 + c];
    f32x4 vnN[4]; float cdN; unsigned short zN[16];
    {
        const f32x4* Ug = (const f32x4*)(ubase + IMG_BYTES);
#pragma unroll
        for (int mb = 0; mb < 4; ++mb) vnN[mb] = __builtin_nontemporal_load(Ug + (wave * 4 + mb) * 64 + lane);
        cdN = cdp[0];
#pragma unroll
        for (int i = 0; i < 16; ++i) zN[i] = proj[(size_t)(b * SEQ + 16 * (i >> 2) + 4 * g + (i & 3)) * NP + C_ZG + h * 128 + col0 + c];
    }
    __syncthreads();
    for (int n = 0; n < 32; ++n) {
        const unsigned char* ub = ubase + (size_t)n * GDN_UNIT_BYTES;
        const LAS unsigned char* img = lds + (n & 1) * IMG_BYTES;
        LAS float* PS = (LAS float*)(lds + GS_PS) + (n & 1) * 512;
        u32x4 pre[8];
        f32x4 vn[4], O[4]; unsigned short zc[16];
#pragma unroll
        for (int mb = 0; mb < 4; ++mb) { vn[mb] = vnN[mb]; O[mb] = (f32x4){0.f, 0.f, 0.f, 0.f}; }
#pragma unroll
        for (int i = 0; i < 16; ++i) zc[i] = zN[i];
        const float cd = cdN;
        if (n + 1 < 32) {
#pragma unroll
            for (int i = 0; i < 8; ++i) pre[i] = __builtin_nontemporal_load((const u32x4*)(ub + GDN_UNIT_BYTES + (size_t)(i * 512 + tid) * 16));
            const f32x4* Ug = (const f32x4*)(ub + GDN_UNIT_BYTES + IMG_BYTES);
#pragma unroll
            for (int mb = 0; mb < 4; ++mb) vnN[mb] = __builtin_nontemporal_load(Ug + (wave * 4 + mb) * 64 + lane);
            cdN = cdp[n + 1];
#pragma unroll
            for (int i = 0; i < 16; ++i) zN[i] = proj[(size_t)(b * SEQ + 64 * (n + 1) + 16 * (i >> 2) + 4 * g + (i & 3)) * NP + C_ZG + h * 128 + col0 + c];
        }
        bf16x8 SB[4];
#pragma unroll
        for (int s2 = 0; s2 < 4; ++s2) SB[s2] = pack_acc(S[2 * s2], S[2 * s2 + 1]);
        const LAS unsigned char* a128 = img + c * GP + 16 * g;
        const LAS unsigned char* a64 = img + c * GP64 + 16 * g;
#pragma unroll
        for (int mb = 0; mb < 4; ++mb)
#pragma unroll
            for (int s2 = 0; s2 < 4; ++s2) {
                vn[mb] = __builtin_amdgcn_mfma_f32_16x16x32_bf16(*(const LAS bf16x8*)(a128 + IMG_NEGW + 16 * mb * GP + 64 * s2), SB[s2], vn[mb], 0, 0, 0);
                O[mb] = __builtin_amdgcn_mfma_f32_16x16x32_bf16(*(const LAS bf16x8*)(a128 + IMG_QD + 16 * mb * GP + 64 * s2), SB[s2], O[mb], 0, 0, 0);
            }
        bf16x8 VB[2];
#pragma unroll
        for (int s2 = 0; s2 < 2; ++s2) VB[s2] = pack_acc(vn[2 * s2], vn[2 * s2 + 1]);
#pragma unroll
        for (int mb = 0; mb < 4; ++mb)
#pragma unroll
            for (int s2 = 0; s2 < 2; ++s2) O[mb] = __builtin_amdgcn_mfma_f32_16x16x32_bf16(*(const LAS bf16x8*)(a64 + IMG_AQK + 16 * mb * GP64 + 64 * s2), VB[s2], O[mb], 0, 0, 0);
#pragma unroll
        for (int rb = 0; rb < 8; ++rb) {
            S[rb] = S[rb] * cd;
#pragma unroll
            for (int s2 = 0; s2 < 2; ++s2) S[rb] = __builtin_amdgcn_mfma_f32_16x16x32_bf16(*(const LAS bf16x8*)(a64 + IMG_KDT + 16 * rb * GP64 + 64 * s2), VB[s2], S[rb], 0, 0, 0);
        }
#pragma unroll
        for (int mb = 0; mb < 4; ++mb) {
            f32x4 q;
#pragma unroll
            for (int e = 0; e < 4; ++e) { float t = O[mb][e] * O[mb][e]; t += dpp_z<0x111, 0xf>(t); t += dpp_z<0x112, 0xf>(t); t += dpp_z<0x114, 0xf>(t); t += dpp_z<0x118, 0xf>(t); q[e] = t; }
            if (c == 15) {
#pragma unroll
                for (int e = 0; e < 4; ++e) PS[(16 * mb + 4 * g + e) * 8 + wave] = q[e];
            }
        }
        if (n + 1 < 32) {
            LAS unsigned char* dst = lds + ((n + 1) & 1) * IMG_BYTES;
#pragma unroll
            for (int i = 0; i < 8; ++i) *(LAS u32x4*)(dst + (i * 512 + tid) * 16) = pre[i];
        }
        __syncthreads();
        {
            const f32x4 p0 = *(const LAS f32x4*)(PS + lane * 8), p1 = *(const LAS f32x4*)(PS + lane * 8 + 4);
            const float ss = ((p0[0] + p0[1]) + (p0[2] + p0[3])) + ((p1[0] + p1[1]) + (p1[2] + p1[3]));
            RS[lane] = rsqrtf(ss * (1.f / 128.f) + 1e-6f);
            asm volatile("s_waitcnt lgkmcnt(0)" ::: "memory");
        }
#pragma unroll
        for (int mb = 0; mb < 4; ++mb) {
            const f32x4 rs = *(const LAS f32x4*)(RS + 16 * mb + 4 * g);
#pragma unroll
            for (int e = 0; e < 4; ++e) {
                const size_t r = (size_t)(b * SEQ + 64 * n + 16 * mb + 4 * g + e);
                const float z = bf2f(zc[4 * mb + e]);
                mixed[r * D_MODEL + 512 + h * 128 + col0 + c] = (bf16_t)(pk2(O[mb][e] * rs[e] * gnc * silu_f(z), 0.f) & 0xffffu);
            }
        }
    }
    float* So = p.out + O_SSMP + (size_t)bh * 128 * 128;
#pragma unroll
    for (int rb = 0; rb < 8; ++rb)
#pragma unroll
        for (int e = 0; e < 4; ++e) So[(16 * rb + 4 * g + e) * 128 + col0 + c] = S[rb][e];
    __syncthreads();
}

constexpr int SU_SCS = 0, SU_LST = 32896, SU_PHYS = 33920, SU_EQL = 34944, SU_CNT = 35200, SU_PL = 35456, SU_QA = 43648, SU_RED = 45696;
__device__ __forceinline__ bf16x8 pack8f(const f32x4 a, const f32x4 b) {
    u32x4 w; w.x = pk2(a[0], a[1]); w.y = pk2(a[2], a[3]); w.z = pk2(b[0], b[1]); w.w = pk2(b[2], b[3]);
    return __builtin_bit_cast(bf16x8, w);
}
__device__ __forceinline__ void sample_unit(const Params& p, LAS unsigned char* lds, int b) {
    int tid = threadIdx.x; asm volatile("" : "+v"(tid)); const int lane = tid & 63, wave = __builtin_amdgcn_readfirstlane(tid >> 6);
    LAS float* scs = (LAS float*)(lds + SU_SCS);
    LAS int* lst = (LAS int*)(lds + SU_LST);
    LAS int* phys = (LAS int*)(lds + SU_PHYS);
    LAS int* eql = (LAS int*)(lds + SU_EQL);
    LAS int* cnts = (LAS int*)(lds + SU_CNT);
    LAS float* pl = (LAS float*)(lds + SU_PL);
    LAS float* qa = (LAS float*)(lds + SU_QA);
    LAS float* red = (LAS float*)(lds + SU_RED);
    const size_t r = (size_t)MPROMPT + b;
    const bf16_t* proj = (const bf16_t*)(p.ws + WS_PROJ); const float* aux = (const float*)(p.ws + WS_AUX); bf16_t* mixed = (bf16_t*)(p.ws + WS_MIXED);
    const int* pt = p.page_table + b * NPAGES;
    qa[tid] = bf2f(proj[r * NP + C_Q + tid]) * 0.125f;
    if (tid < 64) cnts[tid] = 0;
    for (int i = tid; i < 2 * 1536; i += NTHR) p.out[O_CS + (size_t)b * 3 * 1536 + i] = p.state_conv[(size_t)b * 3 * 1536 + 1536 + i];
    {
        const int c = lane & 15, g = lane >> 4;
        const float w = aux[r * AUXP + c]; const float aw = fabsf(w) * (1.f / 32.f), sg = w < 0.f ? -1.f : 1.f;
        bf16x8 Qb[2];
#pragma unroll
        for (int s2 = 0; s2 < 2; ++s2) Qb[s2] = pack8_scaled(*(const u32x4*)(proj + r * NP + C_QI + c * 64 + 32 * s2 + 8 * g), aw);
        const f32x4 z4 = {0.f, 0.f, 0.f, 0.f};
        f32x4 ka[4], kb[4];
        auto load_tile = [&](int kt, f32x4 (&k)[4]) {
            if (kt < 512) {
                const int pg = __builtin_amdgcn_readfirstlane(pt[kt >> 3]);
                const f32x4* rp = (const f32x4*)(p.cache_kidx + ((size_t)pg * PAGE + ((16 * kt) & 127) + c) * 64 + 8 * g);
                k[0] = __builtin_nontemporal_load(rp); k[1] = __builtin_nontemporal_load(rp + 1); k[2] = __builtin_nontemporal_load(rp + 8); k[3] = __builtin_nontemporal_load(rp + 9);
            } else if (kt == 512 && c == 0) {
                const f32x4* rp = (const f32x4*)(p.out + O_KIS + (size_t)b * 64 + 8 * g);
                k[0] = rp[0]; k[1] = rp[1]; k[2] = rp[8]; k[3] = rp[9];
            } else { k[0] = z4; k[1] = z4; k[2] = z4; k[3] = z4; }
        };
        load_tile(wave, ka); load_tile(wave + 8, kb);
        for (int kt = wave; kt < 513; kt += 8) {
            f32x4 kn[4]; load_tile(kt + 16, kn);
            f32x4 acc = __builtin_amdgcn_mfma_f32_16x16x32_bf16(pack8f(ka[0], ka[1]), Qb[0], z4, 0, 0, 0);
            acc = __builtin_amdgcn_mfma_f32_16x16x32_bf16(pack8f(ka[2], ka[3]), Qb[1], acc, 0, 0, 0);
            f32x4 v;
#pragma unroll
            for (int e = 0; e < 4; ++e) {
                float t = sg * fmaxf(acc[e], 0.f);
                t += dpp_z<0x111, 0xf>(t); t += dpp_z<0x112, 0xf>(t); t += dpp_z<0x114, 0xf>(t); t += dpp_z<0x118, 0xf>(t);
                v[e] = t;
            }
            if (c == 15) *(LAS f32x4*)(scs + 16 * kt + 4 * g) = v;
#pragma unroll
            for (int e = 0; e < 4; ++e) { ka[e] = kb[e]; kb[e] = kn[e]; }
        }
    }
    __syncthreads();
    unsigned key[17];
#pragma unroll
    for (int i = 0; i < 17; ++i) { const int s = tid + 512 * i; key[i] = s <= PAST ? f2key(scs[s]) : 0u; }
    unsigned prefix = 0u;
    for (int bit = 30; bit >= 0; bit -= 2) {
        const unsigned c1 = prefix | (1u << bit), c2 = prefix | (2u << bit), c3 = prefix | (3u << bit);
        int n1 = 0, n2 = 0, n3 = 0;
#pragma unroll
        for (int i = 0; i < 17; ++i) { n1 += __popcll(__ballot(key[i] >= c1)); n2 += __popcll(__ballot(key[i] >= c2)); n3 += __popcll(__ballot(key[i] >= c3)); }
        const int slot = ((30 - bit) & 2) ? 32 : 0;
        if (lane == 0) { cnts[slot + wave * 4] = n1; cnts[slot + wave * 4 + 1] = n2; cnts[slot + wave * 4 + 2] = n3; }
        __syncthreads();
        int t1 = 0, t2 = 0, t3 = 0;
#pragma unroll
        for (int w8 = 0; w8 < 8; ++w8) { t1 += cnts[slot + w8 * 4]; t2 += cnts[slot + w8 * 4 + 1]; t3 += cnts[slot + w8 * 4 + 2]; }
        if (t3 >= 256) prefix = c3; else if (t2 >= 256) prefix = c2; else if (t1 >= 256) prefix = c1;
    }
    __syncthreads();
    if (tid < 2) cnts[tid] = 0;
    __syncthreads();
#pragma unroll
    for (int i = 0; i < 17; ++i) {
        const int s = tid + 512 * i;
        if (key[i] > prefix) { const int pos = atomicAdd((int*)&cnts[0], 1); if (pos < 256) lst[pos] = s; }
        else if (key[i] == prefix && s <= PAST) { const int pos = atomicAdd((int*)&cnts[1], 1); if (pos < 64) eql[pos] = s; }
    }
    __syncthreads();
    const int ngt = cnts[0], neq = cnts[1] < 64 ? cnts[1] : 64, need = 256 - ngt;
    __syncthreads();
    if (tid < neq) {
        const int s = eql[tid]; int rank = 0;
        for (int j = 0; j < neq; ++j) rank += (eql[j] < s) ? 1 : 0;
        if (rank < need) { const int pos = atomicAdd((int*)&cnts[0], 1); if (pos < 256) lst[pos] = s; }
    }
    __syncthreads();
    if (tid < 256) { const int s = lst[tid]; phys[tid] = s < PAST ? pt[s >> 7] * PAGE + (s & 127) : -1; }
    __syncthreads();
    {
        const int i = tid & 255, g = tid >> 8;
        const int s = lst[i], ph = phys[i]; int dn = PAST - s; dn = dn > 127 ? 127 : dn;
        const float* krow = ph >= 0 ? p.cache_k + ((size_t)ph * 2 + g) * 64 : p.out + O_KS + (size_t)b * 128 + g * 64;
        float kf[64];
#pragma unroll
        for (int c = 0; c < 16; ++c) { const f32x4 v = ((const f32x4*)krow)[c]; kf[4 * c] = v.x; kf[4 * c + 1] = v.y; kf[4 * c + 2] = v.z; kf[4 * c + 3] = v.w; }
        for (int hh = 0; hh < 4; ++hh) {
            const int h = g * 4 + hh; float dot = 0.f;
#pragma unroll
            for (int d = 0; d < 64; ++d) dot += qa[h * 64 + d] * kf[d];
            pl[h * 256 + i] = dot + p.rel_table[(int)c_bucket[dn] * 8 + h];
        }
    }
    __syncthreads();
    {
        const int h = wave;
        float v[4]; float m = -3.0e38f;
#pragma unroll
        for (int j = 0; j < 4; ++j) { v[j] = pl[h * 256 + lane + 64 * j]; m = fmaxf(m, v[j]); }
        m = wave_max(m);
        float sum = 0.f;
#pragma unroll
        for (int j = 0; j < 4; ++j) { v[j] = __expf(v[j] - m); sum += v[j]; }
        const float inv = 1.f / wave_sum(sum);
#pragma unroll
        for (int j = 0; j < 4; ++j) pl[h * 256 + lane + 64 * j] = v[j] * inv;
    }
    __syncthreads();
    {
        const int d = tid & 63, kg = tid >> 6;
        float acc[8] = {0.f, 0.f, 0.f, 0.f, 0.f, 0.f, 0.f, 0.f};
        for (int i0 = 0; i0 < 32; i0 += 8) {
            float v0[8], v1[8];
#pragma unroll
            for (int j = 0; j < 8; ++j) {
                const int ph = phys[kg * 32 + i0 + j];
                const float* vrow = ph >= 0 ? p.cache_v + (size_t)ph * 128 : p.out + O_VS + (size_t)b * 128;
                v0[j] = vrow[d]; v1[j] = vrow[64 + d];
            }
#pragma unroll
            for (int j = 0; j < 8; ++j) {
                const int i = kg * 32 + i0 + j;
#pragma unroll
                for (int h = 0; h < 8; ++h) acc[h] += pl[h * 256 + i] * (h < 4 ? v0[j] : v1[j]);
            }
        }
#pragma unroll
        for (int h = 0; h < 8; ++h) red[(kg * 8 + h) * 64 + d] = acc[h];
    }
    __syncthreads();
    {
        const int d = tid & 63, h = tid >> 6;
        float o = 0.f;
#pragma unroll
        for (int kg = 0; kg < 8; ++kg) o += red[(kg * 8 + h) * 64 + d];
        const float z = bf2f(proj[r * NP + C_ZA + h * 64 + d]);
        mixed[r * D_MODEL + h * 64 + d] = (bf16_t)f2bf(o * silu_f(z));
    }
    __syncthreads();
}

constexpr int N_PHASES = 6;
struct Args { Params p; int ph_lo, ph_hi; };
__global__ void __launch_bounds__(NTHR, 2) mk_fwd(Args a) {
    extern __shared__ __attribute__((aligned(16))) unsigned char lds_raw[];
    LAS unsigned char* lds = (LAS unsigned char*)lds_raw;
    const Params& p = a.p;
    volatile LAS unsigned* MISC = (volatile LAS unsigned*)(lds + MISC_OFF);
    for (int u = threadIdx.x; u < (LDS_BYTES - SCR_BYTES) / 4; u += NTHR) ((LAS unsigned*)(lds + SCR_BYTES))[u] = 0u;
    __syncthreads();
    const int lo = a.ph_lo, hi = a.ph_hi;
    const bool multi = (hi - lo) > 1;
    XcdBarrier bar; bar.bar = (unsigned*)(p.ws + WS_CTL) + CW_BAR; bar.x = 0; bar.st = nullptr;
    if (multi) bar = xcd_barrier_post((unsigned*)(p.ws + WS_CTL) + CW_BAR, MISC + 8);
#define IN(k) (lo <= (k) && (k) < hi)
#ifdef DBG_TIME
    unsigned long long ts0 = __builtin_amdgcn_s_memrealtime(), ts1 = 0, ts2 = 0, ts3 = 0, ts4 = 0, ts5 = 0;
#define STAMP(k) do { const unsigned long long _t = __builtin_amdgcn_s_memrealtime(); if ((k) == 0) ts1 = _t; else if ((k) == 1) ts2 = _t; else if ((k) == 2) ts3 = _t; else if ((k) == 3) ts4 = _t; else ts5 = _t; } while (0)
#else
#define STAMP(k) do {} while (0)
#endif
#define SEAM(k) do { if (IN(k) && IN((k) + 1)) xcd_barrier(bar); STAMP(k); } while (0)
#ifdef DBG_TIME
    unsigned long long tic_t = 0;
#define TIC() do { tic_t = __builtin_amdgcn_s_memrealtime(); } while (0)
#define TOC(k) do { const unsigned long long _n = __builtin_amdgcn_s_memrealtime(); if (threadIdx.x == 0) MISC[16 + (k)] += (unsigned)(_n - tic_t); tic_t = _n; } while (0)
#else
#define TIC() do {} while (0)
#define TOC(k) do {} while (0)
#endif
    if (IN(0)) { ph_prologue(p, lds); __syncthreads(); }
    SEAM(0);
    if (IN(1)) {
        pg8::Gemm g{(const bf16_t*)(p.ws + WS_XN), (const bf16_t*)(p.ws + WS_WINT), MP, NP, 1024};
        pg8::StaticOrder S; S.init(MP, NP, gridDim.x, blockIdx.x);
        EpiIn E{(bf16_t*)(p.ws + WS_PROJ), (float*)(p.ws + WS_AUX), p.out};
        pg8::gemm_phase<EpiIn, pg8::StaticOrder, true, true>(lds, g, S, E);
    }
    SEAM(1);
    if (IN(2)) {
        TIC();
        const bool flip = (((int)blockIdx.x >> 3) & 1) != 0;
#define GDN_LOCAL_BLOCK() do { GdnPre pre; \
            { int tz = threadIdx.x; asm volatile("" : "+v"(tz)); gdn_local_load(p, blockIdx.x, tz & 63, __builtin_amdgcn_readfirstlane(tz >> 6), pre); } \
            _Pragma("unroll 1") for (int u = blockIdx.x; u < BATCH * 4 * 32; u += gridDim.x) { const int nu = u + (int)gridDim.x; gdn_local_unit(p, lds, u, nu < BATCH * 4 * 32 ? nu : -1, pre); } } while (0)
        if (!flip) GDN_LOCAL_BLOCK();
        TOC(0);
        dsa_fill_bias(p, lds);
        {
            const bool bal = gridDim.x == 256;
            const int nun = bal ? 8 : (BATCH * 64 - (int)blockIdx.x + (int)gridDim.x - 1) / (int)gridDim.x;
            bool prebuilt = false;
#pragma unroll 1
            for (int k = 0; k < nun; ++k) {
                int b, qb, b2 = 0, qb2 = 0;
                if (bal) dsa_unit_of(blockIdx.x, k, b, qb); else { const int u = blockIdx.x + k * gridDim.x; b = u & 31; qb = 63 - (u >> 5); }
                const bool nxt = k + 1 < nun;
                if (nxt) { if (bal) dsa_unit_of(blockIdx.x, k + 1, b2, qb2); else { const int u = blockIdx.x + (k + 1) * gridDim.x; b2 = u & 31; qb2 = 63 - (u >> 5); } }
                const bool pre_next = nxt && qb2 >= 8;
                TIC(); dsa_idx_unit(p, lds, b, qb, prebuilt); TOC(1);
                AttnPre apre; dsa_attn_pre(p, b, qb, apre);
                IdxPre ipre; if (pre_next) dsa_idx_pre_load(p, b2, qb2, ipre);
                dsa_select_unit(p, lds, b, qb);
                if (pre_next) dsa_idx_pre_store(lds, ipre);
                TOC(3); dsa_attn_stage(p, lds, b, qb, apre); TOC(2);
                prebuilt = pre_next;
            }
        }
        if (flip) GDN_LOCAL_BLOCK();
#undef GDN_LOCAL_BLOCK
    }
    SEAM(2);
    if (IN(3)) {
        TIC();
        const int G = gridDim.x, half = G / 2;
        if ((int)blockIdx.x < half) { for (int u = blockIdx.x; u < BATCH * 4; u += half) gdn_seq_unit(p, lds, u, (bf16_t*)(p.ws + WS_MIXED)); }
        else {
            for (int u = (int)blockIdx.x - half; u < DEC_BATCH; u += G - half) {
                sample_unit(p, lds, u);
                for (int hh = 0; hh < 4; ++hh) nv_gdn_unit<1>(p, lds, 4 * u + hh, (bf16_t*)(p.ws + WS_MIXED), p.out + O_SSMS);
            }
        }
#ifdef DBG_TIME
        { const unsigned long long _n = __builtin_amdgcn_s_memrealtime(); if (threadIdx.x == 0 && (blockIdx.x == 0 || (int)blockIdx.x == half)) ((float*)(p.ws + WS_DBGACC))[blockIdx.x == 0 ? 6 : 7] = (float)(_n - tic_t) * 0.01f; }
#endif
    }
    SEAM(3);
    if (IN(4)) {
        pg8::Gemm g{(const bf16_t*)(p.ws + WS_MIXED), (const bf16_t*)(p.ws + WS_WOUTT), MP, 1024, 1024};
        pg8::StaticOrder S; S.init(MP, 1024, gridDim.x, blockIdx.x);
        EpiOut E{(bf16_t*)(p.ws + WS_MO)};
        pg8::gemm_phase<EpiOut, pg8::StaticOrder, true, true>(lds, g, S, E);
    }
    SEAM(4);
#ifdef DBG_CMP
    if (IN(5)) {
        for (int u = blockIdx.x; u < BATCH * 4; u += gridDim.x) nv_gdn_unit<0>(p, lds, u, (bf16_t*)(p.ws + WS_DBG), (float*)(p.ws + WS_DBG + 200 * MiB));
        xcd_barrier(bar);
        {
            const bf16_t* A = (const bf16_t*)(p.ws + WS_MIXED); const bf16_t* R = (const bf16_t*)(p.ws + WS_DBG);
            float num = 0.f, den = 0.f;
            for (size_t i = (size_t)blockIdx.x * NTHR + threadIdx.x; i < (size_t)MPROMPT * 512; i += (size_t)gridDim.x * NTHR) {
                const size_t row = i >> 9, col = 512 + (i & 511); const float a = bf2f(A[row * D_MODEL + col]), r = bf2f(R[row * D_MODEL + col]);
                num += (a - r) * (a - r); den += r * r;
            }
            num = wave_sum(num); den = wave_sum(den);
            if ((threadIdx.x & 63) == 0) { atomicAdd((float*)(p.ws + WS_DBGACC), num); atomicAdd((float*)(p.ws + WS_DBGACC) + 1, den); }
        }
        xcd_barrier(bar);
    }
#endif
#ifdef DBG_TIME
    if (blockIdx.x == 0 && threadIdx.x == 0) {
        const unsigned long long t[6] = {ts0, ts1, ts2, ts3, ts4, ts5};
        float* da = (float*)(p.ws + WS_DBGACC);
        if (TSEL1 == 20) { da[4] = da[6]; da[5] = da[7]; } else {
        da[4] = TSEL1 >= 10 ? (float)MISC[16 + TSEL1 - 10] * 0.01f : (float)(t[TSEL1] - t[TSEL1 - 1]) * 0.01f;
        da[5] = TSEL2 >= 10 ? (float)MISC[16 + TSEL2 - 10] * 0.01f : (float)(t[TSEL2] - t[TSEL2 - 1]) * 0.01f; }
    }
    xcd_barrier(bar);
    if (blockIdx.x == 0 && threadIdx.x == 0) p.out[O_CS] += ((const float*)(p.ws + WS_DBGACC))[5] * 0.1f;
#endif
    if (IN(5)) ph_final_norm(p);
#undef IN
#undef SEAM
}

#ifndef MK_N_LAUNCHES
#define MK_N_LAUNCHES 1
#endif
extern "C" void kernel_launch(void* const* d_in, const int* in_sizes, int n_in, void* d_out, int out_size, void* d_ws, size_t ws_size, hipStream_t stream) {
    static int grid = 0;
    if (grid == 0) {
        if (n_in != 17 || (size_t)out_size != O_END || ws_size < WS_END) { fprintf(stderr, "kernel_launch: unexpected shapes n_in %d out %d ws %zu\n", n_in, out_size, ws_size); grid = -1; return; }
        int dev = 0, cus = 0, per_cu = 0;
        if (hipGetDevice(&dev) != hipSuccess || hipDeviceGetAttribute(&cus, hipDeviceAttributeMultiprocessorCount, dev) != hipSuccess) { grid = -1; return; }
        if (hipFuncSetAttribute((const void*)mk_fwd, hipFuncAttributeMaxDynamicSharedMemorySize, LDS_BYTES) != hipSuccess) { fprintf(stderr, "kernel_launch: hipFuncSetAttribute failed\n"); grid = -1; return; }
        if (hipOccupancyMaxActiveBlocksPerMultiprocessor(&per_cu, (const void*)mk_fwd, NTHR, LDS_BYTES) != hipSuccess || per_cu < 1) { fprintf(stderr, "kernel_launch: occupancy query says %d blocks per CU\n", per_cu); (void)hipGetLastError(); }
        grid = cus;
    }
    if (grid < 0) return;
    Args a{};
    Params& p = a.p;
    p.x_prompt = (const float*)d_in[0]; p.x_sample = (const float*)d_in[1]; p.cache_k = (const float*)d_in[2]; p.cache_v = (const float*)d_in[3]; p.cache_kidx = (const float*)d_in[4];
    p.state_ssm = (const float*)d_in[5]; p.state_conv = (const float*)d_in[6]; p.page_table = (const int*)d_in[7]; p.norm_in = (const float*)d_in[8]; p.w_in = (const float*)d_in[9];
    p.conv_w = (const float*)d_in[10]; p.a_log = (const float*)d_in[11]; p.dt_bias = (const float*)d_in[12]; p.gdn_norm = (const float*)d_in[13]; p.w_out = (const float*)d_in[14];
    p.rel_table = (const float*)d_in[15]; p.norm_final = (const float*)d_in[16]; p.out = (float*)d_out; p.ws = (unsigned char*)d_ws;
    (void)hipMemsetAsync((char*)d_ws + WS_CTL, 0, CTL_BYTES, stream);
#if MK_N_LAUNCHES == 1
    a.ph_lo = 0; a.ph_hi = N_PHASES;
    hipLaunchKernelGGL(mk_fwd, dim3(grid), dim3(NTHR), LDS_BYTES, stream, a);
#else
    for (int k = 0; k < N_PHASES; ++k) { a.ph_lo = k; a.ph_hi = k + 1; hipLaunchKernelGGL(mk_fwd, dim3(grid), dim3(NTHR), LDS_BYTES, stream, a); }
#endif
}
```

```cpp
#include <hip/hip_runtime.h>
#define TSEL1 3
#define TSEL2 4
#include <cstdio>
#include <cstdint>

#define LAS __attribute__((address_space(3)))
#define GAS __attribute__((address_space(1)))
typedef unsigned short bf16_t;
typedef short bf16x8 __attribute__((ext_vector_type(8)));
typedef float f32x4 __attribute__((ext_vector_type(4)));
typedef float f32x2 __attribute__((ext_vector_type(2)));
typedef unsigned u32x4 __attribute__((ext_vector_type(4)));

constexpr int D_MODEL = 1024, BATCH = 32, SEQ = 2048, DEC_BATCH = 128, PAST = 8192, PAGE = 128, NPAGES = 64;
constexpr int MPROMPT = BATCH * SEQ;
constexpr int MVALID = MPROMPT + DEC_BATCH;
constexpr int MP = MPROMPT + 256;
constexpr int NP = 4608;
constexpr int C_Q = 0, C_K = 512, C_V = 640, C_ZA = 768, C_QI = 1280, C_KI = 2304, C_WI = 2368, C_AG = 2384, C_BG = 2388, C_QKV = 2560, C_ZG = 4096;
constexpr int AUXP = 32;
constexpr size_t O_YP = 0, O_YS = 67108864, O_KP = 67239936, O_VP = 75628544, O_KIP = 84017152, O_SSMP = 88211456, O_CP = 90308608,
                 O_KS = 90456064, O_VS = 90472448, O_KIS = 90488832, O_SSMS = 90497024, O_CS = 98885632, O_END = 99475456;
constexpr size_t MiB = 1u << 20;
constexpr size_t WS_CTL = 0, CTL_BYTES = 1 * MiB;
constexpr size_t WS_ROWSS = 512 * 1024;
constexpr size_t WS_WINT = 2 * MiB;
constexpr size_t WS_WOUTT = 12 * MiB;
constexpr size_t WS_XN = 16 * MiB;
constexpr size_t WS_PROJ = 146 * MiB;
constexpr size_t WS_AUX = 726 * MiB;
constexpr size_t WS_MIXED = 736 * MiB;
constexpr size_t WS_MASK = 866 * MiB;
constexpr size_t WS_DBG = 900 * MiB;
constexpr size_t WS_DBGACC = 256 * 1024;
constexpr size_t WS_GDN = 1200 * MiB;
constexpr size_t WS_CD = 1586 * MiB;
constexpr size_t WS_MO = 1590 * MiB;
constexpr size_t WS_END = 1720 * MiB;

__constant__ unsigned char c_bucket[128] = {0, 1, 2, 3, 4, 5, 6, 7, 8, 9, 10, 11, 12, 13, 14, 15, 16, 16, 16, 17, 17, 18, 18, 18, 19, 19, 19, 20, 20, 20, 20, 21, 21, 21, 21, 22, 22, 22, 22, 22, 23, 23, 23, 23, 23, 23, 24, 24, 24, 24, 24, 24, 25, 25, 25, 25, 25, 25, 25, 26, 26, 26, 26, 26, 26, 26, 26, 27, 27, 27, 27, 27, 27, 27, 27, 27, 27, 28, 28, 28, 28, 28, 28, 28, 28, 28, 28, 29, 29, 29, 29, 29, 29, 29, 29, 29, 29, 29, 29, 30, 30, 30, 30, 30, 30, 30, 30, 30, 30, 30, 30, 30, 30, 31, 31, 31, 31, 31, 31, 31, 31, 31, 31, 31, 31, 31, 31, 31};

__device__ __forceinline__ float bf2f(unsigned short b) { return __builtin_bit_cast(float, (unsigned)b << 16); }
__device__ __forceinline__ unsigned f2bf(float f) { unsigned u = __builtin_bit_cast(unsigned, f); return (u + 0x7fffu + ((u >> 16) & 1u)) >> 16; }
typedef __bf16 bf16x2_t __attribute__((ext_vector_type(2)));
__device__ __forceinline__ unsigned pk2(float lo, float hi) { f32x2 v = {lo, hi}; bf16x2_t b = __builtin_convertvector(v, bf16x2_t); return __builtin_bit_cast(unsigned, b); }
template <int CTRL, int RM> __device__ __forceinline__ float dpp_z(float v) { return __builtin_bit_cast(float, __builtin_amdgcn_update_dpp(0, __builtin_bit_cast(int, v), CTRL, RM, 0xf, CTRL < 0x140)); }
template <int CTRL, int RM> __device__ __forceinline__ float dpp_k(float v) { const int iv = __builtin_bit_cast(int, v); return __builtin_bit_cast(float, __builtin_amdgcn_update_dpp(iv, iv, CTRL, RM, 0xf, false)); }
template <int CTRL, int RM> __device__ __forceinline__ int dpp_zi(int v) { return __builtin_amdgcn_update_dpp(0, v, CTRL, RM, 0xf, CTRL < 0x140); }
__device__ __forceinline__ int wave_incl_scan_dpp(int v) {
    v += dpp_zi<0x111, 0xf>(v); v += dpp_zi<0x112, 0xf>(v); v += dpp_zi<0x114, 0xf>(v); v += dpp_zi<0x118, 0xf>(v);
    v += dpp_zi<0x142, 0xa>(v); v += dpp_zi<0x143, 0xc>(v);
    return v;
}
__device__ __forceinline__ float wave_incl_scan_f(float v) {
    v += dpp_z<0x111, 0xf>(v); v += dpp_z<0x112, 0xf>(v); v += dpp_z<0x114, 0xf>(v); v += dpp_z<0x118, 0xf>(v);
    v += dpp_z<0x142, 0xa>(v); v += dpp_z<0x143, 0xc>(v);
    return v;
}
__device__ __forceinline__ float wave_sum_u(float v) {
    v += dpp_z<0x111, 0xf>(v); v += dpp_z<0x112, 0xf>(v); v += dpp_z<0x114, 0xf>(v); v += dpp_z<0x118, 0xf>(v);
    v += dpp_z<0x142, 0xa>(v); v += dpp_z<0x143, 0xc>(v);
    return __builtin_bit_cast(float, __builtin_amdgcn_readlane(__builtin_bit_cast(int, v), 63));
}
__device__ __forceinline__ float wave_sum(float v) {
#pragma unroll
    for (int o = 1; o < 64; o <<= 1) v += __shfl_xor(v, o);
    return v;
}
__device__ __forceinline__ int wave_sum_i(int v) {
#pragma unroll
    for (int o = 1; o < 64; o <<= 1) v += __shfl_xor(v, o);
    return v;
}
__device__ __forceinline__ float wave_max(float v) {
#pragma unroll
    for (int o = 1; o < 64; o <<= 1) v = fmaxf(v, __shfl_xor(v, o));
    return v;
}
__device__ __forceinline__ int wave_excl_scan_i(int v, int lane) {
    int x = v;
#pragma unroll
    for (int o = 1; o < 64; o <<= 1) { int y = __shfl_up(x, o); if (lane >= o) x += y; }
    return x - v;
}
__device__ __forceinline__ unsigned f2key(float f) { unsigned u = __builtin_bit_cast(unsigned, f); return (u & 0x80000000u) ? ~u : (u | 0x80000000u); }
__device__ __forceinline__ float silu_f(float z) { return z * __builtin_amdgcn_rcpf(1.f + __expf(-z)); }
__device__ __forceinline__ void unpack8(const u32x4 w, float* f) {
    f[0] = __builtin_bit_cast(float, w.x << 16); f[1] = __builtin_bit_cast(float, w.x & 0xffff0000u);
    f[2] = __builtin_bit_cast(float, w.y << 16); f[3] = __builtin_bit_cast(float, w.y & 0xffff0000u);
    f[4] = __builtin_bit_cast(float, w.z << 16); f[5] = __builtin_bit_cast(float, w.z & 0xffff0000u);
    f[6] = __builtin_bit_cast(float, w.w << 16); f[7] = __builtin_bit_cast(float, w.w & 0xffff0000u);
}

namespace pg8 {
#define PG8_LAS __attribute__((address_space(3)))
constexpr int BM = 256, BK = 64, HALF = 128, HTB = HALF * BK * 2, STAGE_BYTES = 8 * HTB, NXCD = 8, WGM = 8;
__host__ __device__ __forceinline__ int lds_byte(int r, int c) { const int st = (r >> 4) * 2 + (c >> 5), rr = r & 15, cc = c & 31, ob = rr * 64 + cc * 2; return st * 1024 + (ob ^ (((ob >> 9) & 1) << 5)); }
__host__ __device__ __forceinline__ void stage_rc(int b, int& R, int& C) { const int st = b / 1024, sb = b % 1024, swz = sb ^ (((sb >> 9) & 1) << 5); R = (st >> 1) * 16 + swz / 64; C = (st & 1) * 32 + (swz % 64) / 2; }
__host__ __device__ __forceinline__ int perm32(int rho) { const int n = rho >> 4, i = rho & 15; return 8 * (i >> 2) + 4 * n + (i & 3); }
struct Unit { int pm, pn; };
struct Gemm { const bf16_t* A; const bf16_t* Bt; int M, N, K; };
struct StaticOrder {
    int nM, nN, nwg, G, c;
    __host__ __device__ void init(int M, int N, int G_, int c_) { nM = M / BM; nN = N / BM; nwg = nM * nN; G = G_; c = c_; }
    __host__ __device__ bool next(int i, Unit& u) const {
        const long L = (long)i * G + c; if (L >= nwg) return false;
        int wgid = (int)L; { const int q = nwg / NXCD, r = nwg % NXCD, xcd = wgid % NXCD, off = wgid / NXCD; wgid = (xcd < r ? xcd * (q + 1) : r * (q + 1) + (xcd - r) * q) + off; }
        const int nig = WGM * nN, gid = wgid / nig, fm = gid * WGM, gsz = (nM - fm) < WGM ? (nM - fm) : WGM;
        u.pm = fm + ((wgid % nig) % gsz); u.pn = (wgid % nig) / gsz; return true;
    }
    __device__ __forceinline__ void a_ready(const Unit&) const {}
    __device__ __forceinline__ void done(const Unit&) const {}
};
__device__ __forceinline__ unsigned cvt_pk_bf16(float lo, float hi) { unsigned r; asm volatile("v_cvt_pk_bf16_f32 %0, %1, %2" : "=v"(r) : "v"(lo), "v"(hi)); return r; }

template <class Epi, class Sched, bool ALIGN_EPI = false, bool SP2 = false>
__device__ __forceinline__ void gemm_phase(PG8_LAS unsigned char* lds, const Gemm g, const Sched& S, const Epi& E) {
    const int tid = threadIdx.x, wid = __builtin_amdgcn_readfirstlane(tid >> 6), lane = tid & 63, wr = wid >> 2, wc = wid & 3, fr = lane & 15, fq = lane >> 4;
    const int K = g.K, nt = K / BK;
    unsigned voffA[2], voffB[2];
#pragma unroll
    for (int i = 0; i < 2; ++i) { int R, C; stage_rc(tid * 16 + i * 8192, R, C); const int Rb = Epi::PERM ? ((R & ~31) + perm32(R & 31)) : R;
        voffA[i] = (unsigned)(R * K + C) * 2u; voffB[i] = (unsigned)(Rb * K + C) * 2u; }
    const size_t kstep = (size_t)(BK * 2);
    const size_t hstep = (size_t)HALF * K * 2;
    const size_t tstep = 2 * hstep;
    const unsigned ldsw = (unsigned)wid * 1024u;
    const int aoff = lds_byte(wr * 64 + fr, fq * 8), boff = lds_byte(wc * 32 + fr, fq * 8);
#define PG8_SA(b, h) (((b) * 2 + (h)) * HTB)
#define PG8_SB(b, h) ((4 + (b) * 2 + (h)) * HTB)
#define PG8_STAGE(bufoff, gbase, voff) do { _Pragma("unroll") for (int _i = 0; _i < 2; ++_i) \
        __builtin_amdgcn_global_load_lds((const unsigned*)((const char*)(gbase) + (voff)[_i]), (PG8_LAS unsigned*)(lds + (bufoff) + ldsw + _i * 8192), 16, 0, 0); } while (0)
#define PG8_LDA(dst, b, h) do { _Pragma("unroll") for (int m = 0; m < 4; ++m) _Pragma("unroll") for (int k = 0; k < 2; ++k) dst[m][k] = *(const PG8_LAS bf16x8*)(lds + PG8_SA(b, h) + aoff + m * 2048 + k * 1024); } while (0)
#define PG8_LDB(dst, b, h) do { _Pragma("unroll") for (int n = 0; n < 2; ++n) _Pragma("unroll") for (int k = 0; k < 2; ++k) dst[n][k] = *(const PG8_LAS bf16x8*)(lds + PG8_SB(b, h) + boff + n * 2048 + k * 1024); } while (0)
#define PG8_MMA(ai, bj, At, Bt) do { __builtin_amdgcn_s_setprio(1); _Pragma("unroll") for (int m = 0; m < 4; ++m) _Pragma("unroll") for (int n = 0; n < 2; ++n) _Pragma("unroll") for (int k = 0; k < 2; ++k) \
        acc[ai][bj][m][n] = __builtin_amdgcn_mfma_f32_16x16x32_bf16(Bt[n][k], At[m][k], acc[ai][bj][m][n], 0, 0, 0); __builtin_amdgcn_s_setprio(0); } while (0)
#define PG8_WAIT_V(n) asm volatile("s_waitcnt vmcnt(" #n ")" ::: "memory")
#define PG8_WAIT_L(n) asm volatile("s_waitcnt lgkmcnt(" #n ")" ::: "memory")
#define PG8_BAR __builtin_amdgcn_s_barrier()
#define PG8_SCHED __builtin_amdgcn_sched_barrier(0)
    Unit cur, nxt; int ui = 0;
    if (!S.next(0, cur)) return;
    f32x4 acc[2][2][4][2];
#pragma unroll
    for (int a = 0; a < 2; ++a)
#pragma unroll
        for (int b = 0; b < 2; ++b)
#pragma unroll
            for (int m = 0; m < 4; ++m)
#pragma unroll
                for (int n = 0; n < 2; ++n) acc[a][b][m][n] = (f32x4){0.f, 0.f, 0.f, 0.f};
    bf16x8 At[4][2], B0[2][2], B1[2][2];
    const char* cA = (const char*)g.A + (size_t)cur.pm * tstep; const char* cB = (const char*)g.Bt + (size_t)cur.pn * tstep;
    S.a_ready(cur);
    if constexpr (SP2) {
        PG8_STAGE(PG8_SB(0, 0), cB, voffB); PG8_STAGE(PG8_SB(0, 1), cB + hstep, voffB); PG8_STAGE(PG8_SA(0, 0), cA, voffA); PG8_STAGE(PG8_SA(0, 1), cA + hstep, voffA);
        if (wr == 1) PG8_BAR;
        PG8_WAIT_V(2); PG8_BAR;
        PG8_STAGE(PG8_SB(1, 0), cB + kstep, voffB); PG8_STAGE(PG8_SA(1, 0), cA + kstep, voffA); PG8_STAGE(PG8_SB(1, 1), cB + hstep + kstep, voffB);
        PG8_WAIT_V(6); PG8_BAR;
    } else {
        PG8_STAGE(PG8_SB(0, 0), cB, voffB); PG8_STAGE(PG8_SA(0, 0), cA, voffA); PG8_STAGE(PG8_SB(0, 1), cB + hstep, voffB); PG8_STAGE(PG8_SA(0, 1), cA + hstep, voffA);
        if (wr == 1) PG8_BAR;
        PG8_WAIT_V(4); PG8_BAR;
        PG8_STAGE(PG8_SB(1, 0), cB + kstep, voffB); PG8_STAGE(PG8_SA(1, 0), cA + kstep, voffA); PG8_STAGE(PG8_SB(1, 1), cB + hstep + kstep, voffB);
        PG8_WAIT_V(6); PG8_BAR;
    }
    for (;;) {
        const bool has_next = S.next(ui + 1, nxt);
        const char* nA = has_next ? (const char*)g.A + (size_t)nxt.pm * tstep : cA; const char* nB = has_next ? (const char*)g.Bt + (size_t)nxt.pn * tstep : cB;
        for (int t = 0; t < nt; t += 2) {
            const bool last = (t == nt - 2);
            const char* a1 = cA + (size_t)(t + 1) * kstep;
            const char* a2 = last ? nA : cA + (size_t)(t + 2) * kstep; const char* b2 = last ? nB : cB + (size_t)(t + 2) * kstep;
            const char* a3 = a2 + kstep; const char* b3 = b2 + kstep;
            if (last && has_next) S.a_ready(nxt);
            if constexpr (SP2) {
            PG8_LDB(B0, 0, 0); PG8_LDB(B1, 0, 1); PG8_SCHED; PG8_LDA(At, 0, 0); PG8_STAGE(PG8_SA(1, 1), a1 + hstep, voffA);
            PG8_WAIT_V(8); PG8_WAIT_L(0); PG8_BAR; PG8_MMA(0, 0, At, B0); PG8_MMA(0, 1, At, B1); PG8_BAR; PG8_SCHED;
            PG8_LDA(At, 0, 1); PG8_STAGE(PG8_SB(0, 0), b2, voffB); PG8_STAGE(PG8_SB(0, 1), b2 + hstep, voffB); PG8_STAGE(PG8_SA(0, 0), a2, voffA);
            PG8_WAIT_V(8); PG8_WAIT_L(0); PG8_BAR; PG8_MMA(1, 0, At, B0); PG8_MMA(1, 1, At, B1); PG8_BAR; PG8_SCHED;
            PG8_LDB(B0, 1, 0); PG8_LDB(B1, 1, 1); PG8_SCHED; PG8_LDA(At, 1, 0); PG8_STAGE(PG8_SA(0, 1), a2 + hstep, voffA);
            PG8_WAIT_V(8); PG8_WAIT_L(0); PG8_BAR; PG8_MMA(0, 0, At, B0); PG8_MMA(0, 1, At, B1); PG8_BAR; PG8_SCHED;
            PG8_LDA(At, 1, 1); PG8_STAGE(PG8_SB(1, 0), b3, voffB); PG8_STAGE(PG8_SB(1, 1), b3 + hstep, voffB); PG8_STAGE(PG8_SA(1, 0), a3, voffA);
            PG8_WAIT_V(8); PG8_WAIT_L(0); PG8_BAR; PG8_MMA(1, 0, At, B0); PG8_MMA(1, 1, At, B1); PG8_BAR; PG8_SCHED;
            } else {
            PG8_LDB(B0, 0, 0); PG8_SCHED; PG8_LDA(At, 0, 0); PG8_STAGE(PG8_SA(1, 1), a1 + hstep, voffA);
            PG8_WAIT_L(8); PG8_BAR; PG8_WAIT_L(0); PG8_MMA(0, 0, At, B0); PG8_BAR; PG8_SCHED;
            PG8_LDB(B1, 0, 1); PG8_STAGE(PG8_SB(0, 0), b2, voffB);
            PG8_BAR; PG8_WAIT_L(0); PG8_MMA(0, 1, At, B1); PG8_BAR;
            PG8_LDA(At, 0, 1); PG8_STAGE(PG8_SA(0, 0), a2, voffA);
            PG8_BAR; PG8_WAIT_L(0); PG8_MMA(1, 0, At, B0); PG8_BAR; PG8_SCHED;
            PG8_STAGE(PG8_SB(0, 1), b2 + hstep, voffB);
            PG8_WAIT_V(6); PG8_BAR; PG8_MMA(1, 1, At, B1); PG8_BAR;
            PG8_LDB(B0, 1, 0); PG8_SCHED; PG8_LDA(At, 1, 0); PG8_STAGE(PG8_SA(0, 1), a2 + hstep, voffA);
            PG8_WAIT_L(8); PG8_BAR; PG8_WAIT_L(0); PG8_MMA(0, 0, At, B0); PG8_BAR; PG8_SCHED;
            PG8_LDB(B1, 1, 1); PG8_STAGE(PG8_SB(1, 0), b3, voffB);
            PG8_BAR; PG8_WAIT_L(0); PG8_MMA(0, 1, At, B1); PG8_BAR;
            PG8_LDA(At, 1, 1); PG8_STAGE(PG8_SA(1, 0), a3, voffA);
            PG8_BAR; PG8_WAIT_L(0); PG8_MMA(1, 0, At, B0); PG8_BAR; PG8_SCHED;
            PG8_STAGE(PG8_SB(1, 1), b3 + hstep, voffB);
            PG8_WAIT_V(6); PG8_BAR; PG8_MMA(1, 1, At, B1); PG8_BAR;
            }
        }
        if constexpr (ALIGN_EPI) { if (wr == 0) PG8_BAR; }
        if constexpr (!Epi::AFTER_DRAIN) { E(acc, cur, wr, wc, fr, fq); S.done(cur); }
        if (!has_next) break;
#pragma unroll
        for (int a = 0; a < 2; ++a)
#pragma unroll
            for (int b = 0; b < 2; ++b)
#pragma unroll
                for (int m = 0; m < 4; ++m)
#pragma unroll
                    for (int n = 0; n < 2; ++n) acc[a][b][m][n] = (f32x4){0.f, 0.f, 0.f, 0.f};
        cur = nxt; cA = nA; cB = nB; ++ui;
        if constexpr (ALIGN_EPI) { if (wr == 1) PG8_BAR; }
    }
    PG8_WAIT_V(0);
    if constexpr (!ALIGN_EPI) { if (wr == 0) PG8_BAR; }
    PG8_BAR;
#undef PG8_SA
#undef PG8_SB
#undef PG8_STAGE
#undef PG8_LDA
#undef PG8_LDB
#undef PG8_MMA
#undef PG8_WAIT_V
#undef PG8_WAIT_L
#undef PG8_BAR
#undef PG8_SCHED
}
}

struct EpiIn {
    static constexpr bool PERM = true, AFTER_DRAIN = false;
    bf16_t* proj; float* aux; float* out;
    __device__ __forceinline__ void operator()(const f32x4 (&acc)[2][2][4][2], const pg8::Unit& u, int wr, int wc, int fr, int fq) const {
        const int row0 = u.pm * 256 + wr * 64 + fr, colb = u.pn * 256 + wc * 32 + 8 * fq, pn = u.pn;
#pragma unroll
        for (int ai = 0; ai < 2; ++ai)
#pragma unroll
            for (int m = 0; m < 4; ++m) {
                const int row = row0 + ai * 128 + m * 16;
#pragma unroll
                for (int bj = 0; bj < 2; ++bj) {
                    const int col = colb + bj * 128;
                    const f32x4 v0 = acc[ai][bj][m][0], v1 = acc[ai][bj][m][1];
                    u32x4 w; w.x = pg8::cvt_pk_bf16(v0[0], v0[1]); w.y = pg8::cvt_pk_bf16(v0[2], v0[3]); w.z = pg8::cvt_pk_bf16(v1[0], v1[1]); w.w = pg8::cvt_pk_bf16(v1[2], v1[3]);
                    *(u32x4*)(proj + (size_t)row * NP + col) = w;
                    float* dst = nullptr;
                    if (pn == 2) {
                        const int c = col - C_K; const int isv = c >= 128; const int cc = c & 127;
                        if (row < MPROMPT) dst = out + (isv ? O_VP : O_KP) + (size_t)row * 128 + cc;
                        else if (row < MVALID) dst = out + (isv ? O_VS : O_KS) + (size_t)(row - MPROMPT) * 128 + cc;
                    } else if (pn == 9) {
                        const int c = col - C_KI;
                        if (c < 64) {
                            if (row < MPROMPT) dst = out + O_KIP + (size_t)row * 64 + c;
                            else if (row < MVALID) dst = out + O_KIS + (size_t)(row - MPROMPT) * 64 + c;
                        } else if (c < 88) dst = aux + (size_t)row * AUXP + (c - 64);
                    } else if (pn >= 10 && pn <= 15) {
                        const int c = col - C_QKV;
                        if (row < MPROMPT) { const int t = row & (SEQ - 1); if (t >= SEQ - 3) dst = out + O_CP + ((size_t)(row >> 11) * 3 + (t - (SEQ - 3))) * 1536 + c; }
                        else if (row < MVALID) dst = out + O_CS + ((size_t)(row - MPROMPT) * 3 + 2) * 1536 + c;
                    }
                    if (dst) { __builtin_nontemporal_store(v0, (f32x4*)dst); __builtin_nontemporal_store(v1, (f32x4*)(dst + 4)); }
                }
            }
    }
};
struct EpiOut {
    static constexpr bool PERM = true, AFTER_DRAIN = false;
    bf16_t* mo;
    __device__ __forceinline__ void operator()(const f32x4 (&acc)[2][2][4][2], const pg8::Unit& u, int wr, int wc, int fr, int fq) const {
        const int row0 = u.pm * 256 + wr * 64 + fr, colb = u.pn * 256 + wc * 32 + 8 * fq;
#pragma unroll
        for (int ai = 0; ai < 2; ++ai)
#pragma unroll
            for (int m = 0; m < 4; ++m) {
                const int row = row0 + ai * 128 + m * 16;
#pragma unroll
                for (int bj = 0; bj < 2; ++bj) {
                    const f32x4 v0 = acc[ai][bj][m][0], v1 = acc[ai][bj][m][1];
                    u32x4 w; w.x = pg8::cvt_pk_bf16(v0[0], v0[1]); w.y = pg8::cvt_pk_bf16(v0[2], v0[3]); w.z = pg8::cvt_pk_bf16(v1[0], v1[1]); w.w = pg8::cvt_pk_bf16(v1[2], v1[3]);
                    *(u32x4*)(mo + (size_t)row * D_MODEL + colb + bj * 128) = w;
                }
            }
    }
};

struct Params {
    const float* x_prompt; const float* x_sample; const float* cache_k; const float* cache_v; const float* cache_kidx; const float* state_ssm; const float* state_conv;
    const int* page_table; const float* norm_in; const float* w_in; const float* conv_w; const float* a_log; const float* dt_bias; const float* gdn_norm; const float* w_out;
    const float* rel_table; const float* norm_final; float* out; unsigned char* ws;
};

constexpr int NWAVES = 8, NTHR = 512;
constexpr int SCR_BYTES = 145408;
constexpr int MISC_OFF = SCR_BYTES + 320;
constexpr int LDS_BYTES = 147456;
constexpr int CW_BAR = 4096;
typedef GAS unsigned gu32;
#define RLX_AGENT __ATOMIC_RELAXED, __HIP_MEMORY_SCOPE_AGENT
#define LDS_WAIT() asm volatile("s_waitcnt lgkmcnt(0)" ::: "memory")

#define XB_TMO      128
#define XB_XCNT(j)  (256  + 64 * (j))
#define XB_XSUB(j)  (1280 + 64 * (j))
#define XB_XGEN(j)  (2304 + 64 * (j))
#define XB_TOP      3328
#define XB_TOPGEN   3392
#define XCD_BAR_WORDS 3456
#define XB_SPIN_CAP (1u << 22)
__device__ __forceinline__ unsigned xb_ld(unsigned* p)              { return __hip_atomic_load(p, __ATOMIC_RELAXED, __HIP_MEMORY_SCOPE_AGENT); }
__device__ __forceinline__ unsigned xb_add(unsigned* p, unsigned v) { return __hip_atomic_fetch_add(p, v, __ATOMIC_RELAXED, __HIP_MEMORY_SCOPE_AGENT); }
__device__ __forceinline__ unsigned xb_xcc_id() { return (unsigned)__builtin_amdgcn_s_getreg((3 << 11) | 20) & 0xFu; }
#define XB_SPIN(cond, bar) do { unsigned _sp = 0; while (cond) { __builtin_amdgcn_s_sleep(1); \
    if ((++_sp & 255u) == 0u) { if (xb_ld(&(bar)[XB_TMO])) break; if (_sp > XB_SPIN_CAP) { atomicAdd(&(bar)[XB_TMO], 1u); break; } } } } while (0)
struct XcdBarrier { unsigned* bar; unsigned x; volatile LAS unsigned* st; };
__device__ __forceinline__ XcdBarrier xcd_barrier_post(unsigned* bar, volatile LAS unsigned* st) {
    XcdBarrier b; b.bar = bar; b.x = xb_xcc_id(); b.st = st;
    if (threadIdx.x == 0) (void)xb_add(&bar[XB_XCNT(b.x)], 1u);
    return b;
}
__device__ __forceinline__ void xcd_barrier_complete(unsigned* bar, unsigned x, unsigned& nloc, unsigned& nx) {
    const unsigned G = gridDim.x * gridDim.y * gridDim.z;
    unsigned sum, cnt, mine, sp = 0u;
    for (;;) {
        sum = 0u; cnt = 0u; mine = 0u;
#pragma unroll
        for (unsigned j = 0; j < 16; ++j) { const unsigned c = xb_ld(&bar[XB_XCNT(j)]); sum += c; cnt += (c > 0u) ? 1u : 0u; mine = (j == x) ? c : mine; }
        if (sum == G) break;
        __builtin_amdgcn_s_sleep(1);
        if ((++sp & 255u) == 0u) { if (xb_ld(&bar[XB_TMO])) break; if (sp > XB_SPIN_CAP) { atomicAdd(&bar[XB_TMO], 1u); break; } }
    }
    nloc = mine > 0u ? mine : 1u; nx = cnt > 0u ? cnt : 1u;
}
__device__ __forceinline__ void xcd_barrier(const XcdBarrier& b) {
    asm volatile("s_waitcnt vmcnt(0)" ::: "memory");
    __syncthreads();
    if (threadIdx.x == 0) {
        unsigned* bar = b.bar;
        __builtin_amdgcn_s_waitcnt(0);
        unsigned nloc = b.st[0], nx = b.st[1];
        if (nloc == 0u) { xcd_barrier_complete(bar, b.x, nloc, nx); b.st[0] = nloc; b.st[1] = nx; }
        const unsigned old = xb_add(&bar[XB_XSUB(b.x)], 1u);
        const unsigned gen = old / nloc;
        if (old + 1u == (gen + 1u) * nloc) {
            __builtin_amdgcn_fence(__ATOMIC_RELEASE, "agent");
            asm volatile("s_waitcnt vmcnt(0)" ::: "memory");
            const unsigned og = xb_add(&bar[XB_TOP], 1u);
            const unsigned tg = og / nx;
            if (og + 1u == (tg + 1u) * nx) xb_add(&bar[XB_TOPGEN], 1u);
            else XB_SPIN(xb_ld(&bar[XB_TOPGEN]) == tg, bar);
            __builtin_amdgcn_fence(__ATOMIC_ACQUIRE, "agent");
            xb_add(&bar[XB_XGEN(b.x)], 1u);
            asm volatile("s_waitcnt vmcnt(0)" ::: "memory");
        } else {
            XB_SPIN(xb_ld(&bar[XB_XGEN(b.x)]) == gen, bar);
            __builtin_amdgcn_fence(__ATOMIC_ACQUIRE, "agent");
            asm volatile("s_waitcnt vmcnt(0)" ::: "memory");
        }
    }
    __syncthreads();
}

__device__ __forceinline__ int win_src_col(int n) {
    if (n < C_AG) return n;
    if (n < C_AG + 8) return n + 2048;
    if (n < C_QKV) return -1;
    return n - 176;
}
template <bool MAPPED>
__device__ __forceinline__ void transpose_item(const float* W, int K, int N, bf16_t* WT, LAS float* scr, int item, int nblk, int lane) {
    const int kb = item / nblk, nb = item % nblk, k0 = 64 * kb, n0 = 32 * nb;
    const int nd = n0 + (lane & 31); const int src = MAPPED ? win_src_col(nd) : nd;
#pragma unroll 8
    for (int i = 0; i < 32; ++i) { const int kk = 2 * i + (lane >> 5); scr[kk * 33 + (lane & 31)] = src >= 0 ? W[(size_t)(k0 + kk) * N + src] : 0.f; }
    LDS_WAIT();
    const int c = lane & 7;
#pragma unroll
    for (int j = 0; j < 4; ++j) { const int n = (lane >> 3) + 8 * j; const LAS float* s = scr + (8 * c) * 33 + n;
        u32x4 o; o.x = pk2(s[0 * 33], s[1 * 33]); o.y = pk2(s[2 * 33], s[3 * 33]); o.z = pk2(s[4 * 33], s[5 * 33]); o.w = pk2(s[6 * 33], s[7 * 33]);
        *(u32x4*)(WT + (size_t)(n0 + n) * K + k0 + 8 * c) = o; }
    LDS_WAIT();
}
__device__ __forceinline__ void ph_prologue(const Params& p, LAS unsigned char* lds) {
    const int tid = threadIdx.x, lane = tid & 63, wave = tid >> 6;
    const int gw = blockIdx.x * NWAVES + wave, NGW = gridDim.x * NWAVES;
    bf16_t* WINT = (bf16_t*)(p.ws + WS_WINT); bf16_t* WOUTT = (bf16_t*)(p.ws + WS_WOUTT); bf16_t* XN = (bf16_t*)(p.ws + WS_XN);
    LAS float* scr = (LAS float*)(lds + wave * 8448);
    constexpr int I_IN = (1024 / 64) * (NP / 32), I_OUT = (1024 / 64) * (1024 / 32);
    for (int it = gw; it < I_IN + I_OUT; it += NGW) {
        if (it < I_IN) transpose_item<true>(p.w_in, 1024, 4440, WINT, scr, it, NP / 32, lane);
        else transpose_item<false>(p.w_out, 1024, 1024, WOUTT, scr, it - I_IN, 1024 / 32, lane);
    }
    f32x4 gv[4];
#pragma unroll
    for (int j = 0; j < 4; ++j) gv[j] = ((const f32x4*)p.norm_in)[lane + 64 * j];
    for (int m0 = 4 * gw; m0 < MP; m0 += 4 * NGW) {
        if (m0 >= MVALID) {
#pragma unroll
            for (int rr = 0; rr < 4; ++rr) { unsigned long long* o8 = (unsigned long long*)(XN + (size_t)(m0 + rr) * D_MODEL) + lane;
#pragma unroll
                for (int j = 0; j < 4; ++j) o8[64 * j] = 0ull; }
            continue;
        }
        f32x4 v[4][4];
#pragma unroll
        for (int rr = 0; rr < 4; ++rr) {
            const int m = m0 + rr;
            const f32x4* xr = (const f32x4*)(m < MPROMPT ? p.x_prompt + (size_t)m * D_MODEL : p.x_sample + (size_t)(m - MPROMPT) * D_MODEL) + lane;
#pragma unroll
            for (int j = 0; j < 4; ++j) v[rr][j] = __builtin_nontemporal_load(xr + 64 * j);
        }
#pragma unroll
        for (int rr = 0; rr < 4; ++rr) {
            float ss = 0.f;
#pragma unroll
            for (int j = 0; j < 4; ++j) ss += (v[rr][j].x * v[rr][j].x + v[rr][j].y * v[rr][j].y) + (v[rr][j].z * v[rr][j].z + v[rr][j].w * v[rr][j].w);
            const float ms = wave_sum_u(ss) * (1.f / D_MODEL) + 1e-6f;
            const float rs = rsqrtf(ms);
            if (lane == 0) ((float*)(p.ws + WS_ROWSS))[m0 + rr] = ms * rs;
            unsigned long long* o8 = (unsigned long long*)(XN + (size_t)(m0 + rr) * D_MODEL) + lane;
#pragma unroll
            for (int j = 0; j < 4; ++j) { const f32x4 y = v[rr][j] * rs * gv[j]; o8[64 * j] = (unsigned long long)pk2(y.x, y.y) | ((unsigned long long)pk2(y.z, y.w) << 32); }
        }
    }
}
__device__ __forceinline__ void ph_final_norm(const Params& p) {
    const int lane = threadIdx.x & 63, gw = blockIdx.x * NWAVES + (threadIdx.x >> 6), NGW = gridDim.x * NWAVES;
    const bf16_t* mo = (const bf16_t*)(p.ws + WS_MO); const bf16_t* XN = (const bf16_t*)(p.ws + WS_XN); const float* rowsc = (const float*)(p.ws + WS_ROWSS);
    f32x4 gv[4], ig[4];
#pragma unroll
    for (int j = 0; j < 4; ++j) { gv[j] = ((const f32x4*)p.norm_final)[lane + 64 * j]; const f32x4 t = ((const f32x4*)p.norm_in)[lane + 64 * j]; ig[j] = (f32x4){1.f / t.x, 1.f / t.y, 1.f / t.z, 1.f / t.w}; }
    for (int m0 = 4 * gw; m0 < MVALID; m0 += 4 * NGW) {
        f32x4 h[4][4];
#pragma unroll
        for (int rr = 0; rr < 4; ++rr) {
            const int m = m0 + rr;
            const unsigned long long* xr = (const unsigned long long*)(XN + (size_t)m * D_MODEL) + lane;
            const unsigned long long* mr = (const unsigned long long*)(mo + (size_t)m * D_MODEL) + lane;
            const float sc = rowsc[m];
#pragma unroll
            for (int j = 0; j < 4; ++j) {
                const unsigned long long xv = __builtin_nontemporal_load(xr + 64 * j), mv = __builtin_nontemporal_load(mr + 64 * j);
                const f32x4 xf = (f32x4){bf2f((unsigned short)(xv & 0xffff)), bf2f((unsigned short)((xv >> 16) & 0xffff)), bf2f((unsigned short)((xv >> 32) & 0xffff)), bf2f((unsigned short)(xv >> 48))};
                const f32x4 mf = (f32x4){bf2f((unsigned short)(mv & 0xffff)), bf2f((unsigned short)((mv >> 16) & 0xffff)), bf2f((unsigned short)((mv >> 32) & 0xffff)), bf2f((unsigned short)(mv >> 48))};
                h[rr][j] = xf * ig[j] * sc + mf;
            }
        }
#pragma unroll
        for (int rr = 0; rr < 4; ++rr) {
            float ss = 0.f;
#pragma unroll
            for (int j = 0; j < 4; ++j) ss += (h[rr][j].x * h[rr][j].x + h[rr][j].y * h[rr][j].y) + (h[rr][j].z * h[rr][j].z + h[rr][j].w * h[rr][j].w);
            float rs = rsqrtf(wave_sum_u(ss) * (1.f / D_MODEL) + 1e-6f);
#ifdef DBG_CMP
            if (m0 + rr >= MPROMPT) { const float* da = (const float*)(p.ws + WS_DBGACC); rs *= 1.f + sqrtf(100.f * da[0] / da[1]); }
#endif
#ifdef DBG_TIME
            if (m0 + rr >= MPROMPT) { const float* da = (const float*)(p.ws + WS_DBGACC); rs *= 1.f + sqrtf(da[4] * 1e-4f); }
#endif
            f32x4* yr = (f32x4*)(p.out + (size_t)(m0 + rr) * D_MODEL) + lane;
#pragma unroll
            for (int j = 0; j < 4; ++j) __builtin_nontemporal_store(h[rr][j] * rs * gv[j], yr + 64 * j);
        }
    }
}

#ifdef DBG_CMP
__device__ __forceinline__ void nv_attn(const Params& p, LAS unsigned char* lds, bf16_t* mixed) {
    const int wave = threadIdx.x >> 6, lane = threadIdx.x & 63;
    LAS float* bd = (LAS float*)lds;
    LAS float* qs = (LAS float*)(lds + 4096 + wave * 11264);
    LAS int* lst = (LAS int*)(qs + 512);
    LAS float* pl = (LAS float*)(lst + 256);
    const bf16_t* proj = (const bf16_t*)(p.ws + WS_PROJ); const unsigned* mask = (const unsigned*)(p.ws + WS_MASK);
    for (int i = threadIdx.x; i < 1024; i += NTHR) bd[i] = p.rel_table[(int)c_bucket[i >> 3] * 8 + (i & 7)];
    for (int base = blockIdx.x * NWAVES; base < MPROMPT; base += gridDim.x * NWAVES) {
        const int r = base + wave, b = r >> 11, t = r & (SEQ - 1);
        const bf16_t* qrow = proj + (size_t)r * NP + C_Q;
        for (int i = lane; i < 512; i += 64) qs[i] = bf2f(qrow[i]) * 0.125f;
        const unsigned word = mask[(size_t)r * 64 + lane];
        const int cnt = __popc(word);
        int pos = wave_excl_scan_i(cnt, lane);
        const int nsel = wave_sum_i(cnt);
        { unsigned w = word; while (w) { const int j = __ffs(w) - 1; lst[pos++] = 32 * lane + j; w &= w - 1u; } }
        __syncthreads();
        for (int i = lane; i < nsel; i += 64) {
            const int s = lst[i]; int dn = t - s; dn = dn > 127 ? 127 : dn;
            for (int g = 0; g < 2; ++g) {
                const u32x4* krow = (const u32x4*)(proj + (size_t)(b * SEQ + s) * NP + C_K + g * 64);
                float kf[64];
#pragma unroll
                for (int c = 0; c < 8; ++c) unpack8(krow[c], kf + 8 * c);
                for (int hh = 0; hh < 4; ++hh) {
                    const int h = g * 4 + hh; float dot = 0.f;
#pragma unroll
                    for (int d = 0; d < 64; ++d) dot += qs[h * 64 + d] * kf[d];
                    pl[h * 256 + i] = dot + bd[dn * 8 + h];
                }
            }
        }
        __syncthreads();
        for (int h = 0; h < 8; ++h) {
            float m = -3.0e38f;
            for (int i = lane; i < nsel; i += 64) m = fmaxf(m, pl[h * 256 + i]);
            m = wave_max(m);
            float sum = 0.f;
            for (int i = lane; i < nsel; i += 64) { const float e = __expf(pl[h * 256 + i] - m); pl[h * 256 + i] = e; sum += e; }
            const float inv = 1.f / wave_sum(sum);
            for (int i = lane; i < nsel; i += 64) pl[h * 256 + i] *= inv;
        }
        __syncthreads();
        for (int g = 0; g < 2; ++g) {
            float acc0 = 0.f, acc1 = 0.f, acc2 = 0.f, acc3 = 0.f;
            for (int i = 0; i < nsel; ++i) {
                const int s = lst[i];
                const float v = bf2f(proj[(size_t)(b * SEQ + s) * NP + C_V + g * 64 + lane]);
                acc0 += pl[(g * 4 + 0) * 256 + i] * v; acc1 += pl[(g * 4 + 1) * 256 + i] * v; acc2 += pl[(g * 4 + 2) * 256 + i] * v; acc3 += pl[(g * 4 + 3) * 256 + i] * v;
            }
            const bf16_t* zr = proj + (size_t)r * NP + C_ZA + g * 256 + lane; bf16_t* mr = mixed + (size_t)r * D_MODEL + g * 256 + lane;
            mr[0] = (bf16_t)f2bf(acc0 * silu_f(bf2f(zr[0]))); mr[64] = (bf16_t)f2bf(acc1 * silu_f(bf2f(zr[64])));
            mr[128] = (bf16_t)f2bf(acc2 * silu_f(bf2f(zr[128]))); mr[192] = (bf16_t)f2bf(acc3 * silu_f(bf2f(zr[192])));
        }
        __syncthreads();
    }
}

#endif
template <int MODE>
__device__ __forceinline__ void nv_gdn_unit(const Params& p, LAS unsigned char* lds, int unit, bf16_t* mixed, float* So) {
    LAS float* qkv_s = (LAS float*)lds;
    LAS float* red = qkv_s + 384;
    LAS float* sc = red + 1024;
    int tid = threadIdx.x; asm volatile("" : "+v"(tid)); const int lane = tid & 63, wave = tid >> 6;
    const int b = unit >> 2, h = unit & 3;
    const int T = MODE ? 1 : SEQ; const int row0 = MODE ? MPROMPT + b : b * SEQ;
    const int e = tid & 127, sl = tid >> 7;
    const bf16_t* proj = (const bf16_t*)(p.ws + WS_PROJ); const float* aux = (const float*)(p.ws + WS_AUX);
    float S[32];
#pragma unroll
    for (int i = 0; i < 32; ++i) S[i] = MODE ? p.state_ssm[((size_t)(b * 4 + h) * 128 + sl * 32 + i) * 128 + e] : 0.f;
    const int part = tid >> 7, ci = tid & 127, c = part * 512 + h * 128 + ci;
    float w0 = 0.f, w1 = 0.f, w2 = 0.f, w3 = 0.f, x0 = 0.f, x1 = 0.f, x2 = 0.f;
    if (tid < 384) {
        w0 = p.conv_w[0 * 1536 + c]; w1 = p.conv_w[1 * 1536 + c]; w2 = p.conv_w[2 * 1536 + c]; w3 = p.conv_w[3 * 1536 + c];
        if (MODE) { x0 = p.state_conv[((size_t)b * 3 + 0) * 1536 + c]; x1 = p.state_conv[((size_t)b * 3 + 1) * 1536 + c]; x2 = p.state_conv[((size_t)b * 3 + 2) * 1536 + c]; }
    }
    const float A = __expf(p.a_log[h]), dtb = p.dt_bias[h], gn = p.gdn_norm[e];
    for (int t = 0; t < T; ++t) {
        const size_t r = (size_t)(row0 + t);
        if (tid < 384) {
            float x3;
            if (MODE) x3 = p.out[O_CS + ((size_t)b * 3 + 2) * 1536 + c];
            else x3 = bf2f(proj[r * NP + C_QKV + c]);
            const float y = x0 * w0 + x1 * w1 + x2 * w2 + x3 * w3;
            x0 = x1; x1 = x2; x2 = x3;
            qkv_s[tid] = silu_f(y);
        }
        __syncthreads();
        if (wave == 0) { const float a = qkv_s[lane], a2 = qkv_s[lane + 64]; const float s = wave_sum(a * a + a2 * a2); if (lane == 0) sc[0] = s; }
        else if (wave == 1) { const float a = qkv_s[128 + lane], a2 = qkv_s[192 + lane]; const float s = wave_sum(a * a + a2 * a2); if (lane == 0) sc[1] = s; }
        else if (wave == 2) { const float s = wave_sum(qkv_s[lane] * qkv_s[128 + lane] + qkv_s[lane + 64] * qkv_s[192 + lane]); if (lane == 0) sc[2] = s; }
        __syncthreads();
        const float qn = rsqrtf(sc[0] + 1e-6f) * 0.08838834764831845f, kn = rsqrtf(sc[1] + 1e-6f), qk = sc[2] * qn * kn;
        const float ag = aux[r * AUXP + 16 + h], bg = aux[r * AUXP + 20 + h];
        const float xg = ag + dtb;
        const float sp = xg > 20.f ? xg : log1pf(__expf(xg));
        const float dec = __expf(-A * sp), beta = 1.f / (1.f + __expf(-bg));
        float pk = 0.f, pq = 0.f;
#pragma unroll
        for (int i = 0; i < 32; ++i) { const int d = sl * 32 + i; S[i] *= dec; pk += qkv_s[128 + d] * S[i]; pq += qkv_s[d] * S[i]; }
        red[sl * 128 + e] = pk * kn; red[512 + sl * 128 + e] = pq * qn;
        __syncthreads();
        const float kv = (red[e] + red[128 + e]) + (red[256 + e] + red[384 + e]);
        const float qS = (red[512 + e] + red[640 + e]) + (red[768 + e] + red[896 + e]);
        const float delta = (qkv_s[256 + e] - kv) * beta;
        const float o = qS + qk * delta;
#pragma unroll
        for (int i = 0; i < 32; ++i) { const int d = sl * 32 + i; S[i] += qkv_s[128 + d] * kn * delta; }
        if (sl == 0) { const float s = wave_sum(o * o); if (lane == 0) sc[4 + wave] = s; }
        __syncthreads();
        if (sl == 0) {
            const float rs = rsqrtf((sc[4] + sc[5]) * (1.f / 128.f) + 1e-6f);
            const float z = bf2f(proj[r * NP + C_ZG + h * 128 + e]);
            mixed[r * D_MODEL + 512 + h * 128 + e] = (bf16_t)f2bf(o * rs * gn * silu_f(z));
        }
    }
#pragma unroll
    for (int i = 0; i < 32; ++i) So[((size_t)(b * 4 + h) * 128 + sl * 32 + i) * 128 + e] = S[i];
    __syncthreads();
}

typedef _Float16 half_t;
constexpr int SCP = 2048;
constexpr int DSA_MK_OFF = 32 * SCP * 2;
__device__ __forceinline__ bf16x8 pack8_scaled(const u32x4 raw, float sc) {
    float f[8]; unpack8(raw, f);
    u32x4 o; o.x = pk2(f[0] * sc, f[1] * sc); o.y = pk2(f[2] * sc, f[3] * sc); o.z = pk2(f[4] * sc, f[5] * sc); o.w = pk2(f[6] * sc, f[7] * sc);
    return __builtin_bit_cast(bf16x8, o);
}
constexpr int DSA_KV_OFF = 81920;
struct IdxPre { u32x4 raw[4][2]; float aw[4]; };
__device__ __forceinline__ void dsa_idx_pre_load(const Params& p, int b, int qb, IdxPre& a) {
    int tid = threadIdx.x; asm volatile("" : "+v"(tid)); const int lane = tid & 63, wave = __builtin_amdgcn_readfirstlane(tid >> 6);
    const int qh = wave & 1, kr = wave >> 1, q = lane & 15, g = lane >> 4;
    const bf16_t* proj = (const bf16_t*)(p.ws + WS_PROJ); const float* aux = (const float*)(p.ws + WS_AUX);
    const size_t qrow = (size_t)(b * SEQ + qb * 32 + 16 * qh + q);
#pragma unroll
    for (int hh = 0; hh < 4; ++hh) {
        const int h = 4 * kr + hh;
        a.aw[hh] = aux[qrow * AUXP + h];
#pragma unroll
        for (int s = 0; s < 2; ++s) a.raw[hh][s] = *(const u32x4*)(proj + qrow * NP + C_QI + h * 64 + 32 * s + 8 * g);
    }
}
__device__ __forceinline__ void dsa_idx_pre_store(LAS unsigned char* lds, const IdxPre& a) {
    int tid = threadIdx.x; asm volatile("" : "+v"(tid)); const int lane = tid & 63, wave = __builtin_amdgcn_readfirstlane(tid >> 6);
    const int qh = wave & 1, kr = wave >> 1;
    LAS unsigned char* QS = lds;
    LAS u32x4* QP = (LAS u32x4*)(lds + 65536);
    float ql[2][8];
#pragma unroll
    for (int s = 0; s < 2; ++s)
#pragma unroll
        for (int j = 0; j < 8; ++j) ql[s][j] = 0.f;
#pragma unroll
    for (int hh = 0; hh < 4; ++hh) {
        const int h = 4 * kr + hh;
        const float aw = a.aw[hh] * (1.f / 64.f);
#pragma unroll
        for (int s = 0; s < 2; ++s) {
            float f[8]; unpack8(a.raw[hh][s], f);
#pragma unroll
            for (int j = 0; j < 8; ++j) { f[j] *= aw; ql[s][j] += f[j]; }
            u32x4 o; o.x = pk2(f[0], f[1]); o.y = pk2(f[2], f[3]); o.z = pk2(f[4], f[5]); o.w = pk2(f[6], f[7]);
            *(LAS u32x4*)(QS + ((((qh * 16 + h) * 2 + s) * 64 + lane) * 16)) = o;
        }
    }
#pragma unroll
    for (int s = 0; s < 2; ++s) { u32x4 o; o.x = pk2(ql[s][0], ql[s][1]); o.y = pk2(ql[s][2], ql[s][3]); o.z = pk2(ql[s][4], ql[s][5]); o.w = pk2(ql[s][6], ql[s][7]); QP[((qh * 4 + kr) * 2 + s) * 64 + lane] = o; }
}
__device__ __forceinline__ void dsa_idx_unit(const Params& p, LAS unsigned char* lds, int b, int qb, bool prebuilt) {
    int tid = threadIdx.x; asm volatile("" : "+v"(tid)); const int lane = tid & 63, wave = __builtin_amdgcn_readfirstlane(tid >> 6);
    const int t0 = qb * 32, qh = wave & 1, kr = wave >> 1, q = lane & 15, g = lane >> 4;
    LAS unsigned short* SC = (LAS unsigned short*)lds;
    LAS unsigned* MK = (LAS unsigned*)(lds + DSA_MK_OFF);
    const bf16_t* proj = (const bf16_t*)(p.ws + WS_PROJ); const float* aux = (const float*)(p.ws + WS_AUX); unsigned* mask = (unsigned*)(p.ws + WS_MASK);
    if (qb >= 8) {
        const size_t qrow = (size_t)(b * SEQ + t0 + 16 * qh + q);
        bf16x8 Qf[16][2], QL[2]; float sgf[16];
        {
            const LAS unsigned char* QS = lds; const LAS u32x4* QP = (const LAS u32x4*)(lds + 65536);
            if (!prebuilt) { IdxPre ip; dsa_idx_pre_load(p, b, qb, ip); dsa_idx_pre_store(lds, ip); }
            __syncthreads();
#pragma unroll
            for (int h = 0; h < 16; ++h) {
                sgf[h] = aux[qrow * AUXP + h] < 0.f ? -1.f : 1.f;
#pragma unroll
                for (int s = 0; s < 2; ++s) Qf[h][s] = *(const LAS bf16x8*)(QS + ((((qh * 16 + h) * 2 + s) * 64 + lane) * 16));
            }
#pragma unroll
            for (int s = 0; s < 2; ++s) {
                float t[8], f[8];
                unpack8(QP[((qh * 4 + 0) * 2 + s) * 64 + lane], t);
#pragma unroll
                for (int k2 = 1; k2 < 4; ++k2) { unpack8(QP[((qh * 4 + k2) * 2 + s) * 64 + lane], f);
#pragma unroll
                    for (int j = 0; j < 8; ++j) t[j] += f[j]; }
                u32x4 o; o.x = pk2(t[0], t[1]); o.y = pk2(t[2], t[3]); o.z = pk2(t[4], t[5]); o.w = pk2(t[6], t[7]); QL[s] = __builtin_bit_cast(bf16x8, o);
            }
            __syncthreads();
        }
        const int nkt = 2 * qb + 1 + qh;
        const bf16_t* kbase = proj + (size_t)(b * SEQ + q) * NP + C_KI + 8 * g;
        bf16x8 A0 = {}, A1 = {}, B0 = {}, B1 = {}, C0 = {}, C1 = {};
        { const bf16_t* kp = kbase + (size_t)(16 * kr) * NP;
          A0 = *(const bf16x8*)kp; A1 = *(const bf16x8*)(kp + 32);
          B0 = *(const bf16x8*)(kp + (size_t)64 * NP); B1 = *(const bf16x8*)(kp + (size_t)64 * NP + 32); }
        auto tile = [&](const bf16x8& U0, const bf16x8& U1, bf16x8& L0, bf16x8& L1, const int kt) __attribute__((always_inline)) {
            { const int kl = kt + 8 < nkt ? kt + 8 : nkt - 1;
              const bf16_t* kp = kbase + (size_t)(16 * kl) * NP; L0 = *(const bf16x8*)kp; L1 = *(const bf16x8*)(kp + 32); }
            f32x4 acA[4], acB[4];
            float s0 = 0.f, s1 = 0.f, s2 = 0.f, s3 = 0.f;
#define IDX_SB __builtin_amdgcn_sched_barrier(0)
#define IDX_M(AC, G, J) do { if ((((J)) & 1) == 0) { const f32x4 z_ = {0.f, 0.f, 0.f, 0.f}; AC[(J) >> 1] = __builtin_amdgcn_mfma_f32_16x16x32_bf16(U0, Qf[4 * (G) + ((J) >> 1)][0], z_, 0, 0, 0); } \
                             else AC[(J) >> 1] = __builtin_amdgcn_mfma_f32_16x16x32_bf16(U1, Qf[4 * (G) + ((J) >> 1)][1], AC[(J) >> 1], 0, 0, 0); IDX_SB; } while (0)
#define IDX_F(AC, G, J) do { if ((((J)) & 1) == 0) asm volatile("v_fma_f32 %0, |%2|, %4, %0\n\tv_fma_f32 %1, |%3|, %4, %1" : "+v"(s0), "+v"(s1) : "v"(AC[(J) >> 1][0]), "v"(AC[(J) >> 1][1]), "v"(sgf[4 * (G) + ((J) >> 1)])); \
                             else asm volatile("v_fma_f32 %0, |%2|, %4, %0\n\tv_fma_f32 %1, |%3|, %4, %1" : "+v"(s2), "+v"(s3) : "v"(AC[(J) >> 1][2]), "v"(AC[(J) >> 1][3]), "v"(sgf[4 * (G) + ((J) >> 1)])); IDX_SB; } while (0)
            IDX_SB;
#pragma unroll
            for (int j = 0; j < 8; ++j) IDX_M(acA, 0, j);
#pragma unroll
            for (int j = 0; j < 8; ++j) { IDX_M(acB, 1, j); IDX_F(acA, 0, j); }
#pragma unroll
            for (int j = 0; j < 8; ++j) { IDX_M(acA, 2, j); IDX_F(acB, 1, j); }
#pragma unroll
            for (int j = 0; j < 8; ++j) { IDX_M(acB, 3, j); IDX_F(acA, 2, j); }
            f32x4 lin = {0.f, 0.f, 0.f, 0.f};
            lin = __builtin_amdgcn_mfma_f32_16x16x32_bf16(U0, QL[0], lin, 0, 0, 0); IDX_SB;
            lin = __builtin_amdgcn_mfma_f32_16x16x32_bf16(U1, QL[1], lin, 0, 0, 0); IDX_SB;
            asm volatile("s_nop 7"); IDX_SB;
#pragma unroll
            for (int j = 0; j < 8; ++j) IDX_F(acB, 3, j);
#undef IDX_M
#undef IDX_F
#undef IDX_SB
            const f32x2 sc01 = {lin[0] + s0, lin[1] + s1}, sc23 = {lin[2] + s2, lin[3] + s3};
            unsigned short hv[4] = {__builtin_bit_cast(unsigned short, (half_t)sc01[0]), __builtin_bit_cast(unsigned short, (half_t)sc01[1]), __builtin_bit_cast(unsigned short, (half_t)sc23[0]), __builtin_bit_cast(unsigned short, (half_t)sc23[1])};
            if (kt == 2 * qb + qh) {
#pragma unroll
                for (int e = 0; e < 4; ++e) hv[e] = (4 * g + e > q) ? (unsigned short)0xFC00u : hv[e];
            }
            unsigned lo = (unsigned)hv[0] | ((unsigned)hv[1] << 16), hi = (unsigned)hv[2] | ((unsigned)hv[3] << 16);
            lo ^= (((lo >> 15) & 0x00010001u) * 0xFFFFu) | 0x80008000u; hi ^= (((hi >> 15) & 0x00010001u) * 0xFFFFu) | 0x80008000u;
            *(LAS unsigned long long*)(SC + (16 * qh + q) * SCP + 16 * kt + 4 * g) = (unsigned long long)lo | ((unsigned long long)hi << 32);
        };
        if (wave >= 4) __builtin_amdgcn_s_sleep(7);
        for (int kt = kr;;) {
            tile(A0, A1, C0, C1, kt); kt += 4; if (kt >= nkt) break;
            tile(B0, B1, A0, A1, kt); kt += 4; if (kt >= nkt) break;
            tile(C0, C1, B0, B1, kt); kt += 4; if (kt >= nkt) break;
        }
        if (qh == 0 && kr == ((2 * qb + 1) & 3)) *(LAS unsigned long long*)(SC + q * SCP + 16 * (2 * qb + 1) + 4 * g) = 0x03FF03FF03FF03FFull;
    }
    __syncthreads();
}
__device__ __forceinline__ void dsa_select_unit(const Params& p, LAS unsigned char* lds, int b, int qb) {
    int tid = threadIdx.x; asm volatile("" : "+v"(tid)); const int lane = tid & 63, wave = __builtin_amdgcn_readfirstlane(tid >> 6);
    const int t0 = qb * 32;
    LAS unsigned short* SC = (LAS unsigned short*)lds;
    LAS unsigned* MK = (LAS unsigned*)(lds + DSA_MK_OFF);
    unsigned* mask = (unsigned*)(p.ws + WS_MASK); (void)mask; (void)b;
    if (t0 < 256) {
#pragma unroll
        for (int qi = 0; qi < 4; ++qi) {
            const int ql = wave * 4 + qi, nv = t0 + ql + 1 - 32 * lane;
            MK[ql * 65 + lane] = nv >= 32 ? 0xffffffffu : (nv <= 0 ? 0u : ((1u << nv) - 1u));
#ifdef DBG_CMP
            mask[(size_t)(b * SEQ + t0 + ql) * 64 + lane] = MK[ql * 65 + lane];
#endif
        }
    } else {
        const bool lv = lane <= qb;
        auto load_planes = [&](const int ql, unsigned (&kp)[16]) __attribute__((always_inline)) {
            const LAS u32x4* src = (const LAS u32x4*)(SC + ql * SCP + 32 * lane);
#pragma unroll
            for (int c = 0; c < 4; ++c) {
                const u32x4 v = src[c];
#pragma unroll
                for (int e = 0; e < 4; ++e) kp[4 * c + e] = lv ? v[e] : 0u;
            }
#define SEL_TSTEP(J, M) _Pragma("unroll") for (int k = 0; k < 16; ++k) if (!(k & (J))) { const unsigned t = ((kp[k] >> (J)) ^ kp[k + (J)]) & (M); kp[k + (J)] ^= t; kp[k] ^= t << (J); }
#pragma unroll
            for (int k = 0; k < 8; ++k) { const unsigned a = kp[k], bb = kp[k + 8]; kp[k] = __builtin_amdgcn_perm(bb, a, 0x06020400u); kp[k + 8] = __builtin_amdgcn_perm(bb, a, 0x07030501u); }
            SEL_TSTEP(4, 0x0F0F0F0Fu) SEL_TSTEP(2, 0x33333333u) SEL_TSTEP(1, 0x55555555u)
#undef SEL_TSTEP
        };
        auto shuf = [](unsigned x) -> unsigned {
            unsigned t = (x ^ (x >> 8)) & 0x0000FF00u; x = x ^ t ^ (t << 8);
            t = (x ^ (x >> 4)) & 0x00F000F0u; x = x ^ t ^ (t << 4);
            t = (x ^ (x >> 2)) & 0x0C0C0C0Cu; x = x ^ t ^ (t << 2);
            t = (x ^ (x >> 1)) & 0x22222222u; x = x ^ t ^ (t << 1);
            return x;
        };
#pragma unroll 1
        for (int pp = 0; pp < 2; ++pp) {
            const int ql0 = wave * 4 + 2 * pp, ql1 = ql0 + 1;
            unsigned kp0[16], kp1[16];
            load_planes(ql0, kp0); load_planes(ql1, kp1);
            unsigned alive0 = 0xFFFFFFFFu, gt0 = 0u, alive1 = 0xFFFFFFFFu, gt1 = 0u; int cnt0 = 0, cnt1 = 0;
#pragma unroll
            for (int bit = 15; bit >= 0; --bit) {
                const unsigned x0 = alive0 & kp0[bit], x1 = alive1 & kp1[bit];
                const int tot = __builtin_amdgcn_readlane(wave_incl_scan_dpp((int)((unsigned)__popc(x0) | ((unsigned)__popc(x1) << 16))), 63);
                const int tot0 = tot & 0xffff, tot1 = (int)((unsigned)tot >> 16);
                const bool one0 = cnt0 + tot0 >= 256, one1 = cnt1 + tot1 >= 256;
                const unsigned nsel0 = one0 ? 0u : 0xFFFFFFFFu, nsel1 = one1 ? 0u : 0xFFFFFFFFu;
                gt0 |= x0 & nsel0; gt1 |= x1 & nsel1;
                alive0 &= kp0[bit] ^ nsel0; alive1 &= kp1[bit] ^ nsel1;
                cnt0 += one0 ? 0 : tot0; cnt1 += one1 ? 0 : tot1;
            }
            const unsigned wgt0 = shuf(gt0), wgt1 = shuf(gt1);
            unsigned weq0 = shuf(alive0), weq1 = shuf(alive1);
            const int ceq0 = __popc(weq0), ceq1 = __popc(weq1);
            const unsigned sc2 = (unsigned)wave_incl_scan_dpp((int)((unsigned)ceq0 | ((unsigned)ceq1 << 16)));
            int take0 = (256 - cnt0) - ((int)(sc2 & 0xffffu) - ceq0), take1 = (256 - cnt1) - ((int)(sc2 >> 16) - ceq1);
            unsigned word0 = wgt0, word1 = wgt1;
            if (take0 >= ceq0) word0 |= weq0;
            else { while (take0 > 0) { const unsigned bl = weq0 & (0u - weq0); word0 |= bl; weq0 ^= bl; --take0; } }
            if (take1 >= ceq1) word1 |= weq1;
            else { while (take1 > 0) { const unsigned bl = weq1 & (0u - weq1); word1 |= bl; weq1 ^= bl; --take1; } }
            MK[ql0 * 65 + lane] = word0; MK[ql1 * 65 + lane] = word1;
#ifdef DBG_CMP
            mask[(size_t)(b * SEQ + t0 + ql0) * 64 + lane] = word0; mask[(size_t)(b * SEQ + t0 + ql1) * 64 + lane] = word1;
#endif
        }
    }
    __syncthreads();
}
typedef float f32x16 __attribute__((ext_vector_type(16)));
typedef short s16x4 __attribute__((ext_vector_type(4)));
constexpr int KVP = 272, KVT = 32 * KVP;
constexpr int DSA_BD_OFF = DSA_MK_OFF + 32 * 65 * 4;
static_assert(DSA_BD_OFF + 8 * 128 * 4 <= SCR_BYTES, "LDS map");
__device__ __forceinline__ float max3f(float a, float b, float c) { float r; asm("v_max3_f32 %0, %1, %2, %3" : "=v"(r) : "v"(a), "v"(b), "v"(c)); return r; }
template <int POS> __device__ __forceinline__ float mask_bit(float v, int w) {
    int m; asm("v_bfe_i32 %0, %1, %2, 1" : "=v"(m) : "v"(w), "n"(POS)); return __builtin_bit_cast(float, __builtin_bit_cast(int, v) & m);
}
__device__ __forceinline__ void swap32(float& a, float& b) { asm volatile("s_nop 1\n\tv_permlane32_swap_b32 %0, %1\n\ts_nop 1" : "+v"(a), "+v"(b)); }
__device__ __forceinline__ s16x4 tr16(const LAS unsigned char* p) { return __builtin_bit_cast(s16x4, __builtin_amdgcn_ds_read_tr16_b64_v4i16((LAS s16x4*)p)); }
__device__ __forceinline__ void dsa_fill_bias(const Params& p, LAS unsigned char* lds) {
    LAS float* BD = (LAS float*)(lds + DSA_BD_OFF);
    for (int i = threadIdx.x; i < 1024; i += NTHR) { const int h = i >> 7, n = i & 127; BD[i] = p.rel_table[(int)c_bucket[n] * 8 + h] * 1.4426950408889634f; }
    __syncthreads();
}
struct AttnPre { bf16x8 Qf[4]; u32x4 t0v, t1v, sa0, sa1, sb0, sb1; };
__device__ __forceinline__ void dsa_attn_pre(const Params& p, int b, int qb, AttnPre& a) {
    int tid = threadIdx.x; asm volatile("" : "+v"(tid)); const int lane = tid & 63, wave = __builtin_amdgcn_readfirstlane(tid >> 6);
    const int r = lane & 31, hh = lane >> 5, t0 = qb * 32, nkt = qb + 1;
    const bf16_t* proj = (const bf16_t*)(p.ws + WS_PROJ);
    const size_t qrow = (size_t)(b * SEQ + t0 + r);
#pragma unroll
    for (int s = 0; s < 4; ++s) a.Qf[s] = *(const bf16x8*)(proj + qrow * NP + C_Q + wave * 64 + 16 * s + 8 * hh);
    const int skey = tid >> 4, sch = tid & 15;
    const bf16_t* sbase = proj + (size_t)(b * SEQ + skey) * NP + C_K + 16 * sch;
    a.t0v = *(const u32x4*)sbase; a.t1v = *(const u32x4*)(sbase + 8);
    { const bf16_t* sp = sbase + (size_t)(32 * (1 < nkt ? 1 : nkt - 1)) * NP; a.sa0 = *(const u32x4*)sp; a.sa1 = *(const u32x4*)(sp + 8); }
    { const bf16_t* sp = sbase + (size_t)(32 * (2 < nkt ? 2 : nkt - 1)) * NP; a.sb0 = *(const u32x4*)sp; a.sb1 = *(const u32x4*)(sp + 8); }
}
__device__ __forceinline__ void dsa_attn_stage(const Params& p, LAS unsigned char* lds, int b, int qb, const AttnPre& pre) {
    int tid = threadIdx.x; asm volatile("" : "+v"(tid)); const int lane = tid & 63, wave = __builtin_amdgcn_readfirstlane(tid >> 6);
    const int g = wave >> 2, r = lane & 31, hh = lane >> 5, t0 = qb * 32;
    const LAS unsigned* MK = (const LAS unsigned*)(lds + DSA_MK_OFF);
    const LAS float* BD = (const LAS float*)(lds + DSA_BD_OFF) + wave * 128;
    const bf16_t* proj = (const bf16_t*)(p.ws + WS_PROJ); bf16_t* mixed = (bf16_t*)(p.ws + WS_MIXED);
    const size_t qrow = (size_t)(b * SEQ + t0 + r);
    bf16x8 Qf[4];
#pragma unroll
    for (int s = 0; s < 4; ++s) Qf[s] = pre.Qf[s];
    f32x16 O0, O1;
#pragma unroll
    for (int i = 0; i < 16; ++i) { O0[i] = 0.f; O1[i] = 0.f; }
    float m = 0.f, l = 0.f;
    const float c31 = BD[127];
    const int nkt = qb + 1, qpos = t0 + r;
    const int skey = tid >> 4, sch = tid & 15;
    const bf16_t* sbase = proj + (size_t)(b * SEQ + skey) * NP + C_K + 16 * sch;
    const unsigned sdst = (unsigned)(skey * KVP + (sch & 7) * 32 + (sch >> 3) * KVT);
    u32x4 sa0 = pre.sa0, sa1 = pre.sa1, sb0 = pre.sb0, sb1 = pre.sb1, sc0 = {}, sc1 = {};
    LAS unsigned char* kvb = lds + DSA_KV_OFF;
    *(LAS u32x4*)(kvb + sdst) = pre.t0v; *(LAS u32x4*)(kvb + sdst + 16) = pre.t1v;
    __syncthreads();
    const int i16 = lane & 15, G1 = (lane >> 4) & 1;
    const unsigned vlane = (unsigned)((4 * hh + (i16 >> 2)) * KVP + g * 128 + (16 * G1 + 4 * (i16 & 3)) * 2);
    const unsigned klane = (unsigned)(r * KVP + g * 128 + hh * 16);
    auto tile = [&](const int kt, const u32x4& W0, const u32x4& W1, u32x4& L0, u32x4& L1) __attribute__((always_inline)) {
        const int cur = kt & 1;
        { const bf16_t* sp = sbase + (size_t)(32 * (kt + 3 < nkt ? kt + 3 : nkt - 1)) * NP; L0 = *(const u32x4*)sp; L1 = *(const u32x4*)(sp + 8); }
        const LAS unsigned char* Kb = kvb + cur * (2 * KVT); const LAS unsigned char* Vb = Kb + KVT;
        f32x16 acc;
#pragma unroll
        for (int i = 0; i < 16; ++i) acc[i] = 0.f;
#pragma unroll
        for (int s = 0; s < 4; ++s) { const bf16x8 Kf = *(const LAS bf16x8*)(Kb + klane + s * 32); acc = __builtin_amdgcn_mfma_f32_32x32x16_bf16(Kf, Qf[s], acc, 0, 0, 0); }
        const int wsh = (int)(MK[r * 65 + kt] >> (4 * hh));
        const int kb0 = 32 * kt + 4 * hh;
        float x[16];
        if (t0 - 32 * kt - 31 >= 113) {
            const float cm = c31 - m;
#pragma unroll
            for (int i = 0; i < 16; ++i) x[i] = acc[i] * 0.18033688011112042f + cm;
        } else {
#pragma unroll
            for (int i = 0; i < 16; ++i) { int d = qpos - (kb0 + (i & 3) + 8 * (i >> 2)); d = d < 0 ? 0 : (d > 127 ? 127 : d); x[i] = acc[i] * 0.18033688011112042f + (BD[d] - m); }
        }
        float tmax = max3f(max3f(max3f(x[0], x[1], x[2]), max3f(x[3], x[4], x[5]), max3f(x[6], x[7], x[8])), max3f(x[9], x[10], x[11]), max3f(max3f(x[12], x[13], x[14]), x[15], x[15]));
        { float ta = tmax, tb = tmax; swap32(ta, tb); tmax = fmaxf(ta, tb); }
        if (!__all(tmax <= 8.f)) {
            const float up = fmaxf(tmax, 0.f), alpha = __builtin_amdgcn_exp2f(-up);
#pragma unroll
            for (int i = 0; i < 16; ++i) { O0[i] *= alpha; O1[i] *= alpha; x[i] -= up; }
            l *= alpha; m += up;
        }
#define PEXP(i) x[i] = mask_bit<((i) & 3) + 8 * ((i) >> 2)>(__builtin_amdgcn_exp2f(x[i]), wsh)
        PEXP(0); PEXP(1); PEXP(2); PEXP(3); PEXP(4); PEXP(5); PEXP(6); PEXP(7); PEXP(8); PEXP(9); PEXP(10); PEXP(11); PEXP(12); PEXP(13); PEXP(14); PEXP(15);
#undef PEXP
        const float ps = ((x[0] + x[1]) + (x[2] + x[3])) + ((x[4] + x[5]) + (x[6] + x[7])) + (((x[8] + x[9]) + (x[10] + x[11])) + ((x[12] + x[13]) + (x[14] + x[15])));
        l += ps;
        u32x4 pw0, pw1;
        pw0.x = pk2(x[0], x[1]); pw0.y = pk2(x[2], x[3]); pw0.z = pk2(x[4], x[5]); pw0.w = pk2(x[6], x[7]);
        pw1.x = pk2(x[8], x[9]); pw1.y = pk2(x[10], x[11]); pw1.z = pk2(x[12], x[13]); pw1.w = pk2(x[14], x[15]);
        const bf16x8 P0 = __builtin_bit_cast(bf16x8, pw0), P1 = __builtin_bit_cast(bf16x8, pw1);
#pragma unroll
        for (int s = 0; s < 2; ++s) {
            const bf16x8 Ps = s ? P1 : P0;
#pragma unroll
            for (int c = 0; c < 2; ++c) {
                const s16x4 lo = tr16(Vb + vlane + (16 * s) * KVP + c * 64), hi = tr16(Vb + vlane + (16 * s + 8) * KVP + c * 64);
                const bf16x8 Vf = (bf16x8){lo[0], lo[1], lo[2], lo[3], hi[0], hi[1], hi[2], hi[3]};
                if (c == 0) O0 = __builtin_amdgcn_mfma_f32_32x32x16_bf16(Vf, Ps, O0, 0, 0, 0);
                else O1 = __builtin_amdgcn_mfma_f32_32x32x16_bf16(Vf, Ps, O1, 0, 0, 0);
            }
        }
        { LAS unsigned char* d = kvb + (cur ^ 1) * (2 * KVT) + sdst; *(LAS u32x4*)d = W0; *(LAS u32x4*)(d + 16) = W1; }
        __syncthreads();
    };
    for (int kt = 0;;) {
        tile(kt, sa0, sa1, sc0, sc1); if (++kt >= nkt) break;
        tile(kt, sb0, sb1, sa0, sa1); if (++kt >= nkt) break;
        tile(kt, sc0, sc1, sb0, sb1); if (++kt >= nkt) break;
    }
    { float la = l, lb = l; swap32(la, lb); l = la + lb; }
    const float inv = __builtin_amdgcn_rcpf(l);
#pragma unroll
    for (int c = 0; c < 2; ++c)
#pragma unroll
        for (int rg = 0; rg < 4; ++rg) {
            const int d0 = 32 * c + 8 * rg + 4 * hh;
            const unsigned long long zz = *(const unsigned long long*)(proj + qrow * NP + C_ZA + wave * 64 + d0);
            const float z0 = bf2f((unsigned short)(zz & 0xffff)), z1 = bf2f((unsigned short)((zz >> 16) & 0xffff)), z2 = bf2f((unsigned short)((zz >> 32) & 0xffff)), z3 = bf2f((unsigned short)(zz >> 48));
            const float o0 = (c ? O1[4 * rg] : O0[4 * rg]) * inv, o1 = (c ? O1[4 * rg + 1] : O0[4 * rg + 1]) * inv, o2 = (c ? O1[4 * rg + 2] : O0[4 * rg + 2]) * inv, o3 = (c ? O1[4 * rg + 3] : O0[4 * rg + 3]) * inv;
            const unsigned long long w = (unsigned long long)pk2(o0 * silu_f(z0), o1 * silu_f(z1)) | ((unsigned long long)pk2(o2 * silu_f(z2), o3 * silu_f(z3)) << 32);
            *(unsigned long long*)(mixed + qrow * D_MODEL + wave * 64 + d0) = w;
        }
}
__device__ __forceinline__ void dsa_unit_of(int w, int k, int& b, int& qb) {
    const int u = w + 256 * k; b = u & 31; const int a = (w >> 5) & 7; const int j = 8 * k + ((k & 1) ? 7 - a : a); qb = 63 - j;
}

constexpr int GP = 272, GP64 = 144;
constexpr int IMG_NEGW = 0, IMG_QD = 17408, IMG_KDT = 34816, IMG_AQK = 53248, IMG_BYTES = 65536;
constexpr size_t GDN_UNIT_BYTES = IMG_BYTES + 32768;
__device__ __forceinline__ int kperm(int c) { return (c & ~31) | (((c >> 2) & 3) << 3) | (((c >> 4) & 1) << 2) | (c & 3); }
constexpr int GL_QS = 0, GL_KS = 17408, GL_NEGW = 0, GL_BM = 34816, BMPF = 260, GL_KDT = 101376, GL_AQK = 119808, GL_MA = 129024, GL_ADT = 138240, GL_DD = 142336, GL_GT = 144384;
static_assert(GL_GT + 768 <= SCR_BYTES && GL_BM + 64 * BMPF * 4 == GL_KDT && GL_KDT + 18432 == GL_AQK && GL_AQK + 9216 == GL_MA && GL_MA + 9216 == GL_ADT && GL_ADT + 4096 == GL_DD && GL_DD + 2048 == GL_GT, "LDS map");
__device__ __forceinline__ bf16x8 pack_acc(const f32x4 a, const f32x4 b) {
    u32x4 w; w.x = pk2(a[0], a[1]); w.y = pk2(a[2], a[3]); w.z = pk2(b[0], b[1]); w.w = pk2(b[2], b[3]);
    return __builtin_bit_cast(bf16x8, w);
}
struct GdnPre { unsigned raw[3][11]; float ag, bg; };
__device__ __forceinline__ void gdn_local_load(const Params& p, int unit, int lane, int wave, GdnPre& q) {
    const int n = unit & 31, bh = unit >> 5, h = bh & 3, b = bh >> 2;
    const bf16_t* proj = (const bf16_t*)(p.ws + WS_PROJ); const float* aux = (const float*)(p.ws + WS_AUX);
#pragma unroll
    for (int part = 0; part < 3; ++part) {
        const int ch = part * 512 + h * 128 + 2 * lane;
#pragma unroll
        for (int i = 0; i < 11; ++i) {
            const int tt = 64 * n + 8 * wave - 3 + i;
            q.raw[part][i] = tt >= 0 ? *(const unsigned*)(proj + (size_t)(b * SEQ + tt) * NP + C_QKV + ch) : 0u;
        }
    }
    const size_t r = (size_t)(b * SEQ + 64 * n + lane);
    q.ag = aux[r * AUXP + 16 + h]; q.bg = aux[r * AUXP + 20 + h];
}
__device__ __forceinline__ void gdn_local_unit(const Params& p, LAS unsigned char* lds, int unit, int next_unit, GdnPre& pre) {
    int tid = threadIdx.x; asm volatile("" : "+v"(tid)); const int lane = tid & 63, wave = __builtin_amdgcn_readfirstlane(tid >> 6);
    const int n = unit & 31, bh = unit >> 5, h = bh & 3, b = bh >> 2;
    const GdnPre cur = pre;
    if (next_unit >= 0) gdn_local_load(p, next_unit, lane, wave, pre);
    const int row0 = b * SEQ + 64 * n;
    LAS float* GT = (LAS float*)(lds + GL_GT);
    LAS float* Bm = (LAS float*)(lds + GL_BM);
    const bf16_t* proj = (const bf16_t*)(p.ws + WS_PROJ); const float* aux = (const float*)(p.ws + WS_AUX);
    unsigned char* img = p.ws + WS_GDN + (size_t)unit * GDN_UNIT_BYTES;
    if (wave == 0) {
        const float ag = cur.ag, bg = cur.bg;
        const float xg = ag + p.dt_bias[h];
        const float sp = xg > 20.f ? xg : __logf(1.f + __expf(xg));
        const float gc = wave_incl_scan_f(-__expf(p.a_log[h]) * sp);
        GT[lane] = gc; GT[64 + lane] = __builtin_amdgcn_rcpf(1.f + __expf(-bg)); GT[128 + lane] = __expf(gc);
    }
    __syncthreads();
    {
        float f[3][8][2];
#pragma unroll
        for (int part = 0; part < 3; ++part) {
            const int ch = part * 512 + h * 128 + 2 * lane;
            float w[4][2];
#pragma unroll
            for (int j = 0; j < 4; ++j) { const f32x2 t = *(const f32x2*)(p.conv_w + j * 1536 + ch); w[j][0] = t.x; w[j][1] = t.y; }
            float x[11][2];
#pragma unroll
            for (int i = 0; i < 11; ++i) { const unsigned v = cur.raw[part][i]; x[i][0] = __builtin_bit_cast(float, v << 16); x[i][1] = __builtin_bit_cast(float, v & 0xffff0000u); }
#pragma unroll
            for (int i = 0; i < 8; ++i) {
                const float y0 = x[i][0] * w[0][0] + x[i + 1][0] * w[1][0] + x[i + 2][0] * w[2][0] + x[i + 3][0] * w[3][0];
                const float y1 = x[i][1] * w[0][1] + x[i + 1][1] * w[1][1] + x[i + 2][1] * w[2][1] + x[i + 3][1] * w[3][1];
                f[part][i][0] = silu_f(y0); f[part][i][1] = silu_f(y1);
            }
        }
        const float glast = GT[63];
#pragma unroll
        for (int i = 0; i < 8; ++i) {
            const int t = 8 * wave + i;
            const float qn = rsqrtf(wave_sum_u(f[0][i][0] * f[0][i][0] + f[0][i][1] * f[0][i][1]) + 1e-6f) * 0.08838834764831845f;
            const float kn = rsqrtf(wave_sum_u(f[1][i][0] * f[1][i][0] + f[1][i][1] * f[1][i][1]) + 1e-6f);
            const float gc = GT[t], beta = GT[64 + t], eg = GT[128 + t], egl = __expf(glast - gc);
            const float q0 = f[0][i][0] * qn, q1 = f[0][i][1] * qn, k0 = f[1][i][0] * kn, k1 = f[1][i][1] * kn;
            *(LAS unsigned*)(lds + GL_QS + t * GP + 4 * lane) = pk2(q0, q1);
            *(LAS unsigned*)(lds + GL_KS + t * GP + 4 * lane) = pk2(k0, k1);
            *(LAS f32x2*)(Bm + t * BMPF + 2 * lane) = (f32x2){f[2][i][0] * beta, f[2][i][1] * beta};
            *(LAS f32x2*)(Bm + t * BMPF + 128 + 2 * lane) = (f32x2){k0 * beta * eg, k1 * beta * eg};
            __builtin_nontemporal_store(pk2(q0 * eg, q1 * eg), (unsigned*)(img + IMG_QD + t * GP + 2 * kperm(2 * lane)));
            const int tp = kperm(t);
            const unsigned kd = pk2(k0 * egl, k1 * egl);
            *(LAS unsigned short*)(lds + GL_KDT + (2 * lane) * GP64 + 2 * tp) = (unsigned short)(kd & 0xffffu);
            *(LAS unsigned short*)(lds + GL_KDT + (2 * lane + 1) * GP64 + 2 * tp) = (unsigned short)(kd >> 16);
        }
    }
    __syncthreads();
    {
        const int c = lane & 15, g = lane >> 4;
#pragma unroll
        for (int it = 0; it < 4; ++it) {
            const int idx = wave + 8 * (it & 1), which = it >> 1, mi = idx >> 2, nj = idx & 3;
            const LAS unsigned char* Ab = lds + (which ? GL_QS : GL_KS) + (16 * mi + c) * GP + 16 * g;
            const LAS unsigned char* Bb = lds + GL_KS + (16 * nj + c) * GP + 16 * g;
            f32x4 acc = {0.f, 0.f, 0.f, 0.f};
#pragma unroll
            for (int s2 = 0; s2 < 4; ++s2) acc = __builtin_amdgcn_mfma_f32_16x16x32_bf16(*(const LAS bf16x8*)(Ab + 64 * s2), *(const LAS bf16x8*)(Bb + 64 * s2), acc, 0, 0, 0);
            const int tc = 16 * nj + c; const float gcc = GT[tc];
            f32x4 val;
#pragma unroll
            for (int e = 0; e < 4; ++e) {
                const int t = 16 * mi + 4 * g + e;
                const float dec = __expf(fminf(GT[t] - gcc, 0.f));
                if (which == 0) val[e] = (t > tc) ? GT[64 + t] * acc[e] * dec : 0.f;
                else val[e] = (t >= tc) ? acc[e] * dec : 0.f;
            }
            const int tcp = kperm(tc);
            if (which == 0) {
                if (mi == nj) *(LAS f32x4*)(lds + GL_ADT + ((mi * 16 + c) * 16 + 4 * g) * 4) = val;
#pragma unroll
                for (int e = 0; e < 4; ++e) *(LAS unsigned short*)(lds + GL_MA + (16 * mi + 4 * g + e) * GP64 + 2 * tcp) = (unsigned short)(mi == nj ? 0u : (pk2(-val[e], 0.f) & 0xffffu));
            } else {
#pragma unroll
                for (int e = 0; e < 4; ++e) *(LAS unsigned short*)(lds + GL_AQK + (16 * mi + 4 * g + e) * GP64 + 2 * tcp) = (unsigned short)(pk2(val[e], 0.f) & 0xffffu);
            }
        }
    }
    __syncthreads();
    {
        const int c = lane & 15, g = lane >> 4;
        {
            float T[16];
#pragma unroll
            for (int i = 0; i < 16; ++i) T[i] = (i == c) ? 1.f : 0.f;
            const LAS float* adt = (const LAS float*)(lds + GL_ADT) + g * 256;
#pragma unroll
            for (int j = 0; j < 15; ++j) {
                const float tj = T[j];
#pragma unroll
                for (int q4 = (j + 1) >> 2; q4 < 4; ++q4) {
                    const f32x4 a = *(const LAS f32x4*)(adt + j * 16 + 4 * q4);
                    T[4 * q4] -= a[0] * tj; T[4 * q4 + 1] -= a[1] * tj; T[4 * q4 + 2] -= a[2] * tj; T[4 * q4 + 3] -= a[3] * tj;
                }
            }
            LAS unsigned short* dd = (LAS unsigned short*)(lds + GL_DD) + wave * 0 + g * 256 + c;
#pragma unroll
            for (int i = 0; i < 16; ++i) dd[i * 16] = (unsigned short)(pk2(T[i], 0.f) & 0xffffu);
        }
        LDS_WAIT();
        const f32x4 z4 = {0.f, 0.f, 0.f, 0.f};
#pragma unroll
        for (int j2 = 0; j2 < 2; ++j2) {
            const int nb = 2 * wave + j2;
            f32x4 X[4];
#pragma unroll
            for (int r = 0; r < 4; ++r) {
                f32x4 R;
#pragma unroll
                for (int e = 0; e < 4; ++e) R[e] = Bm[(16 * r + 4 * g + e) * BMPF + 16 * nb + c];
                if (r >= 1) R = __builtin_amdgcn_mfma_f32_16x16x32_bf16(*(const LAS bf16x8*)(lds + GL_MA + (16 * r + c) * GP64 + 16 * g), pack_acc(X[0], r >= 2 ? X[1] : z4), R, 0, 0, 0);
                if (r == 3) R = __builtin_amdgcn_mfma_f32_16x16x32_bf16(*(const LAS bf16x8*)(lds + GL_MA + (16 * r + c) * GP64 + 64 + 16 * g), pack_acc(X[2], z4), R, 0, 0, 0);
                const unsigned long long dq = *(const LAS unsigned long long*)(lds + GL_DD + ((r * 16 + c) * 16 + 4 * g) * 2);
                u32x4 dw; dw.x = (unsigned)dq; dw.y = (unsigned)(dq >> 32); dw.z = 0u; dw.w = 0u;
                X[r] = __builtin_amdgcn_mfma_f32_16x16x32_bf16(__builtin_bit_cast(bf16x8, dw), pack_acc(R, z4), z4, 0, 0, 0);
                if (wave < 4) __builtin_nontemporal_store(X[r], (f32x4*)(img + IMG_BYTES) + (nb * 4 + r) * 64 + lane);
                else {
                    const int cp = kperm(16 * (nb - 8) + c);
#pragma unroll
                    for (int e = 0; e < 4; ++e) *(LAS unsigned short*)(lds + GL_NEGW + (16 * r + 4 * g + e) * GP + 2 * cp) = (unsigned short)(pk2(-X[r][e], 0.f) & 0xffffu);
                }
            }
        }
    }
    __syncthreads();
    for (int i = tid; i < (18432 + 9216 + 17408) / 16; i += NTHR) {
        if (i < 1728) { const u32x4 v = *(const LAS u32x4*)(lds + GL_KDT + 16 * i); if (i < 1152) __builtin_nontemporal_store(v, (u32x4*)(img + IMG_KDT + 16 * i)); else __builtin_nontemporal_store(v, (u32x4*)(img + IMG_AQK + 16 * (i - 1152))); }
        else __builtin_nontemporal_store(*(const LAS u32x4*)(lds + GL_NEGW + 16 * (i - 1728)), (u32x4*)(img + IMG_NEGW + 16 * (i - 1728)));
    }
    if (tid == 0) ((float*)(p.ws + WS_CD))[unit] = GT[128 + 63];
    __syncthreads();
}

constexpr int GS_PS = 2 * IMG_BYTES, GS_RS = GS_PS + 4096;
static_assert(GS_RS + 2048 <= SCR_BYTES, "LDS map");
__device__ __forceinline__ void gdn_seq_unit(const Params& p, LAS unsigned char* lds, int bh, bf16_t* mixed) {
    int tid = threadIdx.x; asm volatile("" : "+v"(tid)); const int lane = tid & 63, wave = __builtin_amdgcn_readfirstlane(tid >> 6);
    const int c = lane & 15, g = lane >> 4, h = bh & 3, b = bh >> 2, col0 = 16 * wave;
    const bf16_t* proj = (const bf16_t*)(p.ws + WS_PROJ);
    const unsigned char* ubase = p.ws + WS_GDN + (size_t)(bh * 32) * GDN_UNIT_BYTES;
    const float* cdp = (const float*)(p.ws + WS_CD) + bh * 32;
    LAS float* RS = (LAS float*)(lds + GS_RS) + wave * 64;
    f32x4 S[8];
#pragma unroll
    for (int rb = 0; rb < 8; ++rb) S[rb] = (f32x4){0.f, 0.f, 0.f, 0.f};
    {
        u32x4 pre[8];
#pragma unroll
        for (int i = 0; i < 8; ++i) pre[i] = __builtin_nontemporal_load((const u32x4*)(ubase + (size_t)(i * 512 + tid) * 16));
#pragma unroll
        for (int i = 0; i < 8; ++i) *(LAS u32x4*)(lds + (i * 512 + tid) * 16) = pre[i];
    }
    const float gnc = p.gdn_norm[col0 + c];
    f32x4 vnN[4]; float cdN; unsigned short zN[16];
    {
        const f32x4* Ug = (const f32x4*)(ubase + IMG_BYTES);
#pragma unroll
        for (int mb = 0; mb < 4; ++mb) vnN[mb] = __builtin_nontemporal_load(Ug + (wave * 4 + mb) * 64 + lane);
        cdN = cdp[0];
#pragma unroll
        for (int i = 0; i < 16; ++i) zN[i] = proj[(size_t)(b * SEQ + 16 * (i >> 2) + 4 * g + (i & 3)) * NP + C_ZG + h * 128 + col0 + c];
    }
    __syncthreads();
    for (int n = 0; n < 32; ++n) {
        const unsigned char* ub = ubase + (size_t)n * GDN_UNIT_BYTES;
        const LAS unsigned char* img = lds + (n & 1) * IMG_BYTES;
        LAS float* PS = (LAS float*)(lds + GS_PS) + (n & 1) * 512;
        u32x4 pre[8];
        f32x4 vn[4], O[4]; unsigned short zc[16];
#pragma unroll
        for (int mb = 0; mb < 4; ++mb) { vn[mb] = vnN[mb]; O[mb] = (f32x4){0.f, 0.f, 0.f, 0.f}; }
#pragma unroll
        for (int i = 0; i < 16; ++i) zc[i] = zN[i];
        const float cd = cdN;
        if (n + 1 < 32) {
#pragma unroll
            for (int i = 0; i < 8; ++i) pre[i] = __builtin_nontemporal_load((const u32x4*)(ub + GDN_UNIT_BYTES + (size_t)(i * 512 + tid) * 16));
            const f32x4* Ug = (const f32x4*)(ub + GDN_UNIT_BYTES + IMG_BYTES);
#pragma unroll
            for (int mb = 0; mb < 4; ++mb) vnN[mb] = __builtin_nontemporal_load(Ug + (wave * 4 + mb) * 64 + lane);
            cdN = cdp[n + 1];
#pragma unroll
            for (int i = 0; i < 16; ++i) zN[i] = proj[(size_t)(b * SEQ + 64 * (n + 1) + 16 * (i >> 2) + 4 * g + (i & 3)) * NP + C_ZG + h * 128 + col0 + c];
        }
        bf16x8 SB[4];
#pragma unroll
        for (int s2 = 0; s2 < 4; ++s2) SB[s2] = pack_acc(S[2 * s2], S[2 * s2 + 1]);
        const LAS unsigned char* a128 = img + c * GP + 16 * g;
        const LAS unsigned char* a64 = img + c * GP64 + 16 * g;
#pragma unroll
        for (int mb = 0; mb < 4; ++mb)
#pragma unroll
            for (int s2 = 0; s2 < 4; ++s2) {
                vn[mb] = __builtin_amdgcn_mfma_f32_16x16x32_bf16(*(const LAS bf16x8*)(a128 + IMG_NEGW + 16 * mb * GP + 64 * s2), SB[s2], vn[mb], 0, 0, 0);
                O[mb] = __builtin_amdgcn_mfma_f32_16x16x32_bf16(*(const LAS bf16x8*)(a128 + IMG_QD + 16 * mb * GP + 64 * s2), SB[s2], O[mb], 0, 0, 0);
            }
        bf16x8 VB[2];
#pragma unroll
        for (int s2 = 0; s2 < 2; ++s2) VB[s2] = pack_acc(vn[2 * s2], vn[2 * s2 + 1]);
#pragma unroll
        for (int mb = 0; mb < 4; ++mb)
#pragma unroll
            for (int s2 = 0; s2 < 2; ++s2) O[mb] = __builtin_amdgcn_mfma_f32_16x16x32_bf16(*(const LAS bf16x8*)(a64 + IMG_AQK + 16 * mb * GP64 + 64 * s2), VB[s2], O[mb], 0, 0, 0);
#pragma unroll
        for (int rb = 0; rb < 8; ++rb) {
            S[rb] = S[rb] * cd;
#pragma unroll
            for (int s2 = 0; s2 < 2; ++s2) S[rb] = __builtin_amdgcn_mfma_f32_16x16x32_bf16(*(const LAS bf16x8*)(a64 + IMG_KDT + 16 * rb * GP64 + 64 * s2), VB[s2], S[rb], 0, 0, 0);
        }
#pragma unroll
        for (int mb = 0; mb < 4; ++mb) {
            f32x4 q;
#pragma unroll
            for (int e = 0; e < 4; ++e) { float t = O[mb][e] * O[mb][e]; t += dpp_z<0x111, 0xf>(t); t += dpp_z<0x112, 0xf>(t); t += dpp_z<0x114, 0xf>(t); t += dpp_z<0x118, 0xf>(t); q[e] = t; }
            if (c == 15) {
#pragma unroll
                for (int e = 0; e < 4; ++e) PS[(16 * mb + 4 * g + e) * 8 + wave] = q[e];
            }
        }
        if (n + 1 < 32) {
            LAS unsigned char* dst = lds + ((n + 1) & 1) * IMG_BYTES;
#pragma unroll
            for (int i = 0; i < 8; ++i) *(LAS u32x4*)(dst + (i * 512 + tid) * 16) = pre[i];
        }
        __syncthreads();
        {
            const f32x4 p0 = *(const LAS f32x4*)(PS + lane * 8), p1 = *(const LAS f32x4*)(PS + lane * 8 + 4);
            const float ss = ((p0[0] + p0[1]) + (p0[2] + p0[3])) + ((p1[0] + p1[1]) + (p1[2] + p1[3]));
            RS[lane] = rsqrtf(ss * (1.f / 128.f) + 1e-6f);
            asm volatile("s_waitcnt lgkmcnt(0)" ::: "memory");
        }
#pragma unroll
        for (int mb = 0; mb < 4; ++mb) {
            const f32x4 rs = *(const LAS f32x4*)(RS + 16 * mb + 4 * g);
#pragma unroll
            for (int e = 0; e < 4; ++e) {
                const size_t r = (size_t)(b * SEQ + 64 * n + 16 * mb + 4 * g + e);
                const float z = bf2f(zc[4 * mb + e]);
                mixed[r * D_MODEL + 512 + h * 128 + col0 + c] = (bf16_t)(pk2(O[mb][e] * rs[e] * gnc * silu_f(z), 0.f) & 0xffffu);
            }
        }
    }
    float* So = p.out + O_SSMP + (size_t)bh * 128 * 128;
#pragma unroll
    for (int rb = 0; rb < 8; ++rb)
#pragma unroll
        for (int e = 0; e < 4; ++e) So[(16 * rb + 4 * g + e) * 128 + col0 + c] = S[rb][e];
    __syncthreads();
}

constexpr int SU_SCS = 0, SU_LST = 32896, SU_PHYS = 33920, SU_EQL = 34944, SU_CNT = 35200, SU_PL = 35456, SU_QA = 43648, SU_RED = 45696;
__device__ __forceinline__ bf16x8 pack8f(const f32x4 a, const f32x4 b) {
    u32x4 w; w.x = pk2(a[0], a[1]); w.y = pk2(a[2], a[3]); w.z = pk2(b[0], b[1]); w.w = pk2(b[2], b[3]);
    return __builtin_bit_cast(bf16x8, w);
}
__device__ __forceinline__ void sample_unit(const Params& p, LAS unsigned char* lds, int b) {
    int tid = threadIdx.x; asm volatile("" : "+v"(tid)); const int lane = tid & 63, wave = __builtin_amdgcn_readfirstlane(tid >> 6);
    LAS float* scs = (LAS float*)(lds + SU_SCS);
    LAS int* lst = (LAS int*)(lds + SU_LST);
    LAS int* phys = (LAS int*)(lds + SU_PHYS);
    LAS int* eql = (LAS int*)(lds + SU_EQL);
    LAS int* cnts = (LAS int*)(lds + SU_CNT);
    LAS float* pl = (LAS float*)(lds + SU_PL);
    LAS float* qa = (LAS float*)(lds + SU_QA);
    LAS float* red = (LAS float*)(lds + SU_RED);
    const size_t r = (size_t)MPROMPT + b;
    const bf16_t* proj = (const bf16_t*)(p.ws + WS_PROJ); const float* aux = (const float*)(p.ws + WS_AUX); bf16_t* mixed = (bf16_t*)(p.ws + WS_MIXED);
    const int* pt = p.page_table + b * NPAGES;
    qa[tid] = bf2f(proj[r * NP + C_Q + tid]) * 0.125f;
    if (tid < 64) cnts[tid] = 0;
    for (int i = tid; i < 2 * 1536; i += NTHR) p.out[O_CS + (size_t)b * 3 * 1536 + i] = p.state_conv[(size_t)b * 3 * 1536 + 1536 + i];
    {
        const int c = lane & 15, g = lane >> 4;
        const float w = aux[r * AUXP + c]; const float aw = fabsf(w) * (1.f / 32.f), sg = w < 0.f ? -1.f : 1.f;
        bf16x8 Qb[2];
#pragma unroll
        for (int s2 = 0; s2 < 2; ++s2) Qb[s2] = pack8_scaled(*(const u32x4*)(proj + r * NP + C_QI + c * 64 + 32 * s2 + 8 * g), aw);
        const f32x4 z4 = {0.f, 0.f, 0.f, 0.f};
        f32x4 ka[4], kb[4];
        auto load_tile = [&](int kt, f32x4 (&k)[4]) {
            if (kt < 512) {
                const int pg = __builtin_amdgcn_readfirstlane(pt[kt >> 3]);
                const f32x4* rp = (const f32x4*)(p.cache_kidx + ((size_t)pg * PAGE + ((16 * kt) & 127) + c) * 64 + 8 * g);
                k[0] = __builtin_nontemporal_load(rp); k[1] = __builtin_nontemporal_load(rp + 1); k[2] = __builtin_nontemporal_load(rp + 8); k[3] = __builtin_nontemporal_load(rp + 9);
            } else if (kt == 512 && c == 0) {
                const f32x4* rp = (const f32x4*)(p.out + O_KIS + (size_t)b * 64 + 8 * g);
                k[0] = rp[0]; k[1] = rp[1]; k[2] = rp[8]; k[3] = rp[9];
            } else { k[0] = z4; k[1] = z4; k[2] = z4; k[3] = z4; }
        };
        load_tile(wave, ka); load_tile(wave + 8, kb);
        for (int kt = wave; kt < 513; kt += 8) {
            f32x4 kn[4]; load_tile(kt + 16, kn);
            f32x4 acc = __builtin_amdgcn_mfma_f32_16x16x32_bf16(pack8f(ka[0], ka[1]), Qb[0], z4, 0, 0, 0);
            acc = __builtin_amdgcn_mfma_f32_16x16x32_bf16(pack8f(ka[2], ka[3]), Qb[1], acc, 0, 0, 0);
            f32x4 v;
#pragma unroll
            for (int e = 0; e < 4; ++e) {
                float t = sg * fmaxf(acc[e], 0.f);
                t += dpp_z<0x111, 0xf>(t); t += dpp_z<0x112, 0xf>(t); t += dpp_z<0x114, 0xf>(t); t += dpp_z<0x118, 0xf>(t);
                v[e] = t;
            }
            if (c == 15) *(LAS f32x4*)(scs + 16 * kt + 4 * g) = v;
#pragma unroll
            for (int e = 0; e < 4; ++e) { ka[e] = kb[e]; kb[e] = kn[e]; }
        }
    }
    __syncthreads();
    unsigned key[17];
#pragma unroll
    for (int i = 0; i < 17; ++i) { const int s = tid + 512 * i; key[i] = s <= PAST ? f2key(scs[s]) : 0u; }
    unsigned prefix = 0u;
    for (int bit = 30; bit >= 0; bit -= 2) {
        const unsigned c1 = prefix | (1u << bit), c2 = prefix | (2u << bit), c3 = prefix | (3u << bit);
        int n1 = 0, n2 = 0, n3 = 0;
#pragma unroll
        for (int i = 0; i < 17; ++i) { n1 += __popcll(__ballot(key[i] >= c1)); n2 += __popcll(__ballot(key[i] >= c2)); n3 += __popcll(__ballot(key[i] >= c3)); }
        const int slot = ((30 - bit) & 2) ? 32 : 0;
        if (lane == 0) { cnts[slot + wave * 4] = n1; cnts[slot + wave * 4 + 1] = n2; cnts[slot + wave * 4 + 2] = n3; }
        __syncthreads();
        int t1 = 0, t2 = 0, t3 = 0;
#pragma unroll
        for (int w8 = 0; w8 < 8; ++w8) { t1 += cnts[slot + w8 * 4]; t2 += cnts[slot + w8 * 4 + 1]; t3 += cnts[slot + w8 * 4 + 2]; }
        if (t3 >= 256) prefix = c3; else if (t2 >= 256) prefix = c2; else if (t1 >= 256) prefix = c1;
    }
    __syncthreads();
    if (tid < 2) cnts[tid] = 0;
    __syncthreads();
#pragma unroll
    for (int i = 0; i < 17; ++i) {
        const int s = tid + 512 * i;
        if (key[i] > prefix) { const int pos = atomicAdd((int*)&cnts[0], 1); if (pos < 256) lst[pos] = s; }
        else if (key[i] == prefix && s <= PAST) { const int pos = atomicAdd((int*)&cnts[1], 1); if (pos < 64) eql[pos] = s; }
    }
    __syncthreads();
    const int ngt = cnts[0], neq = cnts[1] < 64 ? cnts[1] : 64, need = 256 - ngt;
    __syncthreads();
    if (tid < neq) {
        const int s = eql[tid]; int rank = 0;
        for (int j = 0; j < neq; ++j) rank += (eql[j] < s) ? 1 : 0;
        if (rank < need) { const int pos = atomicAdd((int*)&cnts[0], 1); if (pos < 256) lst[pos] = s; }
    }
    __syncthreads();
    if (tid < 256) { const int s = lst[tid]; phys[tid] = s < PAST ? pt[s >> 7] * PAGE + (s & 127) : -1; }
    __syncthreads();
    {
        const int i = tid & 255, g = tid >> 8;
        const int s = lst[i], ph = phys[i]; int dn = PAST - s; dn = dn > 127 ? 127 : dn;
        const float* krow = ph >= 0 ? p.cache_k + ((size_t)ph * 2 + g) * 64 : p.out + O_KS + (size_t)b * 128 + g * 64;
        float kf[64];
#pragma unroll
        for (int c = 0; c < 16; ++c) { const f32x4 v = ((const f32x4*)krow)[c]; kf[4 * c] = v.x; kf[4 * c + 1] = v.y; kf[4 * c + 2] = v.z; kf[4 * c + 3] = v.w; }
        for (int hh = 0; hh < 4; ++hh) {
            const int h = g * 4 + hh; float dot = 0.f;
#pragma unroll
            for (int d = 0; d < 64; ++d) dot += qa[h * 64 + d] * kf[d];
            pl[h * 256 + i] = dot + p.rel_table[(int)c_bucket[dn] * 8 + h];
        }
    }
    __syncthreads();
    {
        const int h = wave;
        float v[4]; float m = -3.0e38f;
#pragma unroll
        for (int j = 0; j < 4; ++j) { v[j] = pl[h * 256 + lane + 64 * j]; m = fmaxf(m, v[j]); }
        m = wave_max(m);
        float sum = 0.f;
#pragma unroll
        for (int j = 0; j < 4; ++j) { v[j] = __expf(v[j] - m); sum += v[j]; }
        const float inv = 1.f / wave_sum(sum);
#pragma unroll
        for (int j = 0; j < 4; ++j) pl[h * 256 + lane + 64 * j] = v[j] * inv;
    }
    __syncthreads();
    {
        const int d = tid & 63, kg = tid >> 6;
        float acc[8] = {0.f, 0.f, 0.f, 0.f, 0.f, 0.f, 0.f, 0.f};
        for (int i0 = 0; i0 < 32; i0 += 8) {
            float v0[8], v1[8];
#pragma unroll
            for (int j = 0; j < 8; ++j) {
                const int ph = phys[kg * 32 + i0 + j];
                const float* vrow = ph >= 0 ? p.cache_v + (size_t)ph * 128 : p.out + O_VS + (size_t)b * 128;
                v0[j] = vrow[d]; v1[j] = vrow[64 + d];
            }
#pragma unroll
            for (int j = 0; j < 8; ++j) {
                const int i = kg * 32 + i0 + j;
#pragma unroll
                for (int h = 0; h < 8; ++h) acc[h] += pl[h * 256 + i] * (h < 4 ? v0[j] : v1[j]);
            }
        }
#pragma unroll
        for (int h = 0; h < 8; ++h) red[(kg * 8 + h) * 64 + d] = acc[h];
    }
    __syncthreads();
    {
        const int d = tid & 63, h = tid >> 6;
        float o = 0.f;
#pragma unroll
        for (int kg = 0; kg < 8; ++kg) o += red[(kg * 8 + h) * 64 + d];
        const float z = bf2f(proj[r * NP + C_ZA + h * 64 + d]);
        mixed[r * D_MODEL + h * 64 + d] = (bf16_t)f2bf(o * silu_f(z));
    }
    __syncthreads();
}

constexpr int N_PHASES = 6;
struct Args { Params p; int ph_lo, ph_hi; };
__global__ void __launch_bounds__(NTHR, 2) mk_fwd(Args a) {
    extern __shared__ __attribute__((aligned(16))) unsigned char lds_raw[];
    LAS unsigned char* lds = (LAS unsigned char*)lds_raw;
    const Params& p = a.p;
    volatile LAS unsigned* MISC = (volatile LAS unsigned*)(lds + MISC_OFF);
    for (int u = threadIdx.x; u < (LDS_BYTES - SCR_BYTES) / 4; u += NTHR) ((LAS unsigned*)(lds + SCR_BYTES))[u] = 0u;
    __syncthreads();
    const int lo = a.ph_lo, hi = a.ph_hi;
    const bool multi = (hi - lo) > 1;
    XcdBarrier bar; bar.bar = (unsigned*)(p.ws + WS_CTL) + CW_BAR; bar.x = 0; bar.st = nullptr;
    if (multi) bar = xcd_barrier_post((unsigned*)(p.ws + WS_CTL) + CW_BAR, MISC + 8);
#define IN(k) (lo <= (k) && (k) < hi)
#ifdef DBG_TIME
    unsigned long long ts0 = __builtin_amdgcn_s_memrealtime(), ts1 = 0, ts2 = 0, ts3 = 0, ts4 = 0, ts5 = 0;
#define STAMP(k) do { const unsigned long long _t = __builtin_amdgcn_s_memrealtime(); if ((k) == 0) ts1 = _t; else if ((k) == 1) ts2 = _t; else if ((k) == 2) ts3 = _t; else if ((k) == 3) ts4 = _t; else ts5 = _t; } while (0)
#else
#define STAMP(k) do {} while (0)
#endif
#define SEAM(k) do { if (IN(k) && IN((k) + 1)) xcd_barrier(bar); STAMP(k); } while (0)
#ifdef DBG_TIME
    unsigned long long tic_t = 0;
#define TIC() do { tic_t = __builtin_amdgcn_s_memrealtime(); } while (0)
#define TOC(k) do { const unsigned long long _n = __builtin_amdgcn_s_memrealtime(); if (threadIdx.x == 0) MISC[16 + (k)] += (unsigned)(_n - tic_t); tic_t = _n; } while (0)
#else
#define TIC() do {} while (0)
#define TOC(k) do {} while (0)
#endif
    if (IN(0)) { ph_prologue(p, lds); __syncthreads(); }
    SEAM(0);
    if (IN(1)) {
        pg8::Gemm g{(const bf16_t*)(p.ws + WS_XN), (const bf16_t*)(p.ws + WS_WINT), MP, NP, 1024};
        pg8::StaticOrder S; S.init(MP, NP, gridDim.x, blockIdx.x);
        EpiIn E{(bf16_t*)(p.ws + WS_PROJ), (float*)(p.ws + WS_AUX), p.out};
        pg8::gemm_phase<EpiIn, pg8::StaticOrder, true, true>(lds, g, S, E);
    }
    SEAM(1);
    if (IN(2)) {
        TIC();
        const bool flip = (((int)blockIdx.x >> 3) & 1) != 0;
#define GDN_LOCAL_BLOCK() do { GdnPre pre; \
            { int tz = threadIdx.x; asm volatile("" : "+v"(tz)); gdn_local_load(p, blockIdx.x, tz & 63, __builtin_amdgcn_readfirstlane(tz >> 6), pre); } \
            _Pragma("unroll 1") for (int u = blockIdx.x; u < BATCH * 4 * 32; u += gridDim.x) { const int nu = u + (int)gridDim.x; gdn_local_unit(p, lds, u, nu < BATCH * 4 * 32 ? nu : -1, pre); } } while (0)
        if (!flip) GDN_LOCAL_BLOCK();
        TOC(0);
        dsa_fill_bias(p, lds);
        {
            const bool bal = gridDim.x == 256;
            const int nun = bal ? 8 : (BATCH * 64 - (int)blockIdx.x + (int)gridDim.x - 1) / (int)gridDim.x;
            bool prebuilt = false;
#pragma unroll 1
            for (int k = 0; k < nun; ++k) {
                int b, qb, b2 = 0, qb2 = 0;
                if (bal) dsa_unit_of(blockIdx.x, k, b, qb); else { const int u = blockIdx.x + k * gridDim.x; b = u & 31; qb = 63 - (u >> 5); }
                const bool nxt = k + 1 < nun;
                if (nxt) { if (bal) dsa_unit_of(blockIdx.x, k + 1, b2, qb2); else { const int u = blockIdx.x + (k + 1) * gridDim.x; b2 = u & 31; qb2 = 63 - (u >> 5); } }
                const bool pre_next = nxt && qb2 >= 8;
                TIC(); dsa_idx_unit(p, lds, b, qb, prebuilt); TOC(1);
                AttnPre apre; dsa_attn_pre(p, b, qb, apre);
                IdxPre ipre; if (pre_next) dsa_idx_pre_load(p, b2, qb2, ipre);
                dsa_select_unit(p, lds, b, qb);
                if (pre_next) dsa_idx_pre_store(lds, ipre);
                TOC(3); dsa_attn_stage(p, lds, b, qb, apre); TOC(2);
                prebuilt = pre_next;
            }
        }
        if (flip) GDN_LOCAL_BLOCK();
#undef GDN_LOCAL_BLOCK
    }
    SEAM(2);
    if (IN(3)) {
        TIC();
        const int G = gridDim.x, half = G / 2;
        if ((int)blockIdx.x < half) { for (int u = blockIdx.x; u < BATCH * 4; u += half) gdn_seq_unit(p, lds, u, (bf16_t*)(p.ws + WS_MIXED)); }
        else {
            for (int u = (int)blockIdx.x - half; u < DEC_BATCH; u += G - half) {
                sample_unit(p, lds, u);
                for (int hh = 0; hh < 4; ++hh) nv_gdn_unit<1>(p, lds, 4 * u + hh, (bf16_t*)(p.ws + WS_MIXED), p.out + O_SSMS);
            }
        }
#ifdef DBG_TIME
        { const unsigned long long _n = __builtin_amdgcn_s_memrealtime(); if (threadIdx.x == 0 && (blockIdx.x == 0 || (int)blockIdx.x == half)) ((float*)(p.ws + WS_DBGACC))[blockIdx.x == 0 ? 6 : 7] = (float)(_n - tic_t) * 0.01f; }
#endif
    }
    SEAM(3);
    if (IN(4)) {
        pg8::Gemm g{(const bf16_t*)(p.ws + WS_MIXED), (const bf16_t*)(p.ws + WS_WOUTT), MP, 1024, 1024};
        pg8::StaticOrder S; S.init(MP, 1024, gridDim.x, blockIdx.x);
        EpiOut E{(bf16_t*)(p.ws + WS_MO)};
        pg8::gemm_phase<EpiOut, pg8::StaticOrder, true, true>(lds, g, S, E);
    }
    SEAM(4);
#ifdef DBG_CMP
    if (IN(5)) {
        for (int u = blockIdx.x; u < BATCH * 4; u += gridDim.x) nv_gdn_unit<0>(p, lds, u, (bf16_t*)(p.ws + WS_DBG), (float*)(p.ws + WS_DBG + 200 * MiB));
        xcd_barrier(bar);
        {
            const bf16_t* A = (const bf16_t*)(p.ws + WS_MIXED); const bf16_t* R = (const bf16_t*)(p.ws + WS_DBG);
            float num = 0.f, den = 0.f;
            for (size_t i = (size_t)blockIdx.x * NTHR + threadIdx.x; i < (size_t)MPROMPT * 512; i += (size_t)gridDim.x * NTHR) {
                const size_t row = i >> 9, col = 512 + (i & 511); const float a = bf2f(A[row * D_MODEL + col]), r = bf2f(R[row * D_MODEL + col]);
                num += (a - r) * (a - r); den += r * r;
            }
            num = wave_sum(num); den = wave_sum(den);
            if ((threadIdx.x & 63) == 0) { atomicAdd((float*)(p.ws + WS_DBGACC), num); atomicAdd((float*)(p.ws + WS_DBGACC) + 1, den); }
        }
        xcd_barrier(bar);
    }
#endif
#ifdef DBG_TIME
    if (blockIdx.x == 0 && threadIdx.x == 0) {
        const unsigned long long t[6] = {ts0, ts1, ts2, ts3, ts4, ts5};
        float* da = (float*)(p.ws + WS_DBGACC);
        if (TSEL1 == 20) { da[4] = da[6]; da[5] = da[7]; } else {
        da[4] = TSEL1 >= 10 ? (float)MISC[16 + TSEL1 - 10] * 0.01f : (float)(t[TSEL1] - t[TSEL1 - 1]) * 0.01f;
        da[5] = TSEL2 >= 10 ? (float)MISC[16 + TSEL2 - 10] * 0.01f : (float)(t[TSEL2] - t[TSEL2 - 1]) * 0.01f; }
    }
    xcd_barrier(bar);
    if (blockIdx.x == 0 && threadIdx.x == 0) p.out[O_CS] += ((const float*)(p.ws + WS_DBGACC))[5] * 0.1f;
#endif
    if (IN(5)) ph_final_norm(p);
#undef IN
#undef SEAM
}

#ifndef MK_N_LAUNCHES
#define MK_N_LAUNCHES 1
#endif
extern "C" void kernel_launch(void* const* d_in, const int* in_sizes, int n_in, void* d_out, int out_size, void* d_ws, size_t ws_size, hipStream_t stream) {
    static int grid = 0;
    if (grid == 0) {
        if (n_in != 17 || (size_t)out_size != O_END || ws_size < WS_END) { fprintf(stderr, "kernel_launch: unexpected shapes n_in %d out %d ws %zu\n", n_in, out_size, ws_size); grid = -1; return; }
        int dev = 0, cus = 0, per_cu = 0;
        if (hipGetDevice(&dev) != hipSuccess || hipDeviceGetAttribute(&cus, hipDeviceAttributeMultiprocessorCount, dev) != hipSuccess) { grid = -1; return; }
        if (hipFuncSetAttribute((const void*)mk_fwd, hipFuncAttributeMaxDynamicSharedMemorySize, LDS_BYTES) != hipSuccess) { fprintf(stderr, "kernel_launch: hipFuncSetAttribute failed\n"); grid = -1; return; }
        if (hipOccupancyMaxActiveBlocksPerMultiprocessor(&per_cu, (const void*)mk_fwd, NTHR, LDS_BYTES) != hipSuccess || per_cu < 1) { fprintf(stderr, "kernel_launch: occupancy query says %d blocks per CU\n", per_cu); (void)hipGetLastError(); }
        grid = cus;
    }
    if (grid < 0) return;
    Args a{};
    Params& p = a.p;
    p.x_prompt = (const float*)d_in[0]; p.x_sample = (const float*)d_in[1]; p.cache_k = (const float*)d_in[2]; p.cache_v = (const float*)d_in[3]; p.cache_kidx = (const float*)d_in[4];
    p.state_ssm = (const float*)d_in[5]; p.state_conv = (const float*)d_in[6]; p.page_table = (const int*)d_in[7]; p.norm_in = (const float*)d_in[8]; p.w_in = (const float*)d_in[9];
    p.conv_w = (const float*)d_in[10]; p.a_log = (const float*)d_in[11]; p.dt_bias = (const float*)d_in[12]; p.gdn_norm = (const float*)d_in[13]; p.w_out = (const float*)d_in[14];
    p.rel_table = (const float*)d_in[15]; p.norm_final = (const float*)d_in[16]; p.out = (float*)d_out; p.ws = (unsigned char*)d_ws;
    (void)hipMemsetAsync((char*)d_ws + WS_CTL, 0, CTL_BYTES, stream);
#if MK_N_LAUNCHES == 1
    a.ph_lo = 0; a.ph_hi = N_PHASES;
    hipLaunchKernelGGL(mk_fwd, dim3(grid), dim3(NTHR), LDS_BYTES, stream, a);
#else
    for (int k = 0; k < N_PHASES; ++k) { a.ph_lo = k; a.ph_hi = k + 1; hipLaunchKernelGGL(mk_fwd, dim3(grid), dim3(NTHR), LDS_BYTES, stream, a); }
#endif
}
```
